# Optimizing an MI355X kernel written in HIP

```python
import math
import jax
import jax.numpy as jnp
from jax import lax
import numpy as np


D_MODEL = 1024
BATCH = 1
SEQ = 16384
DEPTH = 4

GRID_W = 64
CTX_LEN = 256
BLOCK = 128
WINDOW = 128
ROPE_THETA = 10000.0
A_HQ = 8
A_HKV = 2
A_HD = 64
B_H = 4
B_HD = 64
B_VD = 2 * B_HD
C_HQ = 8
C_HKV = 2
C_HD = 128
N_EXPERTS = 16
N_GROUPS = 4
EXPERTS_PER_GROUP = N_EXPERTS // N_GROUPS
TOP_K = 2
D_EXPERT = 512
N_EVEN = (DEPTH + 1) // 2
N_ODD = DEPTH // 2
ALPHA = (2 * DEPTH) ** 0.25
BETA = (8 * DEPTH) ** -0.25
LN_EPS = 1e-5
QK_EPS = 1e-6
SUBLN_EPS = 1e-5
EVEN_SPLITS = (A_HQ * A_HD, A_HKV * A_HD, A_HKV * A_HD, B_H * 2 * B_HD, B_H * 2 * B_HD, B_H * B_VD)
EVEN_IN = sum(EVEN_SPLITS)
EVEN_OUT = A_HQ * A_HD + B_H * B_VD
ODD_SPLITS = (C_HQ * C_HD, C_HKV * C_HD, C_HKV * C_HD)
ODD_IN = sum(ODD_SPLITS)
ODD_OUT = C_HQ * C_HD

kernel_name = 'hybrid_diffusion_window_diff_axial_moe'


def _split(z, sizes):
    idx, acc = [], 0
    for s in sizes[:-1]:
        acc += s
        idx.append(acc)
    return jnp.split(z, idx, axis=-1)


def layer_norm(x, g, b):
    xf = x.astype(jnp.float32)
    mu = jnp.mean(xf, -1, keepdims=True)
    var = jnp.mean(jnp.square(xf - mu), -1, keepdims=True)
    y = (xf - mu) * lax.rsqrt(var + LN_EPS)
    return (y * g.astype(jnp.float32) + b.astype(jnp.float32)).astype(x.dtype)


def rms_norm(x, g, eps):
    xf = x.astype(jnp.float32)
    y = xf * lax.rsqrt(jnp.mean(jnp.square(xf), -1, keepdims=True) + eps)
    return (y * g.astype(jnp.float32)).astype(x.dtype)


def axial_rope_tables(n_tokens, head_dim):
    rows = n_tokens // GRID_W
    rr, cc = jnp.meshgrid(jnp.arange(rows), jnp.arange(GRID_W), indexing='ij')
    quarter = head_dim // 4
    inv_freq = ROPE_THETA ** (-jnp.arange(quarter, dtype=jnp.float32) / quarter)
    ang_r = rr.reshape(-1)[:, None].astype(jnp.float32) * inv_freq
    ang_c = cc.reshape(-1)[:, None].astype(jnp.float32) * inv_freq
    return jnp.cos(ang_r), jnp.sin(ang_r), jnp.cos(ang_c), jnp.sin(ang_c)


def _rotate(x, cos, sin):
    x1, x2 = jnp.split(x, 2, axis=-1)
    return jnp.concatenate([x1 * cos - x2 * sin, x1 * sin + x2 * cos], axis=-1)


def apply_axial_rope(x, tabs):
    cr, sr, cc, sc = [t[:, None, :].astype(x.dtype) for t in tabs]
    xr, xc = jnp.split(x, 2, axis=-1)
    return jnp.concatenate([_rotate(xr, cr, sr), _rotate(xc, cc, sc)], axis=-1)


def gqa_softmax(q, k, v, sink=None):
    hkv, grp = q.shape[2], q.shape[3]
    s = jnp.einsum('bqhgd,bkhd->bhgqk', q, k).astype(jnp.float32) * (q.shape[-1] ** -0.5)
    if sink is not None:
        s_sink = jnp.broadcast_to(sink.astype(jnp.float32).reshape(1, hkv, grp, 1, 1), s.shape[:-1] + (1,))
        p = jax.nn.softmax(jnp.concatenate([s_sink, s], axis=-1), axis=-1)[..., 1:]
    else:
        p = jax.nn.softmax(s, axis=-1)
    return jnp.einsum('bhgqk,bkhd->bqhgd', p.astype(v.dtype), v)


def window_attention_sink(q, k, v, kc, vc, sink):
    bsz, seq = q.shape[0], q.shape[1]
    nb = seq // BLOCK
    grp = A_HQ // A_HKV
    n_ctx = kc.shape[1]
    scale = A_HD ** -0.5
    qb = q.reshape(bsz, nb, BLOCK, A_HKV, grp, A_HD)

    def band(t):
        tp = jnp.pad(t, ((0, 0), (BLOCK, BLOCK), (0, 0), (0, 0))).reshape(bsz, nb + 2, BLOCK, A_HKV, A_HD)
        return jnp.concatenate([tp[:, :-2], tp[:, 1:-1], tp[:, 2:]], axis=2)

    kb, vb = band(k), band(v)
    blk = jnp.arange(nb)[:, None, None] * BLOCK
    qpos = blk + jnp.arange(BLOCK)[None, :, None]
    kpos = blk - BLOCK + jnp.arange(3 * BLOCK)[None, None, :]
    ok = (jnp.abs(qpos - kpos) <= WINDOW) & (kpos >= 0) & (kpos < seq)
    s_loc = jnp.einsum('bnqhgd,bnkhd->bnhgqk', qb, kb).astype(jnp.float32) * scale
    s_loc = jnp.where(ok[None, :, None, None], s_loc, -jnp.inf)
    s_ctx = jnp.einsum('bnqhgd,bchd->bnhgqc', qb, kc).astype(jnp.float32) * scale
    s_sink = jnp.broadcast_to(sink.astype(jnp.float32).reshape(1, 1, A_HKV, grp, 1, 1), s_ctx.shape[:-1] + (1,))
    p = jax.nn.softmax(jnp.concatenate([s_sink, s_ctx, s_loc], axis=-1), axis=-1)
    p_ctx = p[..., 1:1 + n_ctx].astype(v.dtype)
    p_loc = p[..., 1 + n_ctx:].astype(v.dtype)
    o = jnp.einsum('bnhgqc,bchd->bnqhgd', p_ctx, vc) + jnp.einsum('bnhgqk,bnkhd->bnqhgd', p_loc, vb)
    return o.reshape(bsz, seq, A_HQ * A_HD)


def diff_core(q, k, v, lam):
    s = jnp.einsum('bqhmd,bkhmd->bhmqk', q, k).astype(jnp.float32) * (B_HD ** -0.5)
    p = jax.nn.softmax(s, axis=-1)
    a = p[:, :, 0] - lam * p[:, :, 1]
    return jnp.einsum('bhqk,bkhe->bqhe', a.astype(v.dtype), v)


def diff_post(o, subln_g, lam_init):
    o = rms_norm(o, subln_g, SUBLN_EPS) * (1.0 - lam_init)
    return o.reshape(o.shape[0], o.shape[1], B_H * B_VD)


def even_mixer(h, hc, w_in, w_out, sink, lq1, lk1, lq2, lk2, subln_g, lam_init, ctx_out):
    bsz, seq = h.shape[0], h.shape[1]
    n_ctx = hc.shape[1]
    nb = seq // BLOCK
    grp = A_HQ // A_HKV
    tabs = axial_rope_tables(seq, A_HD)

    def proj(t):
        aq, ak, av, bq, bk, bv = _split(t @ w_in, EVEN_SPLITS)
        lead = t.shape[:2]
        return (aq.reshape(lead + (A_HQ, A_HD)), ak.reshape(lead + (A_HKV, A_HD)),
                av.reshape(lead + (A_HKV, A_HD)), bq.reshape(lead + (B_H * 2, B_HD)),
                bk.reshape(lead + (B_H * 2, B_HD)), bv.reshape(lead + (B_H, B_VD)))

    aq, ak, av, bq, bk, bv = proj(h)
    aq, ak, bq, bk = [apply_axial_rope(t, tabs) for t in (aq, ak, bq, bk)]
    aqc, akc, avc, bqc, bkc, bvc = proj(hc)
    lam = (jnp.exp(jnp.sum(lq1 * lk1)) - jnp.exp(jnp.sum(lq2 * lk2))).astype(jnp.float32) + lam_init

    oa = window_attention_sink(aq, ak, av, akc, avc, sink)
    kb_all = jnp.concatenate([bkc, bk], axis=1).reshape(bsz, n_ctx + seq, B_H, 2, B_HD)
    vb_all = jnp.concatenate([bvc, bv], axis=1)
    qblocks = bq.reshape(bsz, nb, BLOCK, B_H, 2, B_HD).swapaxes(0, 1)
    ob = lax.map(lambda qblk: diff_core(qblk, kb_all, vb_all, lam), qblocks)
    ob = diff_post(ob.swapaxes(0, 1).reshape(bsz, seq, B_H, B_VD), subln_g, lam_init)
    y = jnp.concatenate([oa, ob], axis=-1) @ w_out
    if not ctx_out:
        return y, None
    oac = gqa_softmax(aqc.reshape(bsz, n_ctx, A_HKV, grp, A_HD), akc, avc, sink).reshape(bsz, n_ctx, A_HQ * A_HD)
    obc = diff_post(diff_core(bqc.reshape(bsz, n_ctx, B_H, 2, B_HD), bkc.reshape(bsz, n_ctx, B_H, 2, B_HD), bvc, lam), subln_g, lam_init)
    yc = jnp.concatenate([oac, obc], axis=-1) @ w_out
    return y, yc


def odd_mixer(h, hc, w_in, w_out, qn_g, kn_g, ctx_out):
    bsz, seq = h.shape[0], h.shape[1]
    n_ctx = hc.shape[1]
    nb = seq // BLOCK
    grp = C_HQ // C_HKV
    tabs = axial_rope_tables(seq, C_HD)

    def proj(t):
        q, k, v = _split(t @ w_in, ODD_SPLITS)
        lead = t.shape[:2]
        q = rms_norm(q.reshape(lead + (C_HQ, C_HD)), qn_g, QK_EPS)
        k = rms_norm(k.reshape(lead + (C_HKV, C_HD)), kn_g, QK_EPS)
        return q, k, v.reshape(lead + (C_HKV, C_HD))

    q, k, v = proj(h)
    q, k = apply_axial_rope(q, tabs), apply_axial_rope(k, tabs)
    qc, kc, vc = proj(hc)
    k_all = jnp.concatenate([kc, k], axis=1)
    v_all = jnp.concatenate([vc, v], axis=1)
    qblocks = q.reshape(bsz, nb, BLOCK, C_HKV, grp, C_HD).swapaxes(0, 1)
    o = lax.map(lambda qblk: gqa_softmax(qblk, k_all, v_all), qblocks)
    y = o.swapaxes(0, 1).reshape(bsz, seq, C_HQ * C_HD) @ w_out
    if not ctx_out:
        return y, None
    oc = gqa_softmax(qc.reshape(bsz, n_ctx, C_HKV, grp, C_HD), kc, vc).reshape(bsz, n_ctx, C_HQ * C_HD)
    return y, oc @ w_out


def moe(h, w_router, b_router, w_gate, w_up, w_down):
    logits = jnp.einsum('...d,de->...e', h, w_router).astype(jnp.float32)
    scores = jax.nn.sigmoid(logits)
    sel = scores + b_router.astype(jnp.float32)
    grouped = sel.reshape(sel.shape[:-1] + (N_GROUPS, EXPERTS_PER_GROUP))
    group_score = jnp.sum(lax.top_k(grouped, TOP_K)[0], axis=-1)
    best = jnp.argmax(group_score, axis=-1)
    in_group = (jnp.arange(N_EXPERTS) // EXPERTS_PER_GROUP) == best[..., None]
    _, idx = lax.top_k(jnp.where(in_group, sel, -jnp.inf), TOP_K)
    wts = jnp.take_along_axis(scores, idx, axis=-1)
    wts = wts / jnp.sum(wts, axis=-1, keepdims=True)
    gates = jnp.sum(jax.nn.one_hot(idx, N_EXPERTS, dtype=jnp.float32) * wts[..., None], axis=-2)
    g = jnp.einsum('...d,edf->...ef', h, w_gate)
    u = jnp.einsum('...d,edf->...ef', h, w_up)
    a = jax.nn.silu(g) * u * gates[..., None].astype(h.dtype)
    return jnp.einsum('...ef,efd->...d', a, w_down)


def setup_inputs(seed: int = 0) -> dict:
    key = jax.random.key(seed)
    ks = jax.random.split(key, 25)

    def nrm(k, shape, s):
        return jax.random.normal(k, shape, jnp.float32) * s

    return {
        'x': nrm(ks[0], (BATCH, SEQ, D_MODEL), 1.0),
        'c': nrm(ks[1], (BATCH, D_MODEL), 1.0),
        'ctx': nrm(ks[2], (BATCH, CTX_LEN, D_MODEL), 1.0),
        'c_ctx': nrm(ks[3], (D_MODEL,), 1.0),
        'w_mod': nrm(ks[4], (DEPTH, D_MODEL, 6 * D_MODEL), 0.5 * D_MODEL ** -0.5),
        'b_mod': nrm(ks[5], (DEPTH, 6 * D_MODEL), 0.02),
        'ln_g': 1.0 + nrm(ks[6], (DEPTH, 2, D_MODEL), 0.02),
        'ln_b': nrm(ks[7], (DEPTH, 2, D_MODEL), 0.02),
        'w_in_even': nrm(ks[8], (N_EVEN, D_MODEL, EVEN_IN), D_MODEL ** -0.5),
        'w_out_even': nrm(ks[9], (N_EVEN, EVEN_OUT, D_MODEL), BETA * EVEN_OUT ** -0.5),
        'sink_logits': nrm(ks[10], (N_EVEN, A_HQ), 0.5),
        'lam_q1': nrm(ks[11], (N_EVEN, B_HD), 0.1),
        'lam_k1': nrm(ks[12], (N_EVEN, B_HD), 0.1),
        'lam_q2': nrm(ks[13], (N_EVEN, B_HD), 0.1),
        'lam_k2': nrm(ks[14], (N_EVEN, B_HD), 0.1),
        'subln_g': 1.0 + nrm(ks[15], (N_EVEN, B_VD), 0.02),
        'w_in_odd': nrm(ks[16], (N_ODD, D_MODEL, ODD_IN), D_MODEL ** -0.5),
        'w_out_odd': nrm(ks[17], (N_ODD, ODD_OUT, D_MODEL), BETA * ODD_OUT ** -0.5),
        'q_norm_g': 1.0 + nrm(ks[18], (N_ODD, C_HD), 0.02),
        'k_norm_g': 1.0 + nrm(ks[19], (N_ODD, C_HD), 0.02),
        'w_router': nrm(ks[20], (D_MODEL, N_EXPERTS), D_MODEL ** -0.5),
        'b_router': nrm(ks[21], (N_EXPERTS,), 0.01),
        'w_gate': nrm(ks[22], (DEPTH, N_EXPERTS, D_MODEL, D_EXPERT), D_MODEL ** -0.5),
        'w_up': nrm(ks[23], (DEPTH, N_EXPERTS, D_MODEL, D_EXPERT), D_MODEL ** -0.5),
        'w_down': nrm(ks[24], (DEPTH, N_EXPERTS, D_EXPERT, D_MODEL), BETA * D_EXPERT ** -0.5),
    }


def reference(x, c, ctx, c_ctx, w_mod, b_mod, ln_g, ln_b, w_in_even, w_out_even, sink_logits,
              lam_q1, lam_k1, lam_q2, lam_k2, subln_g, w_in_odd, w_out_odd, q_norm_g, k_norm_g,
              w_router, b_router, w_gate, w_up, w_down):
    xc = ctx
    cond = jax.nn.silu(c)
    cond_ctx = jax.nn.silu(c_ctx)
    for l in range(DEPTH):
        ctx_out = l < DEPTH - 1
        sh1, sc1, g1, sh2, sc2, g2 = [m[:, None, :] for m in jnp.split(cond @ w_mod[l] + b_mod[l], 6, axis=-1)]
        shc1, scc1, gc1, shc2, scc2, gc2 = jnp.split(cond_ctx @ w_mod[l] + b_mod[l], 6, axis=-1)
        h = x * (1.0 + sc1) + sh1
        hc = xc * (1.0 + scc1) + shc1
        i = l // 2
        if l % 2 == 0:
            lam_init = 0.8 - 0.6 * math.exp(-0.3 * l)
            y, yc = even_mixer(h, hc, w_in_even[i], w_out_even[i], sink_logits[i], lam_q1[i], lam_k1[i],
                               lam_q2[i], lam_k2[i], subln_g[i], lam_init, ctx_out)
        else:
            y, yc = odd_mixer(h, hc, w_in_odd[i], w_out_odd[i], q_norm_g[i], k_norm_g[i], ctx_out)
        x = layer_norm(ALPHA * x + g1 * y, ln_g[l, 0], ln_b[l, 0])
        h2 = x * (1.0 + sc2) + sh2
        x = layer_norm(ALPHA * x + g2 * moe(h2, w_router, b_router, w_gate[l], w_up[l], w_down[l]), ln_g[l, 1], ln_b[l, 1])
        if ctx_out:
            xc = layer_norm(ALPHA * xc + gc1 * yc, ln_g[l, 0], ln_b[l, 0])
            hc2 = xc * (1.0 + scc2) + shc2
            xc = layer_norm(ALPHA * xc + gc2 * moe(hc2, w_router, b_router, w_gate[l], w_up[l], w_down[l]), ln_g[l, 1], ln_b[l, 1])
    return x
```

```cpp
#include <hip/hip_runtime.h>
#include <cstdio>
#include <cstdint>

#ifndef ATT_F8
#define ATT_F8 1
#endif
#ifndef MK_MULTI
#define MK_MULTI 0
#endif

#define LAS __attribute__((address_space(3)))
#define GAS __attribute__((address_space(1)))
#define CAS __attribute__((address_space(4)))
typedef unsigned short bf16_t;
typedef short bf16x8 __attribute__((ext_vector_type(8)));
typedef short s16x4 __attribute__((ext_vector_type(4)));
typedef float f32x2 __attribute__((ext_vector_type(2)));
typedef float f32x4 __attribute__((ext_vector_type(4)));
typedef float f32x16 __attribute__((ext_vector_type(16)));
typedef unsigned u32x2 __attribute__((ext_vector_type(2)));
typedef unsigned u32x4 __attribute__((ext_vector_type(4)));
typedef int i32x4 __attribute__((ext_vector_type(4)));

constexpr int DM = 1024, SEQ = 16384, NCTX = 256, MROWS = SEQ + NCTX, DEPTH = 4;
constexpr int EVEN_IN = 2304, ODD_IN = 1536;
constexpr int NEXP = 16, DEXP = 512;
constexpr float ALPHA = 1.681792830507429f;
constexpr float LN_EPS = 1e-5f, QK_EPS = 1e-6f, SUBLN_EPS = 1e-5f;
constexpr int NWAVES = 8, NTHREADS = 512;
constexpr int MAXSLOT = 37376;
constexpr float LOG2E = 1.4426950408889634f;

constexpr size_t al256(size_t x) { return (x + 255) / 256 * 256; }
constexpr size_t WS_CTL = 0, CTL_ZERO_BYTES = 1u << 20;
constexpr int CW_BAR = 4096;
constexpr int CW_KMAX = 24576;
constexpr int CW_CNT = 16384;
constexpr size_t WS_MODV = CTL_ZERO_BYTES;
constexpr size_t WS_TAB64 = WS_MODV + al256((size_t)4 * 2 * 6144 * 4);
constexpr size_t WS_TAB128 = WS_TAB64 + al256((size_t)256 * 16 * 2 * 4);
constexpr size_t WS_LAM = WS_TAB128 + al256((size_t)256 * 32 * 2 * 4);
constexpr size_t WS_ROUTE = WS_LAM + 256;
constexpr size_t WS_IDX = WS_ROUTE + al256((size_t)MROWS * 16);
constexpr size_t WS_WINE = al256(WS_IDX + (size_t)NEXP * MROWS * 4);
constexpr size_t WS_WINO = WS_WINE + (size_t)2 * EVEN_IN * DM * 2;
constexpr size_t WS_WOUT = WS_WINO + (size_t)2 * ODD_IN * DM * 2;
constexpr size_t WS_WGU = WS_WOUT + (size_t)4 * DM * DM * 2;
constexpr size_t WS_WD = WS_WGU + (size_t)4 * NEXP * 1024 * DM * 2;
constexpr size_t WS_XB = WS_WD + (size_t)4 * NEXP * DM * DEXP * 2;
constexpr size_t WS_X1B = WS_XB + (size_t)MROWS * DM * 4;
constexpr size_t WS_HB = WS_X1B + (size_t)MROWS * DM * 4;
constexpr size_t WS_QKV = WS_HB + (size_t)MROWS * DM * 2;
constexpr size_t WS_OB = WS_QKV + (size_t)MROWS * EVEN_IN * 2;
constexpr size_t WS_YB = WS_OB + (size_t)MROWS * DM * 2;
constexpr int NTILE = MROWS / 64;
constexpr size_t WS_KF8 = WS_YB + (size_t)MROWS * DM * 4;
constexpr size_t WS_VF8 = WS_KF8 + (size_t)8 * NTILE * 4096;
constexpr size_t WS_END = WS_VF8 + (size_t)4 * NTILE * 8192;
static_assert((size_t)MAXSLOT * DM * 2 <= (size_t)MROWS * EVEN_IN * 2, "moe out fits qkv region");
static_assert((size_t)MAXSLOT * DEXP * 2 <= (size_t)MROWS * DM * 4, "A2 fits y region");

constexpr int RING_BYTES = 131072;
constexpr int LDSCTL_OFF = RING_BYTES;
constexpr int LC_BAR = 0;
constexpr int LC_TSTART = 16;
constexpr int LC_ECNT = 40;
constexpr int LC_LCNT = 56;
constexpr int LC_GBASE = 72;
constexpr int LC_WTAB = 96;
constexpr int LC_KMAX = 1120;
constexpr int LDS_BYTES = 147456;
static_assert(LDSCTL_OFF + (LC_KMAX + 16) * 4 <= 139264 && 139264 + 8192 <= LDS_BYTES, "LDS map");

__device__ __forceinline__ unsigned cvt_pk_bf16(float lo, float hi) { unsigned r; asm volatile("v_cvt_pk_bf16_f32 %0, %1, %2" : "=v"(r) : "v"(lo), "v"(hi)); return r; }
__device__ __forceinline__ float bf_lo(unsigned w) { return __uint_as_float(w << 16); }
__device__ __forceinline__ float bf_hi(unsigned w) { return __uint_as_float(w & 0xffff0000u); }
__device__ __forceinline__ float wave_sum(float v) {
#pragma unroll
    for (int o = 1; o < 64; o <<= 1) v += __shfl_xor(v, o);
    return v;
}
#define LDS_WAIT() asm volatile("s_waitcnt lgkmcnt(0)" ::: "memory")
#define VM_WAIT() asm volatile("s_waitcnt vmcnt(0)" ::: "memory")
#define RLX_AGENT __ATOMIC_RELAXED, __HIP_MEMORY_SCOPE_AGENT

#define XB_TMO      128
#define XB_XCNT(j)  (256  + 64 * (j))
#define XB_XSUB(j)  (1280 + 64 * (j))
#define XB_XGEN(j)  (2304 + 64 * (j))
#define XB_TOP      3328
#define XB_TOPGEN   3392
#define XCD_BAR_WORDS 3456
#define XB_SPIN_CAP (1u << 18)
__device__ __forceinline__ unsigned xb_ld(unsigned* p)              { return __hip_atomic_load(p, __ATOMIC_RELAXED, __HIP_MEMORY_SCOPE_AGENT); }
__device__ __forceinline__ unsigned xb_add(unsigned* p, unsigned v) { return __hip_atomic_fetch_add(p, v, __ATOMIC_RELAXED, __HIP_MEMORY_SCOPE_AGENT); }
__device__ __forceinline__ unsigned xb_xcc_id() { return (unsigned)__builtin_amdgcn_s_getreg((3 << 11) | 20) & 0xFu; }
#define XB_SPIN(cond, bar) do { unsigned _sp = 0; while (cond) { __builtin_amdgcn_s_sleep(1); \
    if ((++_sp & 255u) == 0u) { if (xb_ld(&(bar)[XB_TMO])) break; if (_sp > XB_SPIN_CAP) { atomicAdd(&(bar)[XB_TMO], 1u); break; } } } } while (0)
struct XcdBarrier { unsigned* bar; unsigned x; volatile LAS unsigned* st; };
__device__ __forceinline__ XcdBarrier xcd_barrier_post(unsigned* bar, volatile LAS unsigned* st, bool is_t0) {
    XcdBarrier b; b.bar = bar; b.x = xb_xcc_id(); b.st = st;
    if (is_t0) (void)xb_add(&bar[XB_XCNT(b.x)], 1u);
    return b;
}
__device__ __forceinline__ void xcd_barrier_complete(unsigned* bar, unsigned x, unsigned& nloc, unsigned& nx) {
    const unsigned G = gridDim.x * gridDim.y * gridDim.z;
    unsigned sum, cnt, mine, sp = 0u;
    for (;;) {
        sum = 0u; cnt = 0u; mine = 0u;
#pragma unroll
        for (unsigned j = 0; j < 16; ++j) { const unsigned c = xb_ld(&bar[XB_XCNT(j)]); sum += c; cnt += (c > 0u) ? 1u : 0u; mine = (j == x) ? c : mine; }
        if (sum == G) break;
        __builtin_amdgcn_s_sleep(1);
        if ((++sp & 255u) == 0u) { if (xb_ld(&bar[XB_TMO])) break; if (sp > XB_SPIN_CAP) { atomicAdd(&bar[XB_TMO], 1u); break; } }
    }
    nloc = mine > 0u ? mine : 1u; nx = cnt > 0u ? cnt : 1u;
}
__device__ __forceinline__ void xcd_barrier(const XcdBarrier& b, bool is_t0) {
    asm volatile("s_waitcnt vmcnt(0)" ::: "memory");
    __syncthreads();
    if (is_t0) {
        unsigned* bar = b.bar;
        __builtin_amdgcn_s_waitcnt(0);
        unsigned nloc = b.st[0], nx = b.st[1];
        if (nloc == 0u) { xcd_barrier_complete(bar, b.x, nloc, nx); b.st[0] = nloc; b.st[1] = nx; }
        const unsigned old = xb_add(&bar[XB_XSUB(b.x)], 1u);
        const unsigned gen = old / nloc;
        if (old + 1u == (gen + 1u) * nloc) {
            __builtin_amdgcn_fence(__ATOMIC_RELEASE, "agent");
            asm volatile("s_waitcnt vmcnt(0)" ::: "memory");
            const unsigned og = xb_add(&bar[XB_TOP], 1u);
            const unsigned tg = og / nx;
            if (og + 1u == (tg + 1u) * nx) xb_add(&bar[XB_TOPGEN], 1u);
            else XB_SPIN(xb_ld(&bar[XB_TOPGEN]) == tg, bar);
            __builtin_amdgcn_fence(__ATOMIC_ACQUIRE, "agent");
            xb_add(&bar[XB_XGEN(b.x)], 1u);
            asm volatile("s_waitcnt vmcnt(0)" ::: "memory");
        } else {
            XB_SPIN(xb_ld(&bar[XB_XGEN(b.x)]) == gen, bar);
            __builtin_amdgcn_fence(__ATOMIC_ACQUIRE, "agent");
            asm volatile("s_waitcnt vmcnt(0)" ::: "memory");
        }
    }
    __syncthreads();
}

namespace pg8 {
constexpr int BM = 256, BK = 64, HALF = 128, HTB = HALF * BK * 2, NXCD = 8, WGM = 8;
constexpr int NV_OFF = 139264;
__host__ __device__ __forceinline__ int lds_byte(int r, int c) { const int st = (r >> 4) * 2 + (c >> 5), rr = r & 15, cc = c & 31, ob = rr * 64 + cc * 2; return st * 1024 + (ob ^ (((ob >> 9) & 1) << 5)); }
__host__ __device__ __forceinline__ void stage_rc(int b, int& R, int& C) { const int st = b / 1024, sb = b % 1024, swz = sb ^ (((sb >> 9) & 1) << 5); R = (st >> 1) * 16 + swz / 64; C = (st & 1) * 32 + (swz % 64) / 2; }
__host__ __device__ __forceinline__ int perm32(int rho) { const int n = rho >> 4, i = rho & 15; return 8 * (i >> 2) + 4 * n + (i & 3); }

struct Unit { int pm, pn, e, lrow; };

struct DenseSched {
    static constexpr bool GATHER = false;
    const bf16_t* A; const bf16_t* Bt; int K, nM, nN, nwg, G, c, pm_lo;
    __device__ void init(const bf16_t* A_, const bf16_t* Bt_, int K_, int pm_lo_, int nM_, int N, int G_, int c_) { A = A_; Bt = Bt_; K = K_; pm_lo = pm_lo_; nM = nM_; nN = N / BM; nwg = nM * nN; G = G_; c = c_; }
    __device__ __forceinline__ bool next(int i, Unit& u) const {
        const long L = (long)i * G + c; if (L >= nwg) return false;
        int wgid = (int)L; { const int q = nwg / NXCD, r = nwg % NXCD, xcd = wgid % NXCD, off = wgid / NXCD; wgid = (xcd < r ? xcd * (q + 1) : r * (q + 1) + (xcd - r) * q) + off; }
        const int nig = WGM * nN, gid = wgid / nig, fm = gid * WGM, gsz = (nM - fm) < WGM ? (nM - fm) : WGM;
        u.pm = pm_lo + fm + ((wgid % nig) % gsz); u.pn = (wgid % nig) / gsz; u.e = 0; u.lrow = 0; return true;
    }
    __device__ __forceinline__ const char* a_base(const Unit& u) const { return (const char*)A + (size_t)u.pm * BM * K * 2; }
    __device__ __forceinline__ const char* b_base(const Unit& u) const { return (const char*)Bt + (size_t)u.pn * BM * K * 2; }
    __device__ __forceinline__ void voffs(const Unit&, const int (&R)[2], const int (&C)[2], unsigned (&v0)[2], unsigned (&v1)[2]) const {
#pragma unroll
        for (int i = 0; i < 2; ++i) { v0[i] = (unsigned)(R[i] * K + C[i]) * 2u; v1[i] = v0[i] + (unsigned)(HALF * K) * 2u; }
    }
};
template <bool GATHER_> struct MoeSched {
    static constexpr bool GATHER = GATHER_;
    const bf16_t* Ab; const bf16_t* Wb; const int* idx; const LAS int* tstart; const LAS int* ecnt; int K, base, stride, hi;
    __device__ __forceinline__ bool next(int i, Unit& u) const {
        const int L = base + i * stride; if (L >= hi) return false;
        const int tile = L >> 2; u.pn = L & 3; u.pm = tile;
        int e = 0;
#pragma unroll
        for (int k = 1; k < 16; ++k) e += (tile >= tstart[k]) ? 1 : 0;
        e = __builtin_amdgcn_readfirstlane(e);
        u.e = e; u.lrow = __builtin_amdgcn_readfirstlane((tile - tstart[e]) * 256); return true;
    }
    __device__ __forceinline__ const char* a_base(const Unit& u) const { return GATHER ? (const char*)Ab : (const char*)Ab + (size_t)u.pm * BM * K * 2; }
    __device__ __forceinline__ const char* b_base(const Unit& u) const { return (const char*)Wb + ((size_t)u.e * 1024 + (size_t)u.pn * BM) * K * 2; }
    __device__ __forceinline__ void voffs(const Unit& u, const int (&R)[2], const int (&C)[2], unsigned (&v0)[2], unsigned (&v1)[2]) const {
        if constexpr (GATHER) {
            const int n = ecnt[u.e];
#pragma unroll
            for (int i = 0; i < 2; ++i) {
                const int p0 = u.lrow + R[i], p1 = p0 + HALF;
                const int t0 = p0 < n ? idx[u.e * MROWS + p0] : 0, t1 = p1 < n ? idx[u.e * MROWS + p1] : 0;
                v0[i] = (unsigned)(t0 * K + C[i]) * 2u; v1[i] = (unsigned)(t1 * K + C[i]) * 2u; }
        } else {
#pragma unroll
            for (int i = 0; i < 2; ++i) { v0[i] = (unsigned)(R[i] * K + C[i]) * 2u; v1[i] = v0[i] + (unsigned)(HALF * K) * 2u; }
        }
    }
};

struct EpiF32 {
    static constexpr bool PERM = false;
    float* C; int ldc;
    __device__ __forceinline__ void operator()(const f32x4 (&acc)[2][2][4][2], const Unit& u, int wr, int wc, int fr, int fq) const {
        const int row0 = u.pm * BM + wr * 64 + fr, col0 = u.pn * BM + wc * 32 + 4 * fq;
#pragma unroll
        for (int ai = 0; ai < 2; ++ai)
#pragma unroll
            for (int m = 0; m < 4; ++m) { float* rowp = C + (size_t)(row0 + ai * HALF + m * 16) * ldc + col0;
#pragma unroll
                for (int bj = 0; bj < 2; ++bj)
#pragma unroll
                    for (int n = 0; n < 2; ++n) *(f32x4*)(rowp + bj * HALF + n * 16) = acc[ai][bj][m][n]; }
    }
};
struct EpiBf16 {
    static constexpr bool PERM = true;
    bf16_t* O; int ldc;
    __device__ __forceinline__ void operator()(const f32x4 (&acc)[2][2][4][2], const Unit& u, int wr, int wc, int fr, int fq) const {
        const int row0 = u.pm * BM + wr * 64 + fr, col0 = u.pn * BM + wc * 32 + 8 * fq;
#pragma unroll
        for (int ai = 0; ai < 2; ++ai)
#pragma unroll
            for (int m = 0; m < 4; ++m) { bf16_t* rowp = O + (size_t)(row0 + ai * HALF + m * 16) * ldc + col0;
#pragma unroll
                for (int bj = 0; bj < 2; ++bj) { const f32x4 v0 = acc[ai][bj][m][0], v1 = acc[ai][bj][m][1];
                    u32x4 w; w.x = cvt_pk_bf16(v0[0], v0[1]); w.y = cvt_pk_bf16(v0[2], v0[3]); w.z = cvt_pk_bf16(v1[0], v1[1]); w.w = cvt_pk_bf16(v1[2], v1[3]);
                    *(u32x4*)(rowp + bj * HALF) = w; } }
    }
};
struct EpiGateUp {
    static constexpr bool PERM = true;
    bf16_t* O;
    __device__ __forceinline__ void operator()(const f32x4 (&acc)[2][2][4][2], const Unit& u, int wr, int wc, int fr, int fq) const {
        const int row0 = u.pm * BM + wr * 64 + fr, col0 = u.pn * BM + wc * 32 + 8 * fq;
#pragma unroll
        for (int ai = 0; ai < 2; ++ai)
#pragma unroll
            for (int m = 0; m < 4; ++m) { bf16_t* rowp = O + (size_t)(row0 + ai * HALF + m * 16) * DEXP;
#pragma unroll
                for (int bj = 0; bj < 2; ++bj) { const f32x4 g = acc[ai][bj][m][0], uu = acc[ai][bj][m][1]; float a[4];
#pragma unroll
                    for (int k = 0; k < 4; ++k) { const float s = __builtin_amdgcn_rcpf(1.f + __builtin_amdgcn_exp2f(-g[k] * LOG2E)); a[k] = g[k] * s * uu[k]; }
                    u32x2 w; w.x = cvt_pk_bf16(a[0], a[1]); w.y = cvt_pk_bf16(a[2], a[3]);
                    *(u32x2*)(rowp + ((col0 + bj * HALF) >> 1)) = w; } }
    }
};

template <class Epi, class Sched>
__device__ __forceinline__ void gemm_phase(const int tid, LAS unsigned char* lds, const int K, const Sched& S, const Epi& E) {
    const int wid = __builtin_amdgcn_readfirstlane(tid >> 6), lane = tid & 63, wr = wid >> 2, wc = wid & 3, fr = lane & 15, fq = lane >> 4;
    const int nt = K / BK;
    int Ra[2], Ca[2]; unsigned voffB[2];
#pragma unroll
    for (int i = 0; i < 2; ++i) { int R, C; stage_rc(tid * 16 + i * 8192, R, C); Ra[i] = R; Ca[i] = C; const int Rb = Epi::PERM ? ((R & ~31) + perm32(R & 31)) : R;
        voffB[i] = (unsigned)(Rb * K + C) * 2u; }
    const size_t kstep = (size_t)(BK * 2);
    const size_t hstep = (size_t)HALF * K * 2;
    const unsigned ldsw = (unsigned)wid * 1024u;
    const int aoff = lds_byte(wr * 64 + fr, fq * 8), boff = lds_byte(wc * 32 + fr, fq * 8);
#define PG8_SA(b, h) (((b) * 2 + (h)) * HTB)
#define PG8_SB(b, h) ((4 + (b) * 2 + (h)) * HTB)
#define PG8_STAGE(bufoff, gbase, voff) do { _Pragma("unroll") for (int _i = 0; _i < 2; ++_i) \
        __builtin_amdgcn_global_load_lds((const unsigned*)((const char*)(gbase) + (voff)[_i]), (LAS unsigned*)(lds + (bufoff) + ldsw + _i * 8192), 16, 0, 0); } while (0)
#define PG8_LDA(dst, b, h) do { _Pragma("unroll") for (int m = 0; m < 4; ++m) _Pragma("unroll") for (int k = 0; k < 2; ++k) dst[m][k] = *(const LAS bf16x8*)(lds + PG8_SA(b, h) + aoff + m * 2048 + k * 1024); } while (0)
#define PG8_LDB(dst, b, h) do { _Pragma("unroll") for (int n = 0; n < 2; ++n) _Pragma("unroll") for (int k = 0; k < 2; ++k) dst[n][k] = *(const LAS bf16x8*)(lds + PG8_SB(b, h) + boff + n * 2048 + k * 1024); } while (0)
#define PG8_MMA(ai, bj, At, Bt) do { __builtin_amdgcn_s_setprio(1); _Pragma("unroll") for (int m = 0; m < 4; ++m) _Pragma("unroll") for (int n = 0; n < 2; ++n) _Pragma("unroll") for (int k = 0; k < 2; ++k) \
        acc[ai][bj][m][n] = __builtin_amdgcn_mfma_f32_16x16x32_bf16(Bt[n][k], At[m][k], acc[ai][bj][m][n], 0, 0, 0); __builtin_amdgcn_s_setprio(0); } while (0)
#define PG8_WAIT_V(n) asm volatile("s_waitcnt vmcnt(" #n ")" ::: "memory")
#define PG8_WAIT_L(n) asm volatile("s_waitcnt lgkmcnt(" #n ")" ::: "memory")
#define PG8_BAR __builtin_amdgcn_s_barrier()
#define PG8_SCHED __builtin_amdgcn_sched_barrier(0)
    Unit cur, nxt; int ui = 0;
    if (!S.next(0, cur)) return;
    f32x4 acc[2][2][4][2];
#pragma unroll
    for (int a = 0; a < 2; ++a)
#pragma unroll
        for (int b = 0; b < 2; ++b)
#pragma unroll
            for (int m = 0; m < 4; ++m)
#pragma unroll
                for (int n = 0; n < 2; ++n) acc[a][b][m][n] = (f32x4){0.f, 0.f, 0.f, 0.f};
    bf16x8 At[4][2], B0[2][2], B1[2][2];
    const char* cA = S.a_base(cur); const char* cB = S.b_base(cur);
    unsigned cv0[2], cv1[2], sv0[2], sv1[2];
    S.voffs(cur, Ra, Ca, cv0, cv1);
#define PG8_STAGE_A(bufoff, gbase, half, sel) do { if constexpr (Sched::GATHER) { if (half) { if (sel) PG8_STAGE(bufoff, gbase, sv1); else PG8_STAGE(bufoff, gbase, cv1); } else { if (sel) PG8_STAGE(bufoff, gbase, sv0); else PG8_STAGE(bufoff, gbase, cv0); } } \
        else PG8_STAGE(bufoff, (gbase) + (half) * hstep, cv0); } while (0)
    PG8_STAGE(PG8_SB(0, 0), cB, voffB); PG8_STAGE(PG8_SB(0, 1), cB + hstep, voffB); PG8_STAGE_A(PG8_SA(0, 0), cA, 0, 0); PG8_STAGE_A(PG8_SA(0, 1), cA, 1, 0);
    if (wr == 1) PG8_BAR;
    PG8_WAIT_V(2); PG8_BAR;
    PG8_STAGE(PG8_SB(1, 0), cB + kstep, voffB); PG8_STAGE_A(PG8_SA(1, 0), cA + kstep, 0, 0); PG8_STAGE(PG8_SB(1, 1), cB + hstep + kstep, voffB);
    PG8_WAIT_V(6); PG8_BAR;
    for (;;) {
        const bool has_next = S.next(ui + 1, nxt);
        const char* nA = cA; const char* nB = cB;
        if (has_next) { nA = S.a_base(nxt); nB = S.b_base(nxt); }
        if constexpr (Sched::GATHER) {
            u32x4 q = {cv0[0], cv0[1], cv1[0], cv1[1]};
            if (has_next) { unsigned t0[2], t1[2]; S.voffs(nxt, Ra, Ca, t0, t1); q = (u32x4){t0[0], t0[1], t1[0], t1[1]}; }
            *(LAS u32x4*)(lds + NV_OFF + tid * 16) = q;
        }
        for (int t = 0; t < nt; t += 2) {
            const bool last = (t == nt - 2);
            const char* a1 = cA + (size_t)(t + 1) * kstep;
            const char* a2 = last ? nA : cA + (size_t)(t + 2) * kstep; const char* b2 = last ? nB : cB + (size_t)(t + 2) * kstep;
            const char* a3 = a2 + kstep; const char* b3 = b2 + kstep;
            if constexpr (Sched::GATHER) {
                sv0[0] = cv0[0]; sv0[1] = cv0[1]; sv1[0] = cv1[0]; sv1[1] = cv1[1];
                if (last) { const u32x4 q = *(const LAS u32x4*)(lds + NV_OFF + tid * 16); sv0[0] = q.x; sv0[1] = q.y; sv1[0] = q.z; sv1[1] = q.w; }
            }
            PG8_LDB(B0, 0, 0); PG8_LDB(B1, 0, 1); PG8_SCHED; PG8_LDA(At, 0, 0); PG8_STAGE_A(PG8_SA(1, 1), a1, 1, 0);
            PG8_WAIT_V(8); PG8_WAIT_L(0); PG8_BAR; PG8_MMA(0, 0, At, B0); PG8_MMA(0, 1, At, B1); PG8_BAR; PG8_SCHED;
            PG8_LDA(At, 0, 1); PG8_STAGE(PG8_SB(0, 0), b2, voffB); PG8_STAGE(PG8_SB(0, 1), b2 + hstep, voffB); PG8_STAGE_A(PG8_SA(0, 0), a2, 0, 1);
            PG8_WAIT_V(8); PG8_WAIT_L(0); PG8_BAR; PG8_MMA(1, 0, At, B0); PG8_MMA(1, 1, At, B1); PG8_BAR; PG8_SCHED;
            PG8_LDB(B0, 1, 0); PG8_LDB(B1, 1, 1); PG8_SCHED; PG8_LDA(At, 1, 0); PG8_STAGE_A(PG8_SA(0, 1), a2, 1, 1);
            PG8_WAIT_V(8); PG8_WAIT_L(0); PG8_BAR; PG8_MMA(0, 0, At, B0); PG8_MMA(0, 1, At, B1); PG8_BAR; PG8_SCHED;
            PG8_LDA(At, 1, 1); PG8_STAGE(PG8_SB(1, 0), b3, voffB); PG8_STAGE(PG8_SB(1, 1), b3 + hstep, voffB); PG8_STAGE_A(PG8_SA(1, 0), a3, 0, 1);
            PG8_WAIT_V(8); PG8_WAIT_L(0); PG8_BAR; PG8_MMA(1, 0, At, B0); PG8_MMA(1, 1, At, B1); PG8_BAR; PG8_SCHED;
        }
        if (wr == 0) PG8_BAR;
        E(acc, cur, wr, wc, fr, fq);
        if (!has_next) break;
#pragma unroll
        for (int a = 0; a < 2; ++a)
#pragma unroll
            for (int b = 0; b < 2; ++b)
#pragma unroll
                for (int m = 0; m < 4; ++m)
#pragma unroll
                    for (int n = 0; n < 2; ++n) acc[a][b][m][n] = (f32x4){0.f, 0.f, 0.f, 0.f};
        cur = nxt; cA = nA; cB = nB; ++ui;
        if constexpr (Sched::GATHER) { cv0[0] = sv0[0]; cv0[1] = sv0[1]; cv1[0] = sv1[0]; cv1[1] = sv1[1]; }
        if (wr == 1) PG8_BAR;
    }
    PG8_WAIT_V(0);
    PG8_BAR;
#undef PG8_SA
#undef PG8_SB
#undef PG8_STAGE
#undef PG8_STAGE_A
#undef PG8_LDA
#undef PG8_LDB
#undef PG8_MMA
#undef PG8_WAIT_V
#undef PG8_WAIT_L
#undef PG8_BAR
#undef PG8_SCHED
}
}

namespace att {
constexpr int NW = 8, QBLK = 32, KVBLK = 64;
constexpr int SHM_V = 16384, SHM_K = 16384;
constexpr int SHM_ATTN = 2 * SHM_V + 2 * SHM_K + NW * 64 * 4;
constexpr float THR = 8.f;
#define SBAR() __builtin_amdgcn_sched_barrier(0)
__device__ __forceinline__ int crow(int r, int hi) { return (r & 3) + 8 * (r >> 2) + 4 * hi; }
__device__ __forceinline__ unsigned cvtpk(float lo, float hi) { unsigned r; asm volatile("v_cvt_pk_bf16_f32 %0, %1, %2" : "=v"(r) : "v"(lo), "v"(hi)); return r; }
template <int DQK> __device__ __forceinline__ int kswz(int row, int colB) {
    if constexpr (DQK == 128) return row * 256 + (colB ^ ((row & 7) << 4));
    else return row * 128 + (colB ^ (((row >> 1) & 7) << 4));
}
template <int DQK> __device__ __forceinline__ void partialSM(f32x16& p0, f32x16& p1, float& m_reg, float& mn, float& alpha) {
    constexpr float SCALE = (DQK == 128) ? 0.088388347648318440f : 0.125f;
    constexpr float C = SCALE * LOG2E;
    float pmax = p0[0];
#pragma unroll
    for (int r = 1; r < 16; ++r) pmax = fmaxf(pmax, p0[r]);
#pragma unroll
    for (int r = 0; r < 16; ++r) pmax = fmaxf(pmax, p1[r]);
    { auto rr = __builtin_amdgcn_permlane32_swap(__float_as_uint(pmax), __float_as_uint(pmax), false, false);
      pmax = fmaxf(__uint_as_float(rr[0]), __uint_as_float(rr[1])); }
    if (__builtin_expect(__all(pmax - m_reg <= THR / SCALE), 1)) { mn = m_reg; alpha = 1.f; }
    else { mn = fmaxf(m_reg, pmax); alpha = __builtin_amdgcn_exp2f((m_reg - mn) * C); m_reg = mn; }
    const float mnC = -mn * C;
#pragma unroll
    for (int r = 0; r < 16; ++r) p0[r] = fmaf(p0[r], C, mnC);
#pragma unroll
    for (int r = 0; r < 16; ++r) p1[r] = fmaf(p1[r], C, mnC);
#pragma unroll
    for (int r = 0; r < 16; ++r) p0[r] = __builtin_amdgcn_exp2f(p0[r]);
}
__device__ __forceinline__ void finishSM(f32x16& p0, f32x16& p1, float alpha, float& l_reg, bf16x8& pa0, bf16x8& pa1, bf16x8& pa2, bf16x8& pa3) {
#pragma unroll
    for (int r = 0; r < 16; ++r) p1[r] = __builtin_amdgcn_exp2f(p1[r]);
    float ps = 0;
#pragma unroll
    for (int r = 0; r < 16; ++r) ps += p0[r];
#pragma unroll
    for (int r = 0; r < 16; ++r) ps += p1[r];
    { auto rr = __builtin_amdgcn_permlane32_swap(__float_as_uint(ps), __float_as_uint(ps), false, false);
      ps = __uint_as_float(rr[0]) + __uint_as_float(rr[1]); }
    l_reg = l_reg * alpha + ps;
#define PK4(P, BASE, OUT) do { unsigned a0 = cvtpk(P[BASE + 0], P[BASE + 1]), a1 = cvtpk(P[BASE + 2], P[BASE + 3]);   \
    unsigned b0 = cvtpk(P[BASE + 4], P[BASE + 5]), b1 = cvtpk(P[BASE + 6], P[BASE + 7]);                              \
    auto r0 = __builtin_amdgcn_permlane32_swap(a0, b0, false, false); auto r1 = __builtin_amdgcn_permlane32_swap(a1, b1, false, false); \
    u32x4 w = {r0[0], r1[0], r0[1], r1[1]}; OUT = *reinterpret_cast<bf16x8*>(&w); } while (0)
    PK4(p0, 0, pa0); PK4(p0, 8, pa1); PK4(p1, 0, pa2); PK4(p1, 8, pa3);
#undef PK4
}
template <int DQK> __device__ __forceinline__ void qkt(f32x16& p0, f32x16& p1, const char* Ks, const bf16x8* qr, int r32, int hi) {
    p0 = f32x16{}; p1 = f32x16{};
#pragma unroll
    for (int d0 = 0; d0 < DQK / 16; ++d0) { const int cb = (d0 * 16 + hi * 8) * 2;
        bf16x8 b0 = *reinterpret_cast<const bf16x8*>(Ks + kswz<DQK>(r32, cb));
        bf16x8 b1 = *reinterpret_cast<const bf16x8*>(Ks + kswz<DQK>(32 + r32, cb));
        p0 = __builtin_amdgcn_mfma_f32_32x32x16_bf16(b0, qr[d0], p0, 0, 0, 0);
        p1 = __builtin_amdgcn_mfma_f32_32x32x16_bf16(b1, qr[d0], p1, 0, 0, 0); }
}
__device__ __forceinline__ void wmask(f32x16& p0, f32x16& p1, int k0, int q0lat, int qrel, int hi) {
    const int dbase = k0 - 384 - qrel, pbase = q0lat + k0 - 384;
#pragma unroll
    for (int r = 0; r < 16; ++r) {
        const int kk = crow(r, hi);
        { const int d = dbase + kk, kp = pbase + kk; const bool ok = (d >= -128) && (d <= 128) && (kp >= 0) && (kp < SEQ); p0[r] = ok ? p0[r] : -1e30f; }
        { const int d = dbase + kk + 32, kp = pbase + kk + 32; const bool ok = (d >= -128) && (d <= 128) && (kp >= 0) && (kp < SEQ); p1[r] = ok ? p1[r] : -1e30f; }
    }
}
template <int NCB> __device__ __forceinline__ int v_st(int k, int c) { const int kk = (k & ~0xC) | ((k & 4) << 1) | ((k & 8) >> 1); return ((kk >> 3) * NCB + (c >> 5)) * 512 + ((kk & 7) * 32 + (c & 31)) * 2; }
__device__ __forceinline__ int v_rd_base(int lane) { return ((lane & 3) << 3) | (((lane >> 2) & 3) << 6) | (((lane >> 4) & 1) << 5) | (((lane >> 5) & 1) << 8); }
template <int NCB> constexpr int v_rd_off(int d0, int ks, int half) { return d0 * 512 + ks * (1024 * NCB) + half * (512 * NCB); }
template <int OFF> __device__ __forceinline__ s16x4 tr_read(int vb) {
    s16x4 r; asm volatile("ds_read_b64_tr_b16 %0, %1 offset:%2" : "=&v"(r) : "v"(vb), "i"(OFF) : "memory"); return r;
}
template <int NCB, int D0> __device__ __forceinline__ void pv_one(f32x16& od, int vb, bf16x8 pa0, bf16x8 pa1, bf16x8 pa2, bf16x8 pa3) {
    const s16x4 l0 = tr_read<v_rd_off<NCB>(D0, 0, 0)>(vb), h0 = tr_read<v_rd_off<NCB>(D0, 0, 1)>(vb), l1 = tr_read<v_rd_off<NCB>(D0, 1, 0)>(vb), h1 = tr_read<v_rd_off<NCB>(D0, 1, 1)>(vb);
    const s16x4 l2 = tr_read<v_rd_off<NCB>(D0, 2, 0)>(vb), h2 = tr_read<v_rd_off<NCB>(D0, 2, 1)>(vb), l3 = tr_read<v_rd_off<NCB>(D0, 3, 0)>(vb), h3 = tr_read<v_rd_off<NCB>(D0, 3, 1)>(vb);
    asm volatile("s_waitcnt lgkmcnt(0)" ::: "memory"); SBAR();
#define PK(L, H) (bf16x8){L[0], L[1], L[2], L[3], H[0], H[1], H[2], H[3]}
    od = __builtin_amdgcn_mfma_f32_32x32x16_bf16(pa0, PK(l0, h0), od, 0, 0, 0);
    od = __builtin_amdgcn_mfma_f32_32x32x16_bf16(pa1, PK(l1, h1), od, 0, 0, 0);
    od = __builtin_amdgcn_mfma_f32_32x32x16_bf16(pa2, PK(l2, h2), od, 0, 0, 0);
    od = __builtin_amdgcn_mfma_f32_32x32x16_bf16(pa3, PK(l3, h3), od, 0, 0, 0);
#undef PK
}
template <int NCB> __device__ __forceinline__ void pv_d0(f32x16* o, int vb, bf16x8 pa0, bf16x8 pa1, bf16x8 pa2, bf16x8 pa3) {
    pv_one<NCB, 0>(o[0], vb, pa0, pa1, pa2, pa3); pv_one<NCB, 1>(o[1], vb, pa0, pa1, pa2, pa3);
    if constexpr (NCB == 4) { pv_one<NCB, 2>(o[2], vb, pa0, pa1, pa2, pa3); pv_one<NCB, 3>(o[3], vb, pa0, pa1, pa2, pa3); }
}


template <int DQK>
__device__ __forceinline__ float prep_q_x(float (&x)[DQK / 16][8], const bf16_t* Qw, const float* g, const float* T, int tpos, int hi) {
    constexpr int NQF = DQK / 16, QUART = DQK / 4, NB2 = NQF / 4;
    float ss = 0.f;
#pragma unroll
    for (int b = 0; b < NQF; ++b) { const bf16x8 v = *reinterpret_cast<const bf16x8*>(Qw + b * 16);
#pragma unroll
        for (int j = 0; j < 8; ++j) { x[b][j] = __uint_as_float(((unsigned)(unsigned short)v[j]) << 16); ss = fmaf(x[b][j], x[b][j], ss); } }
    if (g) {
        { auto rr = __builtin_amdgcn_permlane32_swap(__float_as_uint(ss), __float_as_uint(ss), false, false); ss = __uint_as_float(rr[0]) + __uint_as_float(rr[1]); }
        const float rs = 1.f / sqrtf(ss * (1.f / DQK) + QK_EPS); ss = 0.f;
#pragma unroll
        for (int b = 0; b < NQF; ++b) { const f32x4 g0 = *(const f32x4*)(g + b * 16 + hi * 8), g1 = *(const f32x4*)(g + b * 16 + hi * 8 + 4);
#pragma unroll
            for (int j = 0; j < 8; ++j) { x[b][j] *= rs * (j < 4 ? g0[j & 3] : g1[j & 3]); ss = fmaf(x[b][j], x[b][j], ss); } }
    }
    if (tpos >= 0) {
#pragma unroll
        for (int ty = 0; ty < 2; ++ty) { const int pos = ty ? (tpos & 63) : (tpos >> 6);
#pragma unroll
            for (int bb = 0; bb < NB2; ++bb) { const int b1 = ty * 2 * NB2 + bb, b2 = b1 + NB2; const float* tp = T + (pos * QUART + bb * 16 + hi * 8) * 2;
#pragma unroll
                for (int jj = 0; jj < 4; ++jj) { const f32x4 cs = *(const f32x4*)(tp + 4 * jj);
                    { const float x1 = x[b1][2 * jj], x2 = x[b2][2 * jj]; x[b1][2 * jj] = x1 * cs.x - x2 * cs.y; x[b2][2 * jj] = x1 * cs.y + x2 * cs.x; }
                    { const float x1 = x[b1][2 * jj + 1], x2 = x[b2][2 * jj + 1]; x[b1][2 * jj + 1] = x1 * cs.z - x2 * cs.w; x[b2][2 * jj + 1] = x1 * cs.w + x2 * cs.z; } } } }
    }
    { auto rr = __builtin_amdgcn_permlane32_swap(__float_as_uint(ss), __float_as_uint(ss), false, false); ss = __uint_as_float(rr[0]) + __uint_as_float(rr[1]); }
    return ss;
}
template <int DQK>
__device__ __forceinline__ float prep_q(bf16x8 (&qr)[DQK / 16], const bf16_t* Qw, const float* g, const float* T, int tpos, int hi, float pre) {
    constexpr int NQF = DQK / 16;
    float x[NQF][8];
    const float ss = prep_q_x<DQK>(x, Qw, g, T, tpos, hi);
#pragma unroll
    for (int b = 0; b < NQF; ++b) { u32x4 w;
#pragma unroll
        for (int j = 0; j < 4; ++j) w[j] = cvtpk(x[b][2 * j] * pre, x[b][2 * j + 1] * pre);
        qr[b] = *reinterpret_cast<bf16x8*>(&w); }
    return ss;
}
template <int DQK, int DV, bool WINDOW, int SDEPTH>
__device__ __forceinline__ void attn_core(const int tid, const bf16_t* Qb, int ldq, const bf16_t* Kb, const bf16_t* Vb, int ldk, int seq, int q0lat, float m_init, float l_init, char* lds, f32x16 (&o)[DV / 32], const float* ropeT, int tpos0) {
    constexpr int NCB = DV / 32, NQF = DQK / 16, NKL = DQK / 64, NVL = DV / 64;
    constexpr float SCALE = (DQK == 128) ? 0.088388347648318440f : 0.125f;
    constexpr float C = SCALE * LOG2E;
    const int wid = tid >> 6, lane = tid & 63, r32 = lane & 31, hi = lane >> 5;
    char* V_lds = lds; char* K_lds = lds + 2 * SHM_V;
    float* ws = (float*)(lds + 2 * SHM_V + 2 * SHM_K) + wid * 64; float* li_l = ws; float* al_l = ws + 32;
    float m_reg = m_init, l_reg = l_init; bf16x8 qr[NQF];
#pragma unroll
    for (int d = 0; d < NCB; ++d) o[d] = f32x16{};
    const bf16_t* Qw = Qb + (long)(wid * QBLK + r32) * ldq + hi * 8;
    (void)prep_q<DQK>(qr, Qw, nullptr, ropeT, tpos0 >= 0 ? tpos0 + wid * QBLK + r32 : -1, hi, 1.f);
    int krow[NKL], vrow[NVL], kst[NKL], vst[NVL]; int kcol, vcol;
    if constexpr (DQK == 128) { kcol = (tid & 15) * 8; krow[0] = tid >> 4; krow[1] = 32 + (tid >> 4); } else { kcol = (tid & 7) * 8; krow[0] = tid >> 3; }
    if constexpr (DV == 128) { vcol = (tid & 15) * 8; vrow[0] = tid >> 4; vrow[1] = 32 + (tid >> 4); } else { vcol = (tid & 7) * 8; vrow[0] = tid >> 3; }
#pragma unroll
    for (int i = 0; i < NKL; ++i) kst[i] = kswz<DQK>(krow[i], kcol * 2);
#pragma unroll
    for (int i = 0; i < NVL; ++i) vst[i] = v_st<NCB>(vrow[i], vcol);
    const int vb0 = (int)(uintptr_t)V_lds + v_rd_base(lane);
    struct { bf16x8 v[NVL]; bf16x8 k[NKL]; } sr_[SDEPTH];
    unsigned voffv[NVL], voffk[NKL];
#pragma unroll
    for (int i = 0; i < NVL; ++i) voffv[i] = (unsigned)(vrow[i] * ldk + vcol) * 2u;
#pragma unroll
    for (int i = 0; i < NKL; ++i) voffk[i] = (unsigned)(krow[i] * ldk + kcol) * 2u;
#define TROW(k0) (WINDOW ? (((k0) < 256) ? (k0) : (((q0lat + (k0) - 128) > (MROWS - 64)) ? (MROWS - 64) : (q0lat + (k0) - 128))) : (k0))
#define SLOAD(i, k0) do { const size_t _tb = (size_t)TROW(k0) * (size_t)ldk * 2; const char* _vb = (const char*)Vb + _tb; const char* _kb = (const char*)Kb + _tb; \
    _Pragma("unroll") for (int _j = 0; _j < NVL; ++_j) sr_[i].v[_j] = *reinterpret_cast<const bf16x8*>(_vb + voffv[_j]); \
    _Pragma("unroll") for (int _j = 0; _j < NKL; ++_j) sr_[i].k[_j] = *reinterpret_cast<const bf16x8*>(_kb + voffk[_j]); } while (0)
#define SWRITE(b, i) do { _Pragma("unroll") for (int _j = 0; _j < NVL; ++_j) *(bf16x8*)(V_lds + (b) * SHM_V + vst[_j]) = sr_[i].v[_j]; \
    _Pragma("unroll") for (int _j = 0; _j < NKL; ++_j) *(bf16x8*)(K_lds + (b) * SHM_K + kst[_j]) = sr_[i].k[_j]; } while (0)
#define SWAIT() do { if constexpr (SDEPTH == 1) asm volatile("s_waitcnt vmcnt(0)" ::: "memory"); else if constexpr (NKL + NVL == 4) asm volatile("s_waitcnt vmcnt(4)" ::: "memory"); else if constexpr (NKL + NVL == 3) asm volatile("s_waitcnt vmcnt(3)" ::: "memory"); else asm volatile("s_waitcnt vmcnt(2)" ::: "memory"); } while (0)
#define RESC(a) do { if (__any((a) < 1.f)) { if (hi == 0) al_l[r32] = (a); asm volatile("s_waitcnt lgkmcnt(0)" ::: "memory"); \
    _Pragma("unroll") for (int d = 0; d < NCB; ++d) _Pragma("unroll") for (int r = 0; r < 16; ++r) o[d][r] *= al_l[crow(r, hi)]; } } while (0)
#define WMASK(p0, p1, jt) do { if constexpr (WINDOW) { if ((jt) * KVBLK >= 256) wmask(p0, p1, (jt) * KVBLK, q0lat, wid * QBLK + r32, hi); } } while (0)
    f32x16 pA0, pA1, pB0, pB1; float mnA, mnB, alA, alB; bf16x8 pa0, pa1, pa2, pa3; const int NT = seq / KVBLK;
    constexpr int SE = 0, SO = SDEPTH - 1;
    SLOAD(SE, 0); asm volatile("s_waitcnt vmcnt(0)" ::: "memory"); SWRITE(0, SE); __syncthreads();
    qkt<DQK>(pA0, pA1, K_lds, qr, r32, hi); WMASK(pA0, pA1, 0); partialSM<DQK>(pA0, pA1, m_reg, mnA, alA);
    SLOAD(SO, KVBLK); if constexpr (SDEPTH == 2) { if (2 < NT) SLOAD(SE, 2 * KVBLK); }
    SWAIT(); SWRITE(1, SO); __syncthreads();
    for (int j = 1; j + 1 < NT; j += 2) {
        SBAR(); qkt<DQK>(pB0, pB1, K_lds + SHM_K, qr, r32, hi); WMASK(pB0, pB1, j);
        finishSM(pA0, pA1, alA, l_reg, pa0, pa1, pa2, pa3); SBAR();
        SLOAD(SO, (j + SDEPTH) * KVBLK); SBAR();
        pv_d0<NCB>(o, vb0, pa0, pa1, pa2, pa3); partialSM<DQK>(pB0, pB1, m_reg, mnB, alB);
        __syncthreads(); SWAIT(); SWRITE(0, SE);
        RESC(alB); __syncthreads();
        SBAR(); qkt<DQK>(pA0, pA1, K_lds, qr, r32, hi); WMASK(pA0, pA1, j + 1);
        finishSM(pB0, pB1, alB, l_reg, pa0, pa1, pa2, pa3); SBAR();
        if (SDEPTH == 1 || j + 3 < NT) SLOAD(SE, (j + 1 + SDEPTH) * KVBLK); SBAR();
        pv_d0<NCB>(o, vb0 + SHM_V, pa0, pa1, pa2, pa3); partialSM<DQK>(pA0, pA1, m_reg, mnA, alA);
        __syncthreads(); SWAIT(); SWRITE(1, SO);
        RESC(alA); __syncthreads();
    }
    SBAR(); qkt<DQK>(pB0, pB1, K_lds + SHM_K, qr, r32, hi); WMASK(pB0, pB1, NT - 1);
    finishSM(pA0, pA1, alA, l_reg, pa0, pa1, pa2, pa3); SBAR();
    pv_d0<NCB>(o, vb0, pa0, pa1, pa2, pa3); partialSM<DQK>(pB0, pB1, m_reg, mnB, alB);
    __syncthreads(); RESC(alB);
    finishSM(pB0, pB1, alB, l_reg, pa0, pa1, pa2, pa3); SBAR();
    pv_d0<NCB>(o, vb0 + SHM_V, pa0, pa1, pa2, pa3);
    if (hi == 0) li_l[r32] = l_reg; asm volatile("s_waitcnt lgkmcnt(0)" ::: "memory");
#pragma unroll
    for (int r = 0; r < 16; ++r) { const float rl = __builtin_amdgcn_rcpf(li_l[crow(r, hi)]);
#pragma unroll
        for (int d = 0; d < NCB; ++d) o[d][r] *= rl; }
    __syncthreads();
#undef TROW
#undef SLOAD
#undef SWRITE
#undef SWAIT
#undef RESC
#undef WMASK
}
template <int NCB> __device__ __forceinline__ void store_o_bf16(const int tid, const f32x16 (&o)[NCB], bf16_t* O, int ldo) {
    const int wid = tid >> 6, lane = tid & 63, r32 = lane & 31, hi = lane >> 5;
    bf16_t* Ow = O + (long)(wid * QBLK) * ldo + r32;
#pragma unroll
    for (int r = 0; r < 16; ++r) { const int orow = crow(r, hi);
#pragma unroll
        for (int d = 0; d < NCB; ++d) Ow[(long)orow * ldo + d * 32] = (bf16_t)(cvtpk(o[d][r], 0.f) & 0xffffu); }
}

typedef float f32x2_t __attribute__((ext_vector_type(2)));
typedef __bf16 bf16x2_t __attribute__((ext_vector_type(2)));
typedef short v4i16_t __attribute__((ext_vector_type(4)));
__device__ __forceinline__ unsigned cvtpk_s(float lo, float hi) { f32x2_t v = {lo, hi}; bf16x2_t b = __builtin_convertvector(v, bf16x2_t); return __builtin_bit_cast(unsigned, b); }
__device__ __forceinline__ s16x4 vtr(int addr) { return __builtin_bit_cast(s16x4, __builtin_amdgcn_ds_read_tr16_b64_v4i16((LAS v4i16_t*)(uintptr_t)(unsigned)addr)); }
__device__ __forceinline__ float bfv(short x) { return __uint_as_float(((unsigned)(unsigned short)x) << 16); }
template <int DQK> __device__ __forceinline__ void qkt_init(f32x16& p0, f32x16& p1, float init, const char* Ks, const bf16x8* qr, int r32, int hi) {
#pragma unroll
    for (int r = 0; r < 16; ++r) { p0[r] = init; p1[r] = init; }
#pragma unroll
    for (int d0 = 0; d0 < DQK / 16; ++d0) { const int cb = (d0 * 16 + hi * 8) * 2;
        bf16x8 b0 = *reinterpret_cast<const bf16x8*>(Ks + kswz<DQK>(r32, cb));
        bf16x8 b1 = *reinterpret_cast<const bf16x8*>(Ks + kswz<DQK>(32 + r32, cb));
        p0 = __builtin_amdgcn_mfma_f32_32x32x16_bf16(b0, qr[d0], p0, 0, 0, 0);
        p1 = __builtin_amdgcn_mfma_f32_32x32x16_bf16(b1, qr[d0], p1, 0, 0, 0); }
}
__device__ __forceinline__ void exp_half(f32x16& p) {
#pragma unroll
    for (int r = 0; r < 16; ++r) p[r] = __builtin_amdgcn_exp2f(p[r]);
}
__device__ __forceinline__ void finish_fixed(f32x16& p0, f32x16& p1, float& l_reg, bf16x8& pa0, bf16x8& pa1, bf16x8& pa2, bf16x8& pa3) {
    exp_half(p1);
    float ps = 0;
#pragma unroll
    for (int r = 0; r < 16; ++r) ps += p0[r];
#pragma unroll
    for (int r = 0; r < 16; ++r) ps += p1[r];
    l_reg += ps;
#define PK4(P, BASE, OUT) do { unsigned a0 = cvtpk(P[BASE + 0], P[BASE + 1]), a1 = cvtpk(P[BASE + 2], P[BASE + 3]);   \
    unsigned b0 = cvtpk(P[BASE + 4], P[BASE + 5]), b1 = cvtpk(P[BASE + 6], P[BASE + 7]);                              \
    auto r0 = __builtin_amdgcn_permlane32_swap(a0, b0, false, false); auto r1 = __builtin_amdgcn_permlane32_swap(a1, b1, false, false); \
    u32x4 w = {r0[0], r1[0], r0[1], r1[1]}; OUT = *reinterpret_cast<bf16x8*>(&w); } while (0)
    PK4(p0, 0, pa0); PK4(p0, 8, pa1); PK4(p1, 0, pa2); PK4(p1, 8, pa3);
#undef PK4
}
template <int DQK, int DV, int SDEPTH>
__device__ __forceinline__ void attn_core_fixed(const int tid, const bf16_t* Qb, int ldq, const bf16_t* Kb, const bf16_t* Vb, int ldk, int seq, float kmaxC, char* lds, f32x16 (&o)[DV / 32]) {
    constexpr int NCB = DV / 32, NQF = DQK / 16, NKL = DQK / 64, NVL = DV / 64;
    constexpr float SCALE = (DQK == 128) ? 0.088388347648318440f : 0.125f;
    constexpr float C = SCALE * LOG2E;
    const int wid = tid >> 6, lane = tid & 63, r32 = lane & 31, hi = lane >> 5;
    char* V_lds = lds; char* K_lds = lds + 2 * SHM_V;
    float* li_l = (float*)(lds + 2 * SHM_V + 2 * SHM_K) + wid * 64;
    float l_reg = 0.f; bf16x8 qr[NQF];
#pragma unroll
    for (int d = 0; d < NCB; ++d) o[d] = f32x16{};
    const bf16_t* Qw = Qb + (long)(wid * QBLK + r32) * ldq + hi * 8;
#pragma unroll
    for (int d0 = 0; d0 < NQF; ++d0) qr[d0] = *reinterpret_cast<const bf16x8*>(Qw + d0 * 16);
    float ssq = 0.f;
#pragma unroll
    for (int d0 = 0; d0 < NQF; ++d0) { u32x4 w;
#pragma unroll
        for (int j = 0; j < 4; ++j) { const float a = bfv(qr[d0][2 * j]), b = bfv(qr[d0][2 * j + 1]); ssq = fmaf(a, a, ssq); ssq = fmaf(b, b, ssq); w[j] = cvtpk(a * C, b * C); }
        qr[d0] = *reinterpret_cast<bf16x8*>(&w); }
    { auto rr = __builtin_amdgcn_permlane32_swap(__float_as_uint(ssq), __float_as_uint(ssq), false, false); ssq = __uint_as_float(rr[0]) + __uint_as_float(rr[1]); }
    const float ninit = -fmaxf(0.f, sqrtf(ssq) * kmaxC - 60.f);
    int krow[NKL], vrow[NVL], kst[NKL], vst[NVL]; int kcol, vcol;
    if constexpr (DQK == 128) { kcol = (tid & 15) * 8; krow[0] = tid >> 4; krow[1] = 32 + (tid >> 4); } else { kcol = (tid & 7) * 8; krow[0] = tid >> 3; }
    if constexpr (DV == 128) { vcol = (tid & 15) * 8; vrow[0] = tid >> 4; vrow[1] = 32 + (tid >> 4); } else { vcol = (tid & 7) * 8; vrow[0] = tid >> 3; }
#pragma unroll
    for (int i = 0; i < NKL; ++i) kst[i] = kswz<DQK>(krow[i], kcol * 2);
#pragma unroll
    for (int i = 0; i < NVL; ++i) vst[i] = v_st<NCB>(vrow[i], vcol);
    const int vb0 = (int)(uintptr_t)V_lds + v_rd_base(lane);
    struct { bf16x8 v[NVL]; bf16x8 k[NKL]; } sr_[SDEPTH];
    unsigned voffv[NVL], voffk[NKL];
#pragma unroll
    for (int i = 0; i < NVL; ++i) voffv[i] = (unsigned)(vrow[i] * ldk + vcol) * 2u;
#pragma unroll
    for (int i = 0; i < NKL; ++i) voffk[i] = (unsigned)(krow[i] * ldk + kcol) * 2u;
#define SLOAD(i, k0) do { const size_t _tb = (size_t)(k0) * (size_t)ldk * 2; const char* _vb = (const char*)Vb + _tb; const char* _kb = (const char*)Kb + _tb; \
    _Pragma("unroll") for (int _j = 0; _j < NVL; ++_j) sr_[i].v[_j] = *reinterpret_cast<const bf16x8*>(_vb + voffv[_j]); \
    _Pragma("unroll") for (int _j = 0; _j < NKL; ++_j) sr_[i].k[_j] = *reinterpret_cast<const bf16x8*>(_kb + voffk[_j]); } while (0)
#define SWRITE(b, i) do { _Pragma("unroll") for (int _j = 0; _j < NVL; ++_j) *(bf16x8*)(V_lds + (b) * SHM_V + vst[_j]) = sr_[i].v[_j]; \
    _Pragma("unroll") for (int _j = 0; _j < NKL; ++_j) *(bf16x8*)(K_lds + (b) * SHM_K + kst[_j]) = sr_[i].k[_j]; } while (0)
#define SWAIT() do { if constexpr (SDEPTH == 1) asm volatile("s_waitcnt vmcnt(0)" ::: "memory"); else if constexpr (NKL + NVL == 4) asm volatile("s_waitcnt vmcnt(4)" ::: "memory"); else if constexpr (NKL + NVL == 3) asm volatile("s_waitcnt vmcnt(3)" ::: "memory"); else asm volatile("s_waitcnt vmcnt(2)" ::: "memory"); } while (0)
    f32x16 pA0, pA1, pB0, pB1; bf16x8 pa0, pa1, pa2, pa3; const int NT = seq / KVBLK;
    constexpr int SE = 0, SO = SDEPTH - 1;
    SLOAD(SE, 0); asm volatile("s_waitcnt vmcnt(0)" ::: "memory"); SWRITE(0, SE); __syncthreads();
    qkt_init<DQK>(pA0, pA1, ninit, K_lds, qr, r32, hi); exp_half(pA0);
    SLOAD(SO, KVBLK); if constexpr (SDEPTH == 2) { if (2 < NT) SLOAD(SE, 2 * KVBLK); }
    SWAIT(); SWRITE(1, SO); __syncthreads();
    for (int j = 1; j + 1 < NT; j += 2) {
        SBAR(); qkt_init<DQK>(pB0, pB1, ninit, K_lds + SHM_K, qr, r32, hi);
        finish_fixed(pA0, pA1, l_reg, pa0, pa1, pa2, pa3); SBAR();
        SLOAD(SO, (j + SDEPTH) * KVBLK); SBAR();
        pv_d0<NCB>(o, vb0, pa0, pa1, pa2, pa3); SBAR(); exp_half(pB0); SBAR();
        __syncthreads(); SWAIT(); SWRITE(0, SE);
        __syncthreads();
        SBAR(); qkt_init<DQK>(pA0, pA1, ninit, K_lds, qr, r32, hi);
        finish_fixed(pB0, pB1, l_reg, pa0, pa1, pa2, pa3); SBAR();
        if (SDEPTH == 1 || j + 3 < NT) SLOAD(SE, (j + 1 + SDEPTH) * KVBLK); SBAR();
        pv_d0<NCB>(o, vb0 + SHM_V, pa0, pa1, pa2, pa3); SBAR(); exp_half(pA0); SBAR();
        __syncthreads(); SWAIT(); SWRITE(1, SO);
        __syncthreads();
    }
    SBAR(); qkt_init<DQK>(pB0, pB1, ninit, K_lds + SHM_K, qr, r32, hi);
    finish_fixed(pA0, pA1, l_reg, pa0, pa1, pa2, pa3); SBAR();
    pv_d0<NCB>(o, vb0, pa0, pa1, pa2, pa3); exp_half(pB0);
    __syncthreads();
    finish_fixed(pB0, pB1, l_reg, pa0, pa1, pa2, pa3); SBAR();
    pv_d0<NCB>(o, vb0 + SHM_V, pa0, pa1, pa2, pa3);
    { auto rr = __builtin_amdgcn_permlane32_swap(__float_as_uint(l_reg), __float_as_uint(l_reg), false, false); l_reg = __uint_as_float(rr[0]) + __uint_as_float(rr[1]); }
    if (hi == 0) li_l[r32] = l_reg; asm volatile("s_waitcnt lgkmcnt(0)" ::: "memory");
#pragma unroll
    for (int r = 0; r < 16; ++r) { const float rl = __builtin_amdgcn_rcpf(li_l[crow(r, hi)]);
#pragma unroll
        for (int d = 0; d < NCB; ++d) o[d][r] *= rl; }
    __syncthreads();
#undef SLOAD
#undef SWRITE
#undef SWAIT
}

constexpr int DMA_KRING = 0, DMA_VRING = 3 * SHM_K, DMA_SCR = 3 * SHM_K + 3 * SHM_V;
template <int DQK, int DV>
__device__ __forceinline__ void attn_core_dma(const int tid, const bf16_t* Qb, int ldq, const bf16_t* Kb, const bf16_t* Vb, int ldk, int seq, float kmaxC, LAS unsigned char* ldsl, f32x16 (&o)[DV / 32]) {
    static_assert(DV == 128, "V image is [64][128]");
    constexpr int NCB = DV / 32, NQF = DQK / 16, NKL = DQK / 64, NVL = DV / 64;
    constexpr float SCALE = (DQK == 128) ? 0.088388347648318440f : 0.125f;
    constexpr float C = SCALE * LOG2E;
    const int wid = __builtin_amdgcn_readfirstlane(tid >> 6), lane = tid & 63, r32 = lane & 31, hi = lane >> 5;
    char* lds = (char*)(unsigned char*)ldsl;
    char* K_lds = lds + DMA_KRING; char* V_lds = lds + DMA_VRING;
    float* li_l = (float*)(lds + DMA_SCR) + wid * 64;
    float l_reg = 0.f; bf16x8 qr[NQF];
#pragma unroll
    for (int d = 0; d < NCB; ++d) o[d] = f32x16{};
    const bf16_t* Qw = Qb + (long)(wid * QBLK + r32) * ldq + hi * 8;
#pragma unroll
    for (int d0 = 0; d0 < NQF; ++d0) qr[d0] = *reinterpret_cast<const bf16x8*>(Qw + d0 * 16);
    float ssq = 0.f;
#pragma unroll
    for (int d0 = 0; d0 < NQF; ++d0) { u32x4 w;
#pragma unroll
        for (int j = 0; j < 4; ++j) { const float a = bfv(qr[d0][2 * j]), b = bfv(qr[d0][2 * j + 1]); ssq = fmaf(a, a, ssq); ssq = fmaf(b, b, ssq); w[j] = cvtpk(a * C, b * C); }
        qr[d0] = *reinterpret_cast<bf16x8*>(&w); }
    { auto rr = __builtin_amdgcn_permlane32_swap(__float_as_uint(ssq), __float_as_uint(ssq), false, false); ssq = __uint_as_float(rr[0]) + __uint_as_float(rr[1]); }
    const float ninit = -fmaxf(0.f, sqrtf(ssq) * kmaxC - 60.f);
    unsigned srck[NKL], srcv[NVL];
#pragma unroll
    for (int i = 0; i < NKL; ++i) { const int b = (wid * NKL + i) * 1024 + lane * 16;
        if constexpr (DQK == 128) { const int row = b >> 8, colB = (b & 255) ^ ((row & 7) << 4); srck[i] = (unsigned)(row * ldk * 2 + colB); }
        else { const int row = b >> 7, colB = (b & 127) ^ (((row >> 1) & 7) << 4); srck[i] = (unsigned)(row * ldk * 2 + colB); } }
#pragma unroll
    for (int i = 0; i < NVL; ++i) { const int b = (wid * NVL + i) * 1024 + lane * 16; const int sub = b >> 9, kk = (sub >> 2) * 8 + ((b & 511) >> 6);
        const int k = (kk & ~0xC) | ((kk & 4) << 1) | ((kk & 8) >> 1), c = (sub & 3) * 32 + ((b & 63) >> 1); srcv[i] = (unsigned)(k * ldk * 2 + c * 2); }
    const int vb0 = (int)(uintptr_t)V_lds + v_rd_base(lane);
    const int NT = seq / KVBLK;
#define DMA_K(t, slot) do { const int _t = (t) < NT ? (t) : NT - 1; const char* _kb = (const char*)Kb + (size_t)_t * KVBLK * (size_t)ldk * 2; \
    _Pragma("unroll") for (int _i = 0; _i < NKL; ++_i) __builtin_amdgcn_global_load_lds((const unsigned*)(_kb + srck[_i]), (LAS unsigned*)(ldsl + DMA_KRING + (slot) * SHM_K + (wid * NKL + _i) * 1024), 16, 0, 0); } while (0)
#define DMA_V(t, slot) do { const int _t = (t) < NT ? (t) : NT - 1; const char* _vb = (const char*)Vb + (size_t)_t * KVBLK * (size_t)ldk * 2; \
    _Pragma("unroll") for (int _i = 0; _i < NVL; ++_i) __builtin_amdgcn_global_load_lds((const unsigned*)(_vb + srcv[_i]), (LAS unsigned*)(ldsl + DMA_VRING + (slot) * SHM_V + (wid * NVL + _i) * 1024), 16, 0, 0); } while (0)
#define DMA_WAIT_BAR() do { if constexpr (NKL + NVL == 4) asm volatile("s_waitcnt vmcnt(4)" ::: "memory"); else asm volatile("s_waitcnt vmcnt(3)" ::: "memory"); \
    __builtin_amdgcn_s_barrier(); SBAR(); } while (0)
#define NEXT3(x) ((x) == 2 ? 0 : (x) + 1)
    f32x16 pA0, pA1, pB0, pB1; bf16x8 pa0, pa1, pa2, pa3;
    DMA_K(0, 0); DMA_K(1, 1); DMA_V(0, 0);
    asm volatile("s_waitcnt vmcnt(0)" ::: "memory"); __builtin_amdgcn_s_barrier(); SBAR();
    DMA_K(2, 2); DMA_V(1, 1);
    qkt_init<DQK>(pA0, pA1, ninit, K_lds, qr, r32, hi); exp_half(pA0);
    DMA_WAIT_BAR();
    int ks = 1, vs = 0;
    for (int j = 1; j + 1 < NT; j += 2) {
        { const int kd = ks == 0 ? 2 : ks - 1, vd = vs == 0 ? 2 : vs - 1; DMA_K(j + 2, kd); DMA_V(j + 1, vd); }
        SBAR(); qkt_init<DQK>(pB0, pB1, ninit, K_lds + ks * SHM_K, qr, r32, hi);
        finish_fixed(pA0, pA1, l_reg, pa0, pa1, pa2, pa3); SBAR();
        pv_d0<NCB>(o, vb0 + vs * SHM_V, pa0, pa1, pa2, pa3); SBAR(); exp_half(pB0); SBAR();
        DMA_WAIT_BAR();
        ks = NEXT3(ks); vs = NEXT3(vs);
        { const int kd = ks == 0 ? 2 : ks - 1, vd = vs == 0 ? 2 : vs - 1; DMA_K(j + 3, kd); DMA_V(j + 2, vd); }
        SBAR(); qkt_init<DQK>(pA0, pA1, ninit, K_lds + ks * SHM_K, qr, r32, hi);
        finish_fixed(pB0, pB1, l_reg, pa0, pa1, pa2, pa3); SBAR();
        pv_d0<NCB>(o, vb0 + vs * SHM_V, pa0, pa1, pa2, pa3); SBAR(); exp_half(pA0); SBAR();
        DMA_WAIT_BAR();
        ks = NEXT3(ks); vs = NEXT3(vs);
    }
    SBAR(); qkt_init<DQK>(pB0, pB1, ninit, K_lds + ks * SHM_K, qr, r32, hi);
    finish_fixed(pA0, pA1, l_reg, pa0, pa1, pa2, pa3); SBAR();
    pv_d0<NCB>(o, vb0 + vs * SHM_V, pa0, pa1, pa2, pa3); SBAR(); exp_half(pB0); SBAR();
    asm volatile("s_waitcnt vmcnt(0)" ::: "memory"); __builtin_amdgcn_s_barrier(); SBAR();
    vs = NEXT3(vs);
    finish_fixed(pB0, pB1, l_reg, pa0, pa1, pa2, pa3); SBAR();
    pv_d0<NCB>(o, vb0 + vs * SHM_V, pa0, pa1, pa2, pa3);
    { auto rr = __builtin_amdgcn_permlane32_swap(__float_as_uint(l_reg), __float_as_uint(l_reg), false, false); l_reg = __uint_as_float(rr[0]) + __uint_as_float(rr[1]); }
    if (hi == 0) li_l[r32] = l_reg; asm volatile("s_waitcnt lgkmcnt(0)" ::: "memory");
#pragma unroll
    for (int r = 0; r < 16; ++r) { const float rl = __builtin_amdgcn_rcpf(li_l[crow(r, hi)]);
#pragma unroll
        for (int d = 0; d < NCB; ++d) o[d][r] *= rl; }
    __syncthreads();
#undef DMA_K
#undef DMA_V
#undef DMA_WAIT_BAR
#undef NEXT3
}

__device__ __forceinline__ void glds16(const void* gsrc, unsigned lds_dst) { unsigned keep;
    asm volatile("s_mov_b32 %0, m0\n\ts_mov_b32 m0, %2\n\ts_nop 0\n\tglobal_load_lds_dwordx4 %1, off\n\ts_mov_b32 m0, %0" : "=&s"(keep) : "v"(gsrc), "s"(lds_dst) : "memory"); }
template <int DQK>
__device__ __forceinline__ void attn_core_il(const int tid, const bf16_t* Qb, int ldq, const bf16_t* Kb, const bf16_t* Vb, int ldk, int seq, float kmaxC, LAS unsigned char* ldsl, f32x16 (&o)[4], const float* qgain, const float* ropeT, int tpos0) {
    constexpr int NQF = DQK / 16, NKL = DQK / 64, NVL = 2, NGA = 2 * NQF, NADD = 32 / NGA, NPK = 16 / NGA, NCG = DQK / 32;
    constexpr float SCALE = (DQK == 128) ? 0.088388347648318440f : 0.125f;
    constexpr float C = SCALE * LOG2E;
    typedef const LAS char* lds_cptr;
    const int wid = __builtin_amdgcn_readfirstlane(tid >> 6), lane = tid & 63, r32 = lane & 31, hi = lane >> 5;
    char* lds = (char*)(unsigned char*)ldsl; const unsigned ldsb = (unsigned)(uintptr_t)ldsl;
    float* li_l = (float*)(lds + DMA_SCR) + wid * 64;
    float l_reg = 0.f; bf16x8 qr[NQF];
#pragma unroll
    for (int d = 0; d < 4; ++d) o[d] = f32x16{};
    const bf16_t* Qw = Qb + (long)(wid * QBLK + r32) * ldq + hi * 8;
    const float ssq = prep_q<DQK>(qr, Qw, qgain, ropeT, tpos0 >= 0 ? tpos0 + wid * QBLK + r32 : -1, hi, C);
    f32x16 negm;
    { const float ninit = -fmaxf(0.f, sqrtf(ssq) * kmaxC - 60.f);
#pragma unroll
      for (int r = 0; r < 16; ++r) negm[r] = ninit; }
    asm volatile("" : "+v"(negm));
    unsigned srck[2 * NKL], srcv[2 * NVL];
#pragma unroll
    for (int i = 0; i < 2 * NKL; ++i) { const int p = (wid & 3) + 4 * i, rg = p / NCG, cg = p % NCG; srck[i] = (unsigned)((rg * 16 + (lane & 15)) * ldk + (cg * 4 + (lane >> 4)) * 8) * 2u; }
#pragma unroll
    for (int i = 0; i < 2 * NVL; ++i) { const int p = (wid & 3) + 4 * i; srcv[i] = (unsigned)((16 * (p & 3) + (lane >> 2)) * ldk + (p >> 2) * 32 + (lane & 3) * 8) * 2u; }
    const lds_cptr kp0 = (lds_cptr)ldsl + DMA_KRING + (r32 >> 4) * (NCG * 1024) + hi * 256 + (r32 & 15) * 16;
    const lds_cptr vp0 = (lds_cptr)ldsl + DMA_VRING + ((lane >> 4) & 1) * 32 + (lane & 3) * 8 + (4 * hi + ((lane & 15) >> 2)) * 64;
    const int NT = seq / KVBLK;
#define DMA_K(t, slot) do { const int _t = (t) < NT ? (t) : NT - 1; const char* _kb = (const char*)Kb + (size_t)_t * KVBLK * (size_t)ldk * 2; \
    if (wid < 4) { _Pragma("unroll") for (int _i = 0; _i < 2 * NKL; ++_i) glds16(_kb + srck[_i], (unsigned)__builtin_amdgcn_readfirstlane((int)(ldsb + DMA_KRING + (slot) * SHM_K + (wid + 4 * _i) * 1024))); } } while (0)
#define DMA_V(t, slot) do { const int _t = (t) < NT ? (t) : NT - 1; const char* _vb = (const char*)Vb + (size_t)_t * KVBLK * (size_t)ldk * 2; \
    if (wid < 4) { _Pragma("unroll") for (int _i = 0; _i < 2 * NVL; ++_i) glds16(_vb + srcv[_i], (unsigned)__builtin_amdgcn_readfirstlane((int)(ldsb + DMA_VRING + (slot) * SHM_V + (wid + 4 * _i) * 1024))); } } while (0)
#define WAIT_BAR_N() do { if constexpr (NKL + NVL == 4) asm volatile("s_waitcnt vmcnt(8) lgkmcnt(0)\n\ts_barrier" ::: "memory"); else asm volatile("s_waitcnt vmcnt(6) lgkmcnt(0)\n\ts_barrier" ::: "memory"); SBAR(); } while (0)
#define WAIT_BAR_0() do { asm volatile("s_waitcnt vmcnt(0) lgkmcnt(0)\n\ts_barrier" ::: "memory"); SBAR(); } while (0)
#define PIN(x) asm volatile("" : "+v"(x))
#define KFR(kp, g) (*(const LAS bf16x8*)((kp) + ((g) & 1) * (2 * NCG * 1024) + ((g) >> 2) * 1024 + (((g) >> 1) & 1) * 512))
#define NEXT3(x) ((x) == 2 ? 0 : (x) + 1)
    f32x16 pA0, pA1, pB0, pB1; u32x4 pw0, pw1, pw2, pw3;
#define STEP(C0, C1, P0, P1, kso, vso) do { SBAR(); \
    const lds_cptr kp_ = kp0 + (kso); const lds_cptr vp_ = vp0 + (vso); \
    bf16x8 kf_[3]; s16x4 vl_[3], vh_[3]; float sacc = 0.f; \
    kf_[0] = KFR(kp_, 0); kf_[1] = KFR(kp_, 1); SBAR(); \
    _Pragma("unroll") for (int g = 0; g < NGA; ++g) { \
        if (g + 2 < NGA) kf_[(g + 2) % 3] = KFR(kp_, g + 2); \
        if (g == NGA - 2) { vl_[0] = vtr((int)(uintptr_t)(vp_)); vh_[0] = vtr((int)(uintptr_t)(vp_ + 512)); } \
        if (g == NGA - 1) { vl_[1] = vtr((int)(uintptr_t)(vp_ + 4096)); vh_[1] = vtr((int)(uintptr_t)(vp_ + 4096 + 512)); } \
        SBAR(); \
        if ((g & 1) == 0) C0 = __builtin_amdgcn_mfma_f32_32x32x16_bf16(kf_[g % 3], qr[g >> 1], (g < 2) ? negm : C0, 0, 0, 0); \
        else              C1 = __builtin_amdgcn_mfma_f32_32x32x16_bf16(kf_[g % 3], qr[g >> 1], (g < 2) ? negm : C1, 0, 0, 0); \
        _Pragma("unroll") for (int a_ = 0; a_ < NADD; ++a_) { const int v_ = g * NADD + a_; sacc += (v_ < 16) ? P0[v_ & 15] : P1[v_ & 15]; } \
        PIN(sacc); \
        _Pragma("unroll") for (int k_ = 0; k_ < NPK; ++k_) { const int w_ = g * NPK + k_; const int e_ = (2 * w_) & 15; const unsigned pk_ = (w_ < 8) ? cvtpk_s(P0[e_], P0[e_ + 1]) : cvtpk_s(P1[e_], P1[e_ + 1]); \
            if ((w_ >> 2) == 0) pw0[w_ & 3] = pk_; else if ((w_ >> 2) == 1) pw1[w_ & 3] = pk_; else if ((w_ >> 2) == 2) pw2[w_ & 3] = pk_; else pw3[w_ & 3] = pk_; } \
        PIN(pw0); PIN(pw1); PIN(pw2); PIN(pw3); SBAR(); } \
    l_reg += sacc; \
    _Pragma("unroll") for (int g = 0; g < 16; ++g) { \
        if (g + 2 < 16) { const int g2 = g + 2; vl_[g2 % 3] = vtr((int)(uintptr_t)(vp_ + (g2 & 3) * 4096 + (g2 >> 2) * 1024)); vh_[g2 % 3] = vtr((int)(uintptr_t)(vp_ + (g2 & 3) * 4096 + (g2 >> 2) * 1024 + 512)); } \
        SBAR(); \
        { const s16x4 l_ = vl_[g % 3], h_ = vh_[g % 3]; const bf16x8 vf_ = (bf16x8){l_[0], l_[1], l_[2], l_[3], h_[0], h_[1], h_[2], h_[3]}; \
          const bf16x8 pa_ = __builtin_bit_cast(bf16x8, (g >> 2) == 0 ? pw0 : ((g >> 2) == 1 ? pw1 : ((g >> 2) == 2 ? pw2 : pw3))); \
          o[g & 3] = __builtin_amdgcn_mfma_f32_32x32x16_bf16(pa_, vf_, o[g & 3], 0, 0, 0); } \
        if (g < 8) { C0[2 * g] = __builtin_amdgcn_exp2f(C0[2 * g]); C0[2 * g + 1] = __builtin_amdgcn_exp2f(C0[2 * g + 1]); PIN(C0); } \
        else { C1[2 * g - 16] = __builtin_amdgcn_exp2f(C1[2 * g - 16]); C1[2 * g - 15] = __builtin_amdgcn_exp2f(C1[2 * g - 15]); PIN(C1); } \
        SBAR(); } \
    } while (0)
    DMA_K(0, 0); DMA_K(1, 1); DMA_V(0, 0);
    WAIT_BAR_0();
    DMA_K(2, 2); DMA_V(1, 1);
    { const lds_cptr kp_ = kp0;
#pragma unroll
      for (int g = 0; g < NGA; ++g) { const bf16x8 kf = KFR(kp_, g);
          if ((g & 1) == 0) pA0 = __builtin_amdgcn_mfma_f32_32x32x16_bf16(kf, qr[g >> 1], (g < 2) ? negm : pA0, 0, 0, 0);
          else              pA1 = __builtin_amdgcn_mfma_f32_32x32x16_bf16(kf, qr[g >> 1], (g < 2) ? negm : pA1, 0, 0, 0); } }
    exp_half(pA0); exp_half(pA1);
    WAIT_BAR_N();
    int ks = 1, vs = 0;
    for (int t = 1; t + 1 < NT; t += 2) {
        { const int kd = ks == 0 ? 2 : ks - 1, vd = vs == 0 ? 2 : vs - 1; DMA_K(t + 2, kd); DMA_V(t + 1, vd); }
        STEP(pB0, pB1, pA0, pA1, ks * SHM_K, vs * SHM_V); WAIT_BAR_N(); ks = NEXT3(ks); vs = NEXT3(vs);
        { const int kd = ks == 0 ? 2 : ks - 1, vd = vs == 0 ? 2 : vs - 1; DMA_K(t + 3, kd); DMA_V(t + 2, vd); }
        STEP(pA0, pA1, pB0, pB1, ks * SHM_K, vs * SHM_V); WAIT_BAR_N(); ks = NEXT3(ks); vs = NEXT3(vs);
    }
    STEP(pB0, pB1, pA0, pA1, ks * SHM_K, vs * SHM_V); WAIT_BAR_0(); vs = NEXT3(vs);
    { float sacc = 0.f;
#pragma unroll
      for (int r = 0; r < 16; ++r) sacc += pB0[r];
#pragma unroll
      for (int r = 0; r < 16; ++r) sacc += pB1[r];
      l_reg += sacc;
      pw0 = (u32x4){cvtpk_s(pB0[0], pB0[1]), cvtpk_s(pB0[2], pB0[3]), cvtpk_s(pB0[4], pB0[5]), cvtpk_s(pB0[6], pB0[7])};
      pw1 = (u32x4){cvtpk_s(pB0[8], pB0[9]), cvtpk_s(pB0[10], pB0[11]), cvtpk_s(pB0[12], pB0[13]), cvtpk_s(pB0[14], pB0[15])};
      pw2 = (u32x4){cvtpk_s(pB1[0], pB1[1]), cvtpk_s(pB1[2], pB1[3]), cvtpk_s(pB1[4], pB1[5]), cvtpk_s(pB1[6], pB1[7])};
      pw3 = (u32x4){cvtpk_s(pB1[8], pB1[9]), cvtpk_s(pB1[10], pB1[11]), cvtpk_s(pB1[12], pB1[13]), cvtpk_s(pB1[14], pB1[15])};
      const lds_cptr vp_ = vp0 + vs * SHM_V;
#pragma unroll
      for (int g = 0; g < 16; ++g) { const s16x4 l_ = vtr((int)(uintptr_t)(vp_ + (g & 3) * 4096 + (g >> 2) * 1024)), h_ = vtr((int)(uintptr_t)(vp_ + (g & 3) * 4096 + (g >> 2) * 1024 + 512));
          const bf16x8 vf_ = (bf16x8){l_[0], l_[1], l_[2], l_[3], h_[0], h_[1], h_[2], h_[3]};
          const bf16x8 pa_ = __builtin_bit_cast(bf16x8, (g >> 2) == 0 ? pw0 : ((g >> 2) == 1 ? pw1 : ((g >> 2) == 2 ? pw2 : pw3)));
          o[g & 3] = __builtin_amdgcn_mfma_f32_32x32x16_bf16(pa_, vf_, o[g & 3], 0, 0, 0); } }
    { auto rr = __builtin_amdgcn_permlane32_swap(__float_as_uint(l_reg), __float_as_uint(l_reg), false, false); l_reg = __uint_as_float(rr[0]) + __uint_as_float(rr[1]); }
    if (hi == 0) li_l[r32] = l_reg; asm volatile("s_waitcnt lgkmcnt(0)" ::: "memory");
#pragma unroll
    for (int r = 0; r < 16; ++r) { const float rl = __builtin_amdgcn_rcpf(li_l[crow(r, hi)]);
#pragma unroll
        for (int d = 0; d < 4; ++d) o[d][r] *= rl; }
    __syncthreads();
#undef DMA_K
#undef DMA_V
#undef WAIT_BAR_N
#undef WAIT_BAR_0
#undef PIN
#undef KFR
#undef NEXT3
#undef STEP
}

typedef int i32x8 __attribute__((ext_vector_type(8)));
constexpr int F8_KRING = 0, F8_VRING = 4 * 8192, F8_SCR = 8 * 8192, F8_Q = 8 * 8192 + 2048;
constexpr float THR8 = 8.f;
__device__ __forceinline__ unsigned f8x4u(float a, float b, float c, float d) {
    int p = __builtin_amdgcn_cvt_pk_fp8_f32(a, b, 0, false); p = __builtin_amdgcn_cvt_pk_fp8_f32(c, d, p, true); return (unsigned)p; }
__device__ __forceinline__ void f8x8u(float a0, float a1, float a2, float a3, float b0, float b1, float b2, float b3, int& pa, int& pb) {
    asm volatile("v_cvt_pk_fp8_f32 %0, %2, %3\n\tv_cvt_pk_fp8_f32 %1, %6, %7\n\tv_cvt_pk_fp8_f32 %0, %4, %5 op_sel:[0,0,1]\n\tv_cvt_pk_fp8_f32 %1, %8, %9 op_sel:[0,0,1]\n\ts_nop 0"
                 : "=&v"(pa), "=&v"(pb) : "v"(a0), "v"(a1), "v"(a2), "v"(a3), "v"(b0), "v"(b1), "v"(b2), "v"(b3)); }
__device__ __forceinline__ float cl448(float x) { return __builtin_amdgcn_fmed3f(x, -448.f, 448.f); }
__device__ __forceinline__ unsigned f8x4(float a, float b, float c, float d) { return f8x4u(cl448(a), cl448(b), cl448(c), cl448(d)); }
template <int DQK> __device__ __forceinline__ int kimg_off(int key, int d) { const int g = (DQK == 128) ? ((key >> 1) & 7) : ((key >> 2) & 3); return key * DQK + ((((d >> 4) ^ g)) << 4) + (d & 15); }
__device__ __forceinline__ int vimg_off(int n, int j) { return n * 64 + ((((j >> 4) ^ ((n >> 2) & 3))) << 4) + (j & 15); }
__device__ __forceinline__ int kap(int h, int e) { return e < 16 ? crow(e, h) : 32 + crow(e - 16, h); }
template <int DQK>
__device__ __forceinline__ void attn_core_f8(const int tid, const bf16_t* Qb, int ldq, const unsigned char* Kimg, const unsigned char* Vimg, int seq, LAS unsigned char* ldsl, f32x16 (&o)[4],
                                             const float* qgain, const float* ropeT, int tpos0, float kmaxC) {
    constexpr int NQF = DQK / 16, NKS = DQK / 64, KTB = 64 * DQK, NKP = KTB / 1024;
    constexpr float SCALE = (DQK == 128) ? 0.088388347648318440f : 0.125f;
    constexpr float C = SCALE * LOG2E;
    typedef const LAS char* lds_cptr;
    const int wid = __builtin_amdgcn_readfirstlane(tid >> 6), lane = tid & 63, r32 = lane & 31, hi = lane >> 5;
    char* lds = (char*)(unsigned char*)ldsl; const unsigned ldsb = (unsigned)(uintptr_t)ldsl;
    float l_reg = 0.f;
#pragma unroll
    for (int d = 0; d < 4; ++d) o[d] = f32x16{};
    i32x8 qf[NKS]; float qn2;
    { float x[NQF][8];
      qn2 = prep_q_x<DQK>(x, Qb + (long)(wid * QBLK + r32) * ldq + hi * 8, qgain, ropeT, tpos0 >= 0 ? tpos0 + wid * QBLK + r32 : -1, hi);
#pragma unroll
      for (int ks = 0; ks < NKS; ++ks)
#pragma unroll
          for (int i = 0; i < 2; ++i) { const int da = 4 * ks + i, db = 4 * ks + 2 + i;
              unsigned a0 = f8x4(x[da][0] * C, x[da][1] * C, x[da][2] * C, x[da][3] * C), a1 = f8x4(x[da][4] * C, x[da][5] * C, x[da][6] * C, x[da][7] * C);
              unsigned b0 = f8x4(x[db][0] * C, x[db][1] * C, x[db][2] * C, x[db][3] * C), b1 = f8x4(x[db][4] * C, x[db][5] * C, x[db][6] * C, x[db][7] * C);
              auto r0 = __builtin_amdgcn_permlane32_swap(a0, b0, false, false); auto r1 = __builtin_amdgcn_permlane32_swap(a1, b1, false, false);
              qf[ks][4 * i + 0] = (int)r0[0]; qf[ks][4 * i + 1] = (int)r1[0]; qf[ks][4 * i + 2] = (int)r0[1]; qf[ks][4 * i + 3] = (int)r1[1]; } }
    const int gk = (DQK == 128) ? ((r32 >> 1) & 7) : ((r32 >> 2) & 3), gv = (r32 >> 2) & 3;
    int kc2[2], vco[2];
#pragma unroll
    for (int i = 0; i < 2; ++i) kc2[i] = (((2 * hi + i) ^ gk) << 4);
#define kco(i) (((i) >> 1) ? (kc2[(i) & 1] ^ 64) : kc2[(i) & 1])
#pragma unroll
    for (int i = 0; i < 2; ++i) vco[i] = (((2 * hi + i) ^ gv) << 4);
    const lds_cptr qp0 = (lds_cptr)ldsl + F8_Q + wid * 4096 + r32 * DQK;
#pragma unroll
    for (int ks = 0; ks < NKS; ++ks) { *(LAS u32x4*)(qp0 + kco(2 * ks)) = (u32x4){(unsigned)qf[ks][0], (unsigned)qf[ks][1], (unsigned)qf[ks][2], (unsigned)qf[ks][3]};
        *(LAS u32x4*)(qp0 + kco(2 * ks + 1)) = (u32x4){(unsigned)qf[ks][4], (unsigned)qf[ks][5], (unsigned)qf[ks][6], (unsigned)qf[ks][7]}; }
    asm volatile("s_waitcnt lgkmcnt(0)" ::: "memory");
    const lds_cptr kp0 = (lds_cptr)ldsl + F8_KRING + r32 * DQK;
    const lds_cptr vp0 = (lds_cptr)ldsl + F8_VRING + r32 * 64;
    const int NT = seq / KVBLK;
    const unsigned char* kimgw = Kimg + (wid % NKP) * 1024; const unsigned char* vimgw = Vimg + wid * 1024;
#define ksrc (kimgw + (unsigned)(lane * 16))
#define vsrc (vimgw + (unsigned)(lane * 16))
#define DMA8(t, kslot, vslot) do { const int _t = (t) < NT ? (t) : NT - 1; \
    glds16(ksrc + (size_t)_t * KTB, (unsigned)__builtin_amdgcn_readfirstlane((int)(ldsb + F8_KRING + (kslot) * 8192 + (wid % NKP) * 1024))); \
    glds16(vsrc + (size_t)_t * 8192, (unsigned)__builtin_amdgcn_readfirstlane((int)(ldsb + F8_VRING + (vslot) * 8192 + wid * 1024))); } while (0)
#define DMA8K(t, kslot) do { const int _t = (t) < NT ? (t) : NT - 1; glds16(ksrc + (size_t)_t * KTB, (unsigned)__builtin_amdgcn_readfirstlane((int)(ldsb + F8_KRING + (kslot) * 8192 + (wid % NKP) * 1024))); } while (0)
#define WB8(n) do { asm volatile("s_waitcnt vmcnt(" #n ") lgkmcnt(0)\n\ts_barrier" ::: "memory"); SBAR(); } while (0)
#define QKT8(C0, C1, kso) do { const lds_cptr kp_ = kp0 + (kso); \
    _Pragma("unroll") for (int ks = 0; ks < NKS; ++ks) { \
        const u32x4 a0 = *(const LAS u32x4*)(kp_ + kco(2 * ks)), a1 = *(const LAS u32x4*)(kp_ + kco(2 * ks + 1)); \
        const u32x4 b0 = *(const LAS u32x4*)(kp_ + 32 * DQK + kco(2 * ks)), b1 = *(const LAS u32x4*)(kp_ + 32 * DQK + kco(2 * ks + 1)); \
        const i32x8 ka = {(int)a0[0], (int)a0[1], (int)a0[2], (int)a0[3], (int)a1[0], (int)a1[1], (int)a1[2], (int)a1[3]}; \
        const i32x8 kb = {(int)b0[0], (int)b0[1], (int)b0[2], (int)b0[3], (int)b1[0], (int)b1[1], (int)b1[2], (int)b1[3]}; \
        const u32x4 q0 = *(const LAS u32x4*)(qp0 + kco(2 * ks)), q1 = *(const LAS u32x4*)(qp0 + kco(2 * ks + 1)); \
        const i32x8 qq = {(int)q0[0], (int)q0[1], (int)q0[2], (int)q0[3], (int)q1[0], (int)q1[1], (int)q1[2], (int)q1[3]}; \
        C0 = __builtin_amdgcn_mfma_scale_f32_32x32x64_f8f6f4(ka, qq, ks == 0 ? negm : C0, 0, 0, 0, 0, 0, 0); \
        C1 = __builtin_amdgcn_mfma_scale_f32_32x32x64_f8f6f4(kb, qq, ks == 0 ? negm : C1, 0, 0, 0, 0, 0, 0); SBAR(); } } while (0)
#define PV8(vso) do { const lds_cptr vp_ = vp0 + (vso); \
    _Pragma("unroll") for (int d = 0; d < 4; ++d) { const u32x4 v0 = *(const LAS u32x4*)(vp_ + d * 2048 + vco[0]), v1 = *(const LAS u32x4*)(vp_ + d * 2048 + vco[1]); \
        const i32x8 vf = {(int)v0[0], (int)v0[1], (int)v0[2], (int)v0[3], (int)v1[0], (int)v1[1], (int)v1[2], (int)v1[3]}; \
        o[d] = __builtin_amdgcn_mfma_scale_f32_32x32x64_f8f6f4(pw, vf, o[d], 0, 0, 0, 0, 0, 0); } } while (0)
#define PART8(P0, P1, AL) do { float pm = P0[0]; \
    _Pragma("unroll") for (int r = 1; r < 16; ++r) pm = fmaxf(pm, P0[r]); \
    _Pragma("unroll") for (int r = 0; r < 16; ++r) pm = fmaxf(pm, P1[r]); \
    { auto rr = __builtin_amdgcn_permlane32_swap(__float_as_uint(pm), __float_as_uint(pm), false, false); pm = fmaxf(__uint_as_float(rr[0]), __uint_as_float(rr[1])); } \
    AL = 1.f; \
    if (!__builtin_expect(__all(pm <= THR8), 1)) { const float dl = fmaxf(pm, 0.f); AL = __builtin_amdgcn_exp2f(-dl); \
        _Pragma("unroll") for (int r = 0; r < 16; ++r) { P0[r] -= dl; P1[r] -= dl; negm[r] -= dl; } } \
    _Pragma("unroll") for (int r = 0; r < 16; ++r) P0[r] = __builtin_amdgcn_exp2f(P0[r]); } while (0)
#define FIN8(P0, P1, AL) do { \
    _Pragma("unroll") for (int r = 0; r < 16; ++r) P1[r] = __builtin_amdgcn_exp2f(P1[r]); \
    float ps = 0.f; \
    _Pragma("unroll") for (int r = 0; r < 16; ++r) ps += P0[r]; \
    _Pragma("unroll") for (int r = 0; r < 16; ++r) ps += P1[r]; \
    l_reg = l_reg * AL + ps; \
    _Pragma("unroll") for (int v = 0; v < 4; ++v) { pw[v] = (int)f8x4u(P0[4 * v], P0[4 * v + 1], P0[4 * v + 2], P0[4 * v + 3]); pw[4 + v] = (int)f8x4u(P1[4 * v], P1[4 * v + 1], P1[4 * v + 2], P1[4 * v + 3]); } } while (0)
#define RESC8(a) do { if (__any((a) < 1.f)) { int t2 = tid; asm volatile("" : "+v"(t2)); const int h2 = (t2 >> 5) & 1, r2 = t2 & 31; float* al2 = (float*)(lds + F8_SCR) + (t2 >> 6) * 64 + 32;   \
    if (h2 == 0) al2[r2] = (a); asm volatile("s_waitcnt lgkmcnt(0)" ::: "memory"); \
    _Pragma("unroll") for (int d = 0; d < 4; ++d) _Pragma("unroll") for (int r = 0; r < 16; ++r) o[d][r] *= al2[crow(r, h2)]; } } while (0)
#define NEXT3(x) ((x) == 2 ? 0 : (x) + 1)
    f32x16 pA0, pA1, pB0, pB1, negm = f32x16{}; float alA = 1.f, alB = 1.f; i32x8 pw;
    DMA8(0, 0, 0); DMA8K(1, 1); DMA8K(2, 2);
    WB8(0);
    { const int tk = 3 < NT ? 3 : NT - 1, tv = 1;
      glds16(ksrc + (size_t)tk * KTB, (unsigned)__builtin_amdgcn_readfirstlane((int)(ldsb + F8_KRING + 3 * 8192 + (wid % NKP) * 1024)));
      glds16(vsrc + (size_t)tv * 8192, (unsigned)__builtin_amdgcn_readfirstlane((int)(ldsb + F8_VRING + 1 * 8192 + wid * 1024))); }
    QKT8(pA0, pA1, 0);
    { float pm = pA0[0];
#pragma unroll
      for (int r = 1; r < 16; ++r) pm = fmaxf(pm, pA0[r]);
#pragma unroll
      for (int r = 0; r < 16; ++r) pm = fmaxf(pm, pA1[r]);
      { auto rr = __builtin_amdgcn_permlane32_swap(__float_as_uint(pm), __float_as_uint(pm), false, false); pm = fmaxf(__uint_as_float(rr[0]), __uint_as_float(rr[1])); }
      pm = fmaxf(pm, sqrtf(qn2) * kmaxC * 1.1f - 100.f);
#pragma unroll
      for (int r = 0; r < 16; ++r) { pA0[r] -= pm; pA1[r] -= pm; negm[r] = -pm; }
#pragma unroll
      for (int r = 0; r < 16; ++r) pA0[r] = __builtin_amdgcn_exp2f(pA0[r]); }
#pragma unroll
    for (int r = 0; r < 16; ++r) pA1[r] = __builtin_amdgcn_exp2f(pA1[r]);
#define PIN(x) asm volatile("" : "+v"(x))
#define KF8(kp, g) ({ const u32x4 _a = *(const LAS u32x4*)((kp) + ((g) & 1) * (32 * DQK) + kco(2 * ((g) >> 1))), _b = *(const LAS u32x4*)((kp) + ((g) & 1) * (32 * DQK) + kco(2 * ((g) >> 1) + 1)); \
    (i32x8){(int)_a[0], (int)_a[1], (int)_a[2], (int)_a[3], (int)_b[0], (int)_b[1], (int)_b[2], (int)_b[3]}; })
#define QF8(ks) ({ const u32x4 _a = *(const LAS u32x4*)(qp0 + kco(2 * (ks))), _b = *(const LAS u32x4*)(qp0 + kco(2 * (ks) + 1)); \
    (i32x8){(int)_a[0], (int)_a[1], (int)_a[2], (int)_a[3], (int)_b[0], (int)_b[1], (int)_b[2], (int)_b[3]}; })
#define VF8(vp, d) ({ const u32x4 _a = *(const LAS u32x4*)((vp) + (d) * 2048 + vco[0]), _b = *(const LAS u32x4*)((vp) + (d) * 2048 + vco[1]); \
    (i32x8){(int)_a[0], (int)_a[1], (int)_a[2], (int)_a[3], (int)_b[0], (int)_b[1], (int)_b[2], (int)_b[3]}; })
    constexpr int NG = 2 * NKS, NPG = (NG == 4) ? 2 : 1, NPK = 8 / NPG;
    constexpr float LIM8 = 448.f;
    bool resc = false; float pdl = 0.f;
    i32x8 sel; { const int sv = ((lane & 15) < 2 && ((lane >> 4) & 1) == (lane & 15)) ? 0x38383838 : 0;
#pragma unroll
      for (int i = 0; i < 8; ++i) sel[i] = sv; }
    f32x4 lacc = {0.f, 0.f, 0.f, 0.f}, srs;
#define PACK8(P0, P1, w_) do { const int e_ = (4 * (w_)) & 15; int pa_, pb_; \
    if ((w_) < 4) f8x8u(P0[e_], P0[e_ + 1], P0[e_ + 2], P0[e_ + 3], P0[e_ + 4], P0[e_ + 5], P0[e_ + 6], P0[e_ + 7], pa_, pb_); \
    else          f8x8u(P1[e_], P1[e_ + 1], P1[e_ + 2], P1[e_ + 3], P1[e_ + 4], P1[e_ + 5], P1[e_ + 6], P1[e_ + 7], pa_, pb_); \
    pw[w_] = pa_; pw[(w_) + 1] = pb_; } while (0)
#define RSUM8() srs = __builtin_amdgcn_mfma_scale_f32_16x16x128_f8f6f4(pw, sel, (f32x4){0.f, 0.f, 0.f, 0.f}, 0, 0, 0, 0, 0, 0)
#define MOVE9(P0, P1) do { float sacc = 0.f; \
    _Pragma("unroll") for (int r = 0; r < 16; ++r) sacc += P0[r]; \
    _Pragma("unroll") for (int r = 0; r < 16; ++r) sacc += P1[r]; \
    float srow; { auto rr = __builtin_amdgcn_permlane32_swap(__float_as_uint(sacc), __float_as_uint(sacc), false, false); srow = __uint_as_float(rr[0]) + __uint_as_float(rr[1]); } \
    pdl = fmaxf(__builtin_ceilf(__builtin_amdgcn_logf(srow)) - 6.f, 0.f); const float f_ = __builtin_amdgcn_exp2f(-pdl); \
    _Pragma("unroll") for (int r = 0; r < 16; ++r) { P0[r] *= f_; P1[r] *= f_; negm[r] -= pdl; } \
    { int t2 = tid; asm volatile("" : "+v"(t2)); float* al2 = (float*)(lds + F8_SCR) + (t2 >> 6) * 64 + 32; if (((t2 >> 5) & 1) == 0) al2[t2 & 31] = f_; asm volatile("s_waitcnt lgkmcnt(0)" ::: "memory"); \
      const int q0 = 16 * (t2 & 1) + 4 * ((t2 >> 4) & 3); \
      _Pragma("unroll") for (int r = 0; r < 4; ++r) lacc[r] *= al2[q0 + r]; } \
    _Pragma("unroll") for (int w_ = 0; w_ < 8; w_ += 2) PACK8(P0, P1, w_); \
    RSUM8(); resc = true; } while (0)
#define MOVE9B(C0, C1) do { int t2 = tid; asm volatile("" : "+v"(t2)); const int h2 = (t2 >> 5) & 1; const float* al2 = (const float*)(lds + F8_SCR) + (t2 >> 6) * 64 + 32; asm volatile("s_waitcnt lgkmcnt(0)" ::: "memory"); \
    _Pragma("unroll") for (int r = 0; r < 16; ++r) { C0[r] -= pdl; C1[r] -= pdl; } \
    _Pragma("unroll") for (int d = 0; d < 4; ++d) _Pragma("unroll") for (int r = 0; r < 16; ++r) o[d][r] *= al2[crow(r, h2)]; resc = false; } while (0)
#define TEST9(P0, P1) do { const float mx_ = (srs[0] + srs[1]) + (srs[2] + srs[3]);     \
    if (__builtin_expect(__any(!(mx_ < LIM8)), 0)) MOVE9(P0, P1); \
    lacc += srs; } while (0)
#define DMAK_(tk_, kd_) do { const int tk = (tk_) < NT ? (tk_) : NT - 1; glds16(ksrc + (size_t)tk * KTB, (unsigned)__builtin_amdgcn_readfirstlane((int)(ldsb + F8_KRING + (kd_) * 8192 + (wid % NKP) * 1024))); } while (0)
#define DMAV_(tv_, vd_) do { const int tv = (tv_) < NT ? (tv_) : NT - 1; glds16(vsrc + (size_t)tv * 8192, (unsigned)__builtin_amdgcn_readfirstlane((int)(ldsb + F8_VRING + (vd_) * 8192 + wid * 1024))); } while (0)
#define STEP8(C0, C1, P0, P1, kso, vso, knext, tk_, kd_, tv_, vd_) do { SBAR(); \
    const lds_cptr kp_ = kp0 + (kso); const lds_cptr vp_ = vp0 + (vso); \
    i32x8 vf_[2]; \
      \
    C0 = __builtin_amdgcn_mfma_scale_f32_32x32x64_f8f6f4(kc0_, qc0_, negm, 0, 0, 0, 0, 0, 0); SBAR(); \
    if (NG == 4) { kc0_ = KF8(kp_, 2); } else { vf_[0] = VF8(vp_, 0); } \
    if (NG == 4) { PACK8(P0, P1, 0); PACK8(P0, P1, 2); } else { PACK8(P0, P1, 0); PACK8(P0, P1, 2); PACK8(P0, P1, 4); PACK8(P0, P1, 6); SBAR(); RSUM8(); } \
    SBAR(); \
      \
    C1 = __builtin_amdgcn_mfma_scale_f32_32x32x64_f8f6f4(kc1_, qc0_, negm, 0, 0, 0, 0, 0, 0); SBAR(); \
    if (NG == 4) { kc1_ = KF8(kp_, 3); PACK8(P0, P1, 4); PACK8(P0, P1, 6); SBAR(); RSUM8(); } \
    else { DMAK_(tk_, kd_); DMAV_(tv_, vd_); SBAR(); TEST9(P0, P1); } \
    SBAR(); \
    if (NG == 4) { \
          \
        C0 = __builtin_amdgcn_mfma_scale_f32_32x32x64_f8f6f4(kc0_, qc1_, C0, 0, 0, 0, 0, 0, 0); SBAR(); \
        DMAK_(tk_, kd_); vf_[0] = VF8(vp_, 0); SBAR(); \
          \
        C1 = __builtin_amdgcn_mfma_scale_f32_32x32x64_f8f6f4(kc1_, qc1_, C1, 0, 0, 0, 0, 0, 0); SBAR(); \
        DMAV_(tv_, vd_); SBAR(); TEST9(P0, P1); SBAR(); } \
    if (__builtin_expect(resc, 0)) MOVE9B(C0, C1); \
    SBAR(); \
    _Pragma("unroll") for (int d = 0; d < 4; ++d) { \
        if (d + 1 < 4) vf_[(d + 1) & 1] = VF8(vp_, d + 1); \
        if (d == 3) { const lds_cptr kn_ = kp0 + (knext); kc0_ = KF8(kn_, 0); kc1_ = KF8(kn_, 1); }     \
        SBAR(); \
        o[d] = __builtin_amdgcn_mfma_scale_f32_32x32x64_f8f6f4(pw, vf_[d & 1], o[d], 0, 0, 0, 0, 0, 0); \
        if (d < 2) { _Pragma("unroll") for (int e_ = 0; e_ < 8; ++e_) C0[8 * d + e_] = __builtin_amdgcn_exp2f(C0[8 * d + e_]); PIN(C0); } \
        else       { _Pragma("unroll") for (int e_ = 0; e_ < 8; ++e_) C1[8 * (d - 2) + e_] = __builtin_amdgcn_exp2f(C1[8 * (d - 2) + e_]); PIN(C1); } \
        SBAR(); } \
    } while (0)
    i32x8 kc0_, kc1_, qc0_, qc1_;
    { const lds_cptr kn_ = kp0 + 1 * 8192; kc0_ = KF8(kn_, 0); qc0_ = QF8(0); kc1_ = KF8(kn_, 1); if (NG == 4) qc1_ = QF8(1); else qc1_ = qc0_; }
    WB8(2);
#define STEPQ(C0, C1, P0, P1, t_, q_) STEP8(C0, C1, P0, P1, ((q_) & 3) * 8192, (((q_) + 3) & 3) * 8192, (((q_) + 1) & 3) * 8192, (t_) + 3, ((q_) + 3) & 3, (t_) + 1, ((q_) + 1) & 3)
    int t = 1;
    for (; t + 6 < NT; t += 4) {
        STEPQ(pB0, pB1, pA0, pA1, t, 1); WB8(2);
        STEPQ(pA0, pA1, pB0, pB1, t + 1, 2); WB8(2);
        STEPQ(pB0, pB1, pA0, pA1, t + 2, 3); WB8(2);
        STEPQ(pA0, pA1, pB0, pB1, t + 3, 0); WB8(2);
    }
    STEPQ(pB0, pB1, pA0, pA1, t, 1); WB8(2);
    STEPQ(pA0, pA1, pB0, pB1, t + 1, 2); WB8(2);
    STEP8(pB0, pB1, pA0, pA1, 3 * 8192, 2 * 8192, 0 * 8192, NT, 2, NT, 0); WB8(0);
    const int vs_ = 3;
    {
#pragma unroll
      for (int w_ = 0; w_ < 8; w_ += 2) PACK8(pB0, pB1, w_);
      RSUM8();
      TEST9(pB0, pB1);
      if (resc) MOVE9B(pA0, pA1);
      PV8(vs_ * 8192); }
    { int t2 = tid; asm volatile("" : "+v"(t2)); const int h2 = (t2 >> 5) & 1; float* li2 = (float*)(lds + F8_SCR) + (t2 >> 6) * 64;
      if ((t2 & 15) < 2) { const int q0 = 16 * (t2 & 15) + 4 * ((t2 >> 4) & 3);
#pragma unroll
          for (int r = 0; r < 4; ++r) li2[q0 + r] = lacc[r]; }
      asm volatile("s_waitcnt lgkmcnt(0)" ::: "memory");
#pragma unroll
      for (int r = 0; r < 16; ++r) { const float rl = __builtin_amdgcn_rcpf(li2[crow(r, h2)]);
#pragma unroll
          for (int d = 0; d < 4; ++d) o[d][r] *= rl; } }
    __syncthreads();
#undef DMA8
#undef PIN
#undef KF8
#undef QF8
#undef VF8
#undef STEP8
#undef MOVE9
#undef MOVE9B
#undef TEST9
#undef PACK8
#undef RSUM8
#undef DMAK_
#undef DMAV_
#undef STEPQ
#undef kco
#undef ksrc
#undef vsrc
#undef DMA8K
#undef WB8
#undef QKT8
#undef PV8
#undef PART8
#undef FIN8
#undef RESC8
#undef NEXT3
}
template <int NCB> __device__ __forceinline__ void store_o_lds(const int tid, const f32x16 (&o)[NCB], bf16_t* O, int ldo, char* lds) {
    const int wid = tid >> 6, lane = tid & 63, r32 = lane & 31, hi = lane >> 5;
    constexpr int RB = NCB * 64;
    char* st = lds + wid * 8192;
#pragma unroll
    for (int r = 0; r < 16; ++r) { const int orow = crow(r, hi);
#pragma unroll
        for (int d = 0; d < NCB; ++d) *(bf16_t*)(st + orow * RB + (d * 32 + r32) * 2) = (bf16_t)(cvtpk(o[d][r], 0.f) & 0xffffu); }
    asm volatile("s_waitcnt lgkmcnt(0)" ::: "memory");
    constexpr int CPR = RB / 16;
#pragma unroll
    for (int i = 0; i < (32 * CPR) / 64; ++i) { const int c = lane + 64 * i, row = c / CPR, cc = c % CPR;
        const u32x4 v = *(const u32x4*)(st + row * RB + cc * 16);
        *(u32x4*)((char*)(O + (long)(wid * QBLK + row) * ldo) + cc * 16) = v; }
    asm volatile("s_waitcnt lgkmcnt(0)" ::: "memory");
    __syncthreads();
}
}

struct Args { const float* in[25]; float* out; unsigned char* ws; int ph_lo, ph_hi; };
enum { I_X = 0, I_C, I_CTX, I_CCTX, I_WMOD, I_BMOD, I_LNG, I_LNB, I_WINE, I_WOUTE, I_SINK, I_LQ1, I_LK1, I_LQ2, I_LK2, I_SUBG, I_WINO, I_WOUTO, I_QNG, I_KNG, I_WR, I_BR, I_WG, I_WU, I_WDN };

struct Ctx {
    LAS unsigned char* lds; LAS int* lc; int tid, lane, wave, G, c, gw, NGW;
    const GAS float* const CAS* in; unsigned char* ws;
};

#define INP(i) ((const float*)F.in[i])
__device__ __forceinline__ int lane_id() { int l; asm volatile("v_mbcnt_lo_u32_b32 %0, -1, 0\n\tv_mbcnt_hi_u32_b32 %0, -1, %0" : "=v"(l)); return l; }
__device__ __forceinline__ Ctx make_ctx(int wave_s) {
    Ctx F;
    unsigned t = (unsigned)(wave_s * 64 + lane_id()); asm volatile("" : "+v"(t));
    const CAS char* ka = (const CAS char*)__builtin_amdgcn_kernarg_segment_ptr(); asm volatile("" : "+s"(ka));
    unsigned lb = 0u; asm volatile("" : "+s"(lb));
    F.lds = (LAS unsigned char*)(uintptr_t)lb; F.lc = (LAS int*)(F.lds + LDSCTL_OFF);
    F.tid = (int)t; F.lane = F.tid & 63; F.wave = __builtin_amdgcn_readfirstlane(F.tid >> 6);
    F.G = gridDim.x; F.c = blockIdx.x; F.gw = F.c * NWAVES + F.wave; F.NGW = F.G * NWAVES;
    F.in = (const GAS float* const CAS*)ka; F.ws = (unsigned char*)*(GAS unsigned char* const CAS*)(ka + 208);
    return F;
}
__device__ __forceinline__ void p0_transpose_item(const float* W, int K, int N, bf16_t* WT, int mode, LAS float* scr, int item, int lane) {
    const int nblk = N / 32, kb = item / nblk, nb = item % nblk, k0 = 64 * kb, n0 = 32 * nb;
#pragma unroll 8
    for (int i = 0; i < 32; ++i) { const int kk = 2 * i + (lane >> 5); scr[kk * 33 + (lane & 31)] = W[(size_t)(k0 + kk) * N + n0 + (lane & 31)]; }
    LDS_WAIT(); asm volatile("" ::: "memory");
    const int cc = lane & 7;
#pragma unroll
    for (int j = 0; j < 4; ++j) { const int n = (lane >> 3) + 8 * j; const LAS float* s = scr + (8 * cc) * 33 + n;
        u32x4 o; o.x = cvt_pk_bf16(s[0 * 33], s[1 * 33]); o.y = cvt_pk_bf16(s[2 * 33], s[3 * 33]); o.z = cvt_pk_bf16(s[4 * 33], s[5 * 33]); o.w = cvt_pk_bf16(s[6 * 33], s[7 * 33]);
        const int ng = n0 + n; const int nr = (mode == 0) ? ng : ((ng >> 2) * 8 + (ng & 3) + (mode == 2 ? 4 : 0));
        *(u32x4*)(WT + (size_t)nr * K + k0 + 8 * cc) = o; }
    LDS_WAIT(); asm volatile("" ::: "memory");
}
__device__ __forceinline__ void p0_prologue(const Ctx& F) {
    unsigned char* ws = F.ws;
    for (int blk = F.c; blk < 192; blk += F.G) {
        LAS float* cs = (LAS float*)F.lds;
        for (int i = F.tid; i < 2048; i += NTHREADS) { const float v = (i < 1024) ? INP(I_C)[i] : INP(I_CCTX)[i - 1024]; cs[i] = v / (1.f + __expf(-v)); }
        __syncthreads();
        const int l = blk / 48, cb = (blk % 48) * 128, kg = F.tid >> 5, c4 = (F.tid & 31) * 4;
        const float* wp = INP(I_WMOD) + (size_t)l * DM * 6144 + (size_t)(kg * 64) * 6144 + cb + c4;
        f32x4 a0 = {0.f, 0.f, 0.f, 0.f}, a1 = {0.f, 0.f, 0.f, 0.f};
#pragma unroll 16
        for (int k = 0; k < 64; ++k) { const f32x4 w = *(const f32x4*)(wp + (size_t)k * 6144); a0 += cs[kg * 64 + k] * w; a1 += cs[1024 + kg * 64 + k] * w; }
        LAS float* red = (LAS float*)F.lds + 2048;
        *(LAS f32x4*)(red + (0 * 16 + kg) * 128 + c4) = a0; *(LAS f32x4*)(red + (1 * 16 + kg) * 128 + c4) = a1;
        __syncthreads();
        if (F.tid < 256) { const int s = F.tid >> 7, cc = F.tid & 127, col = cb + cc; float v = INP(I_BMOD)[l * 6144 + col];
#pragma unroll
            for (int g = 0; g < 16; ++g) v += red[(s * 16 + g) * 128 + cc];
            ((float*)(ws + WS_MODV))[(l * 2 + s) * 6144 + col] = v; }
        __syncthreads();
    }
    if (F.c == F.G - 1) {
        float* t64 = (float*)(ws + WS_TAB64); float* t128 = (float*)(ws + WS_TAB128);
        const float l2t = 13.287712379549449f;
        for (int i = F.tid; i < 256 * 16; i += NTHREADS) { const int pos = i >> 4, f = i & 15; const float inv = exp2f(-(float)f * (1.f / 16.f) * l2t), a = (float)pos * inv; t64[2 * i] = cosf(a); t64[2 * i + 1] = sinf(a); }
        for (int i = F.tid; i < 256 * 32; i += NTHREADS) { const int pos = i >> 5, f = i & 31; const float inv = exp2f(-(float)f * (1.f / 32.f) * l2t), a = (float)pos * inv; t128[2 * i] = cosf(a); t128[2 * i + 1] = sinf(a); }
        if (F.tid < 2) { const int i = F.tid; float s1 = 0.f, s2 = 0.f;
            for (int k = 0; k < 64; ++k) { s1 += INP(I_LQ1)[i * 64 + k] * INP(I_LK1)[i * 64 + k]; s2 += INP(I_LQ2)[i * 64 + k] * INP(I_LK2)[i * 64 + k]; }
            const float lam_init = 0.8f - 0.6f * expf(-0.3f * (float)(2 * i));
            ((float*)(ws + WS_LAM))[i] = expf(s1) - expf(s2) + lam_init; }
    }
    LAS float* scr = (LAS float*)(F.lds + 32768 + F.wave * 8704);
    constexpr int I_INE = 16 * 72, I_INO = 16 * 48, I_OUT = 16 * 32, I_GU = 16 * 16, I_DN = 8 * 32;
    constexpr int N_A = 2 * I_INE, N_B = 2 * I_INO, N_C = 4 * I_OUT, N_D = 64 * I_GU, N_E = 64 * I_GU, N_F = 64 * I_DN;
    constexpr int NITEMS = N_A + N_B + N_C + N_D + N_E + N_F;
    for (int it = F.gw; it < NITEMS; it += F.NGW) {
        int r = it;
        if (r < N_A) { const int i = r / I_INE; p0_transpose_item(INP(I_WINE) + (size_t)i * DM * EVEN_IN, DM, EVEN_IN, (bf16_t*)(ws + WS_WINE) + (size_t)i * EVEN_IN * DM, 0, scr, r % I_INE, F.lane); continue; } r -= N_A;
        if (r < N_B) { const int i = r / I_INO; p0_transpose_item(INP(I_WINO) + (size_t)i * DM * ODD_IN, DM, ODD_IN, (bf16_t*)(ws + WS_WINO) + (size_t)i * ODD_IN * DM, 0, scr, r % I_INO, F.lane); continue; } r -= N_B;
        if (r < N_C) { const int l = r / I_OUT; const float* src = ((l & 1) ? INP(I_WOUTO) : INP(I_WOUTE)) + (size_t)(l >> 1) * DM * DM;
            p0_transpose_item(src, DM, DM, (bf16_t*)(ws + WS_WOUT) + (size_t)l * DM * DM, 0, scr, r % I_OUT, F.lane); continue; } r -= N_C;
        if (r < N_D) { const int m = r / I_GU; p0_transpose_item(INP(I_WG) + (size_t)m * DM * DEXP, DM, DEXP, (bf16_t*)(ws + WS_WGU) + (size_t)m * 1024 * DM, 1, scr, r % I_GU, F.lane); continue; } r -= N_D;
        if (r < N_E) { const int m = r / I_GU; p0_transpose_item(INP(I_WU) + (size_t)m * DM * DEXP, DM, DEXP, (bf16_t*)(ws + WS_WGU) + (size_t)m * 1024 * DM, 2, scr, r % I_GU, F.lane); continue; } r -= N_E;
        { const int m = r / I_DN; p0_transpose_item(INP(I_WDN) + (size_t)m * DEXP * DM, DEXP, DM, (bf16_t*)(ws + WS_WD) + (size_t)m * DM * DEXP, 0, scr, r % I_DN, F.lane); }
    }
}

__device__ __forceinline__ void load_tstart(const Ctx& F, int l) {
    if (F.tid == 0) { unsigned* cw = (unsigned*)(F.ws + WS_CTL) + CW_CNT + l * 16 * 64; int acc = 0;
        for (int e = 0; e < 16; ++e) { const int n = (int)__hip_atomic_load(cw + e * 64, RLX_AGENT); F.lc[LC_ECNT + e] = n; F.lc[LC_TSTART + e] = acc; acc += (n + 255) >> 8; }
        F.lc[LC_TSTART + 16] = acc; }
    __syncthreads();
}

__device__ __forceinline__ void phase_a(const Ctx& F, int l, float* out) {
    unsigned char* ws = F.ws;
    float* XB = (float*)(ws + WS_XB); const float* X1B = (const float*)(ws + WS_X1B); bf16_t* HB = (bf16_t*)(ws + WS_HB);
    const bf16_t* MO = (const bf16_t*)(ws + WS_QKV); const i32x4* ROUTE = (const i32x4*)(ws + WS_ROUTE); const float* MODV = (const float*)(ws + WS_MODV);
    if (l > 0) load_tstart(F, l - 1);
    const int row_lo = (l == 4) ? NCTX : 0;
    for (int row = row_lo + F.gw; row < MROWS; row += F.NGW) {
        const int isctx = row < NCTX ? 1 : 0;
        f32x4 v[4];
        if (l == 0) {
            const float* src = isctx ? INP(I_CTX) + (size_t)row * DM : INP(I_X) + (size_t)(row - NCTX) * DM;
#pragma unroll
            for (int j = 0; j < 4; ++j) v[j] = *(const f32x4*)(src + 4 * F.lane + 256 * j);
        } else {
            const float* mp = MODV + ((l - 1) * 2 + isctx) * 6144;
            const i32x4 rt = ROUTE[row];
            const int e0 = rt.x >> 15, e1 = rt.y >> 15; const float w0 = __int_as_float(rt.z), w1 = __int_as_float(rt.w);
            const bf16_t* m0 = MO + (size_t)(F.lc[LC_TSTART + e0] * 256 + (rt.x & 32767)) * DM; const bf16_t* m1 = MO + (size_t)(F.lc[LC_TSTART + e1] * 256 + (rt.y & 32767)) * DM;
            float s = 0.f;
#pragma unroll
            for (int j = 0; j < 4; ++j) { const int col = 4 * F.lane + 256 * j;
                const f32x4 x1 = *(const f32x4*)(X1B + (size_t)row * DM + col); const f32x4 g2 = *(const f32x4*)(mp + 5120 + col);
                const u32x2 a = *(const u32x2*)(m0 + col), b = *(const u32x2*)(m1 + col);
                f32x4 mo; mo.x = w0 * bf_lo(a.x) + w1 * bf_lo(b.x); mo.y = w0 * bf_hi(a.x) + w1 * bf_hi(b.x); mo.z = w0 * bf_lo(a.y) + w1 * bf_lo(b.y); mo.w = w0 * bf_hi(a.y) + w1 * bf_hi(b.y);
                v[j] = ALPHA * x1 + g2 * mo; s += (v[j].x + v[j].y) + (v[j].z + v[j].w); }
            const float mean = wave_sum(s) * (1.f / DM); float s2 = 0.f;
#pragma unroll
            for (int j = 0; j < 4; ++j) { v[j] = v[j] - mean; s2 += (v[j].x * v[j].x + v[j].y * v[j].y) + (v[j].z * v[j].z + v[j].w * v[j].w); }
            const float rstd = 1.f / sqrtf(wave_sum(s2) * (1.f / DM) + LN_EPS);
#pragma unroll
            for (int j = 0; j < 4; ++j) { const int col = 4 * F.lane + 256 * j;
                const f32x4 g = *(const f32x4*)(INP(I_LNG) + ((l - 1) * 2 + 1) * DM + col), b = *(const f32x4*)(INP(I_LNB) + ((l - 1) * 2 + 1) * DM + col);
                v[j] = v[j] * rstd * g + b; }
        }
        if (l == 4) {
#pragma unroll
            for (int j = 0; j < 4; ++j) *(f32x4*)(out + (size_t)(row - NCTX) * DM + 4 * F.lane + 256 * j) = v[j];
        } else {
            const float* mq = MODV + (l * 2 + isctx) * 6144;
#pragma unroll
            for (int j = 0; j < 4; ++j) { const int col = 4 * F.lane + 256 * j;
                *(f32x4*)(XB + (size_t)row * DM + col) = v[j];
                const f32x4 sh = *(const f32x4*)(mq + col), sc = *(const f32x4*)(mq + 1024 + col);
                const f32x4 h = v[j] * (1.f + sc) + sh;
                u32x2 w; w.x = cvt_pk_bf16(h.x, h.y); w.y = cvt_pk_bf16(h.z, h.w);
                *(u32x2*)(HB + (size_t)row * DM + col) = w; }
        }
    }
}

__device__ __forceinline__ void kmax_begin(const Ctx& F) { if (F.tid < 16) F.lc[LC_KMAX + F.tid] = 0; __syncthreads(); }
__device__ __forceinline__ void kmax_end(const Ctx& F, int l, int nheads) {
    __syncthreads();
    if (F.tid < nheads) { const unsigned v = (unsigned)F.lc[LC_KMAX + F.tid]; if (v) atomicMax((unsigned*)(F.ws + WS_CTL) + CW_KMAX + (l * 16 + F.tid) * 64, v); }
}
__device__ __forceinline__ void rope8(u32x4& a, u32x4& b, const float* T) {
    unsigned* pa = (unsigned*)&a; unsigned* pb = (unsigned*)&b;
#pragma unroll
    for (int j = 0; j < 4; ++j) { const f32x4 cs = *(const f32x4*)(T + 4 * j);
        const float x10 = bf_lo(pa[j]), x11 = bf_hi(pa[j]), x20 = bf_lo(pb[j]), x21 = bf_hi(pb[j]);
        pa[j] = cvt_pk_bf16(x10 * cs.x - x20 * cs.y, x11 * cs.z - x21 * cs.w);
        pb[j] = cvt_pk_bf16(x10 * cs.y + x20 * cs.x, x11 * cs.w + x21 * cs.z); }
}
__device__ __forceinline__ float ss8(const u32x4& a) {
    const unsigned* p = (const unsigned*)&a; float s = 0.f;
#pragma unroll
    for (int j = 0; j < 4; ++j) { const float lo = bf_lo(p[j]), hi = bf_hi(p[j]); s = fmaf(lo, lo, s); s = fmaf(hi, hi, s); }
    return s;
}
__device__ __forceinline__ u32x2 pk8(const u32x4& a) {
    u32x2 w; w.x = att::f8x4(bf_lo(a.x), bf_hi(a.x), bf_lo(a.y), bf_hi(a.y)); w.y = att::f8x4(bf_lo(a.z), bf_hi(a.z), bf_lo(a.w), bf_hi(a.w)); return w; }
__device__ __forceinline__ void vimg_build(const Ctx& F, const bf16_t* QKV, int ld, int col0, int nheads) {
    unsigned char* VF8 = F.ws + WS_VF8;
    for (int it = F.gw; it < nheads * NTILE; it += F.NGW) {
        const int h = it / NTILE, tile = it - h * NTILE;
        unsigned char* img = VF8 + (size_t)it * 8192;
#pragma unroll 1
        for (int pass = 0; pass < 2; ++pass) { const int n = pass * 64 + F.lane;
            const bf16_t* src = QKV + (size_t)(tile * 64) * ld + col0 + h * 128 + n;
            float v[64];
#pragma unroll
            for (int k = 0; k < 64; ++k) v[k] = __uint_as_float(((unsigned)src[(size_t)k * ld]) << 16);
#pragma unroll
            for (int c = 0; c < 4; ++c) { u32x4 w;
#pragma unroll
                for (int d = 0; d < 4; ++d) { const int j = 16 * c + 4 * d, hh = j >> 5, e = j & 31;
                    w[d] = att::f8x4(v[att::kap(hh, e)], v[att::kap(hh, e + 1)], v[att::kap(hh, e + 2)], v[att::kap(hh, e + 3)]); }
                *(u32x4*)(img + att::vimg_off(n, 16 * c)) = w; } }
    }
}
__device__ __forceinline__ void phase_c_even(const Ctx& F, int l) {
    bf16_t* QKV = (bf16_t*)(F.ws + WS_QKV); const float* T = (const float*)(F.ws + WS_TAB64); unsigned char* KF8 = F.ws + WS_KF8;
    kmax_begin(F);
    const int sub = F.lane >> 2, q = F.lane & 3;
    const int e1 = (q >> 1) * 32 + (q & 1) * 8;
    const int nitems = SEQ * 10;
    for (int it = F.gw * 16 + sub; it < nitems; it += F.NGW * 16) {
        const int t = it / 10, hd = it - t * 10;
        const int col = hd < 2 ? 512 + 64 * hd : 1280 + 64 * (hd - 2);
        const int pos = (q >> 1) ? (t & 63) : (t >> 6);
        bf16_t* p = QKV + (size_t)(NCTX + t) * EVEN_IN + col + e1;
        u32x4 a = *(const u32x4*)p, b = *(const u32x4*)(p + 16);
        float ss = ss8(a) + ss8(b);
        rope8(a, b, T + (pos * 16 + (q & 1) * 8) * 2);
        *(u32x4*)p = a; *(u32x4*)(p + 16) = b;
        if (hd >= 2) {
            const int row = NCTX + t; unsigned char* img = KF8 + ((size_t)(hd - 2) * NTILE + (row >> 6)) * 4096;
            *(u32x2*)(img + att::kimg_off<64>(row & 63, e1)) = pk8(a); *(u32x2*)(img + att::kimg_off<64>(row & 63, e1 + 16)) = pk8(b); }
        ss += __shfl_xor(ss, 1); ss += __shfl_xor(ss, 2);
        if (q == 0 && hd >= 2) __hip_atomic_fetch_max((LAS unsigned*)(F.lc + LC_KMAX) + (hd - 2), __float_as_uint(ss), __ATOMIC_RELAXED, __HIP_MEMORY_SCOPE_WORKGROUP);
    }
    for (int it = F.gw * 16 + sub; it < NCTX * 8; it += F.NGW * 16) {
        const int row = it >> 3, hd = it & 7;
        const bf16_t* p = QKV + (size_t)row * EVEN_IN + 1280 + 64 * hd + 16 * q;
        const u32x4 a = *(const u32x4*)p, b = *(const u32x4*)(p + 8);
        float ss = ss8(a) + ss8(b);
        { unsigned char* img = KF8 + ((size_t)hd * NTILE + (row >> 6)) * 4096; const u32x2 w0 = pk8(a), w1 = pk8(b);
          *(u32x4*)(img + att::kimg_off<64>(row & 63, 16 * q)) = (u32x4){w0.x, w0.y, w1.x, w1.y}; }
        ss += __shfl_xor(ss, 1); ss += __shfl_xor(ss, 2);
        if (q == 0) __hip_atomic_fetch_max((LAS unsigned*)(F.lc + LC_KMAX) + hd, __float_as_uint(ss), __ATOMIC_RELAXED, __HIP_MEMORY_SCOPE_WORKGROUP);
    }
    vimg_build(F, QKV, EVEN_IN, 1792, 4);
    kmax_end(F, l, 8);
}
__device__ __forceinline__ void phase_c_odd(const Ctx& F, int li, int l) {
    bf16_t* QKV = (bf16_t*)(F.ws + WS_QKV); const float* T = (const float*)(F.ws + WS_TAB128); unsigned char* KF8 = F.ws + WS_KF8;
    const float* g = INP(I_KNG) + li * 128;
    kmax_begin(F);
    const int sub = F.lane >> 3, q = F.lane & 7;
    const int e1 = (q >> 2) * 64 + (q & 3) * 8;
    const int nitems = MROWS * 2;
    for (int it = F.gw * 8 + sub; it < nitems; it += F.NGW * 8) {
        const int row = it >> 1, hd = it & 1;
        bf16_t* p = QKV + (size_t)row * ODD_IN + 1024 + hd * 128 + e1;
        u32x4 a = *(const u32x4*)p, b = *(const u32x4*)(p + 32);
        float ss = ss8(a) + ss8(b);
        ss += __shfl_xor(ss, 1); ss += __shfl_xor(ss, 2); ss += __shfl_xor(ss, 4);
        const float rs = 1.f / sqrtf(ss * (1.f / 128.f) + QK_EPS);
        { unsigned* pa = (unsigned*)&a; unsigned* pb = (unsigned*)&b;
#pragma unroll
          for (int j = 0; j < 4; ++j) { const f32x2 ga = *(const f32x2*)(g + e1 + 2 * j), gb = *(const f32x2*)(g + e1 + 32 + 2 * j);
              pa[j] = cvt_pk_bf16(bf_lo(pa[j]) * rs * ga.x, bf_hi(pa[j]) * rs * ga.y); pb[j] = cvt_pk_bf16(bf_lo(pb[j]) * rs * gb.x, bf_hi(pb[j]) * rs * gb.y); } }
        float s2 = ss8(a) + ss8(b);
        s2 += __shfl_xor(s2, 1); s2 += __shfl_xor(s2, 2); s2 += __shfl_xor(s2, 4);
        if (q == 0) __hip_atomic_fetch_max((LAS unsigned*)(F.lc + LC_KMAX) + hd, __float_as_uint(s2), __ATOMIC_RELAXED, __HIP_MEMORY_SCOPE_WORKGROUP);
        if (row >= NCTX) { const int t = row - NCTX, pos = (q >> 2) ? (t & 63) : (t >> 6); rope8(a, b, T + (pos * 32 + (q & 3) * 8) * 2); }
        *(u32x4*)p = a; *(u32x4*)(p + 32) = b;
        { unsigned char* img = KF8 + ((size_t)hd * NTILE + (row >> 6)) * 8192;
          *(u32x2*)(img + att::kimg_off<128>(row & 63, e1)) = pk8(a); *(u32x2*)(img + att::kimg_off<128>(row & 63, e1 + 32)) = pk8(b); }
    }
    vimg_build(F, QKV, ODD_IN, 1280, 2);
    kmax_end(F, l, 2);
}

#define ATT_COMMON const bf16_t* QKV = (const bf16_t*)(F.ws + WS_QKV); bf16_t* OB = (bf16_t*)(F.ws + WS_OB); float* SCR = (float*)(F.ws + WS_YB); \
    char* lds = (char*)(unsigned char*)F.lds; (void)SCR; (void)OB;
#define EPI_TID() int te = F.wave * 64 + lane_id(); asm volatile("" : "+v"(te)); const int lane = te & 63, wid = te >> 6, r32 = lane & 31; (void)r32; (void)wid; (void)lane
__device__ __forceinline__ void phase_d_b0(const Ctx& F, int l) {
    ATT_COMMON
    for (int u = F.c; u < 260; u += F.G) {
        const bool isctx = u >= 256; const int h = isctx ? u - 256 : (u >> 6); const int row0 = isctx ? 0 : NCTX + (u & 63) * 256; const int seq = isctx ? NCTX : MROWS;
        f32x16 o[4];
        const float kmaxC = sqrtf(__uint_as_float(__hip_atomic_load((unsigned*)(F.ws + WS_CTL) + CW_KMAX + (l * 16 + 2 * h) * 64, RLX_AGENT))) * (0.125f * LOG2E * 1.02f);
#if ATT_F8
        att::attn_core_f8<64>(F.wave * 64 + lane_id(), QKV + (size_t)row0 * EVEN_IN + 768 + (2 * h) * 64, EVEN_IN, F.ws + WS_KF8 + (size_t)(2 * h) * NTILE * 4096, F.ws + WS_VF8 + (size_t)h * NTILE * 8192, seq, F.lds, o, nullptr, (const float*)(F.ws + WS_TAB64), isctx ? -1 : (u & 63) * 256, kmaxC);
#else
        att::attn_core_il<64>(F.tid, QKV + (size_t)row0 * EVEN_IN + 768 + (2 * h) * 64, EVEN_IN, QKV + 1280 + (2 * h) * 64, QKV + 1792 + h * 128, EVEN_IN, seq, kmaxC, F.lds, o, nullptr, (const float*)(F.ws + WS_TAB64), isctx ? -1 : (u & 63) * 256);
#endif
        EPI_TID();
        float* scr = SCR + (size_t)u * 32768 + (size_t)wid * 4096 + lane;
#pragma unroll
        for (int r = 0; r < 16; ++r)
#pragma unroll
            for (int d = 0; d < 4; ++d) scr[(r * 4 + d) * 64] = o[d][r];
    }
}
__device__ __forceinline__ void phase_d_b1(const Ctx& F, int li, int l) { const int lam_layer = l;
    ATT_COMMON
    for (int u = (F.c + F.G - 4) % F.G; u < 260; u += F.G) {
        const bool isctx = u >= 256; const int h = isctx ? u - 256 : (u >> 6); const int row0 = isctx ? 0 : NCTX + (u & 63) * 256; const int seq = isctx ? NCTX : MROWS;
        f32x16 o[4];
        const float kmaxC = sqrtf(__uint_as_float(__hip_atomic_load((unsigned*)(F.ws + WS_CTL) + CW_KMAX + (l * 16 + 2 * h + 1) * 64, RLX_AGENT))) * (0.125f * LOG2E * 1.02f);
#if ATT_F8
        att::attn_core_f8<64>(F.wave * 64 + lane_id(), QKV + (size_t)row0 * EVEN_IN + 768 + (2 * h + 1) * 64, EVEN_IN, F.ws + WS_KF8 + (size_t)(2 * h + 1) * NTILE * 4096, F.ws + WS_VF8 + (size_t)h * NTILE * 8192, seq, F.lds, o, nullptr, (const float*)(F.ws + WS_TAB64), isctx ? -1 : (u & 63) * 256, kmaxC);
#else
        att::attn_core_il<64>(F.tid, QKV + (size_t)row0 * EVEN_IN + 768 + (2 * h + 1) * 64, EVEN_IN, QKV + 1280 + (2 * h + 1) * 64, QKV + 1792 + h * 128, EVEN_IN, seq, kmaxC, F.lds, o, nullptr, (const float*)(F.ws + WS_TAB64), isctx ? -1 : (u & 63) * 256);
#endif
        EPI_TID();
        const float* scr = SCR + (size_t)u * 32768 + (size_t)wid * 4096 + lane;
        const float lam = __hip_atomic_load((float*)(F.ws + WS_LAM) + li, RLX_AGENT);
        const float lam_init = 0.8f - 0.6f * expf(-0.3f * (float)lam_layer);
        const float* sg = INP(I_SUBG) + li * 128;
#pragma unroll
        for (int r = 0; r < 16; ++r) { float s = 0.f;
#pragma unroll
            for (int d = 0; d < 4; ++d) { const float v = scr[(r * 4 + d) * 64] - lam * o[d][r]; o[d][r] = v; s += v * v; }
#pragma unroll
            for (int mm = 1; mm < 32; mm <<= 1) s += __shfl_xor(s, mm);
            s = (1.f - lam_init) / sqrtf(s * (1.f / 128.f) + SUBLN_EPS);
#pragma unroll
            for (int d = 0; d < 4; ++d) o[d][r] *= s * sg[d * 32 + r32]; }
        att::store_o_lds<4>(te, o, OB + (size_t)row0 * DM + 512 + h * 128, DM, lds);
    }
}
__device__ __forceinline__ void phase_d_a(const Ctx& F, int li) {
    ATT_COMMON
    for (int u = F.c; u < 520; u += F.G) {
        const bool isctx = u >= 512; const int hq = isctx ? u - 512 : (u >> 6); const int q0lat = isctx ? 0 : (u & 63) * 256; const int row0 = isctx ? 0 : NCTX + q0lat; const int seq = isctx ? NCTX : NCTX + 512;
        const int kvh = hq >> 2; const float sink = INP(I_SINK)[li * 8 + hq];
        f32x16 o[2];
        att::attn_core<64, 64, true, 2>(F.wave * 64 + lane_id(), QKV + (size_t)row0 * EVEN_IN + hq * 64, EVEN_IN, QKV + 512 + kvh * 64, QKV + 640 + kvh * 64, EVEN_IN, seq, q0lat, sink * 8.f, 1.f, lds, o, (const float*)(F.ws + WS_TAB64), isctx ? -1 : q0lat);
        EPI_TID();
        att::store_o_lds<2>(te, o, OB + (size_t)row0 * DM + hq * 64, DM, lds);
    }
}
__device__ __forceinline__ void phase_d_odd(const Ctx& F, int l) {
    const bf16_t* QKV = (const bf16_t*)(F.ws + WS_QKV); bf16_t* OB = (bf16_t*)(F.ws + WS_OB);
    char* lds = (char*)(unsigned char*)F.lds;
    const int nun = (l == DEPTH - 1) ? 512 : 520;
    for (int u = F.c; u < nun; u += F.G) {
        const bool isctx = u >= 512; const int hq = isctx ? u - 512 : (u >> 6); const int row0 = isctx ? 0 : NCTX + (u & 63) * 256; const int seq = isctx ? NCTX : MROWS;
        const int kvh = hq >> 2;
        f32x16 o[4];
        const float kmaxC = sqrtf(__uint_as_float(__hip_atomic_load((unsigned*)(F.ws + WS_CTL) + CW_KMAX + (l * 16 + kvh) * 64, RLX_AGENT))) * (0.088388347648318440f * LOG2E * 1.02f);
#if ATT_F8
        att::attn_core_f8<128>(F.wave * 64 + lane_id(), QKV + (size_t)row0 * ODD_IN + hq * 128, ODD_IN, F.ws + WS_KF8 + (size_t)kvh * NTILE * 8192, F.ws + WS_VF8 + (size_t)kvh * NTILE * 8192, seq, F.lds, o, INP(I_QNG) + (l >> 1) * 128, (const float*)(F.ws + WS_TAB128), isctx ? -1 : (u & 63) * 256, kmaxC);
#else
        att::attn_core_il<128>(F.tid, QKV + (size_t)row0 * ODD_IN + hq * 128, ODD_IN, QKV + 1024 + kvh * 128, QKV + 1280 + kvh * 128, ODD_IN, seq, kmaxC, F.lds, o, INP(I_QNG) + (l >> 1) * 128, (const float*)(F.ws + WS_TAB128), isctx ? -1 : (u & 63) * 256);
#endif
        EPI_TID();
        att::store_o_lds<4>(te, o, OB + (size_t)row0 * DM + hq * 128, DM, lds);
    }
}


__device__ __forceinline__ void ctx_outproj_mini(const Ctx& F, const bf16_t* O, const bf16_t* Wt, bf16_t* Y) {
    for (int blk = F.c; blk < 256; blk += F.G) {
        const int rb = blk >> 4, cb = blk & 15, fr = F.lane & 15, fq = F.lane >> 4, kb = F.wave * 128;
        f32x4 acc[4];
#pragma unroll
        for (int n = 0; n < 4; ++n) acc[n] = (f32x4){0.f, 0.f, 0.f, 0.f};
        const bf16_t* ap = O + (size_t)(rb * 16 + fr) * DM + kb + 8 * fq;
        const bf16_t* bp = Wt + (size_t)(cb * 64 + fr) * DM + kb + 8 * fq;
#pragma unroll
        for (int k = 0; k < 4; ++k) { const bf16x8 a = *(const bf16x8*)(ap + 32 * k);
#pragma unroll
            for (int n = 0; n < 4; ++n) { const bf16x8 b = *(const bf16x8*)(bp + (size_t)(16 * n) * DM + 32 * k); acc[n] = __builtin_amdgcn_mfma_f32_16x16x32_bf16(b, a, acc[n], 0, 0, 0); } }
        LAS float* red = (LAS float*)F.lds + F.wave * 1024;
#pragma unroll
        for (int n = 0; n < 4; ++n) *(LAS f32x4*)(red + fr * 64 + 16 * n + 4 * fq) = acc[n];
        __syncthreads();
        { const int e = F.tid * 2; float s0 = 0.f, s1 = 0.f;
#pragma unroll
          for (int w = 0; w < 8; ++w) { const f32x2 v = *(const LAS f32x2*)((LAS float*)F.lds + w * 1024 + e); s0 += v.x; s1 += v.y; }
          const int row = e >> 6, col = e & 63;
          *(unsigned*)(Y + (size_t)(rb * 16 + row) * DM + cb * 64 + col) = cvt_pk_bf16(s0, s1); }
        __syncthreads();
    }
}
__device__ __forceinline__ void phase_f(const Ctx& F, int l, int row_lo, bool dry = false) {
    unsigned char* ws = F.ws;
    const float* XB = (const float*)(ws + WS_XB); const bf16_t* YB = (const bf16_t*)(ws + WS_YB); float* X1B = (float*)(ws + WS_X1B); bf16_t* HB = (bf16_t*)(ws + WS_HB);
    const float* MODV = (const float*)(ws + WS_MODV); i32x4* ROUTE = (i32x4*)(ws + WS_ROUTE); int* IDX = (int*)(ws + WS_IDX);
    LAS float* wr_l = (LAS float*)F.lds;
    for (int i = F.tid; i < 16384; i += NTHREADS) wr_l[(i & 15) * 1024 + (i >> 4)] = INP(I_WR)[i];
    if (F.tid < 16) F.lc[LC_LCNT + F.tid] = 0;
    __syncthreads();
    float br[16];
#pragma unroll
    for (int e = 0; e < 16; ++e) br[e] = INP(I_BR)[e];
    int nr = 0;
    for (int row = row_lo + F.gw; row < MROWS; row += F.NGW, ++nr) {
        const int isctx = row < NCTX ? 1 : 0; const float* mp = MODV + (l * 2 + isctx) * 6144;
        f32x4 v[4]; float s = 0.f;
#pragma unroll
        for (int j = 0; j < 4; ++j) { const int col = 4 * F.lane + 256 * j;
            const f32x4 x = *(const f32x4*)(XB + (size_t)row * DM + col), g1 = *(const f32x4*)(mp + 2048 + col); const u32x2 yw = *(const u32x2*)(YB + (size_t)row * DM + col);
            const f32x4 y = {bf_lo(yw.x), bf_hi(yw.x), bf_lo(yw.y), bf_hi(yw.y)};
            v[j] = ALPHA * x + g1 * y; s += (v[j].x + v[j].y) + (v[j].z + v[j].w); }
        const float mean = wave_sum(s) * (1.f / DM); float s2 = 0.f;
#pragma unroll
        for (int j = 0; j < 4; ++j) { v[j] = v[j] - mean; s2 += (v[j].x * v[j].x + v[j].y * v[j].y) + (v[j].z * v[j].z + v[j].w * v[j].w); }
        const float rstd = 1.f / sqrtf(wave_sum(s2) * (1.f / DM) + LN_EPS);
#pragma unroll
        for (int j = 0; j < 4; ++j) { const int col = 4 * F.lane + 256 * j;
            const f32x4 g = *(const f32x4*)(INP(I_LNG) + (l * 2) * DM + col), b = *(const f32x4*)(INP(I_LNB) + (l * 2) * DM + col);
            v[j] = v[j] * rstd * g + b;
            *(f32x4*)(X1B + (size_t)row * DM + col) = v[j];
            const f32x4 sh = *(const f32x4*)(mp + 3072 + col), sc = *(const f32x4*)(mp + 4096 + col);
            v[j] = v[j] * (1.f + sc) + sh;
            u32x2 w; w.x = cvt_pk_bf16(v[j].x, v[j].y); w.y = cvt_pk_bf16(v[j].z, v[j].w);
            *(u32x2*)(HB + (size_t)row * DM + col) = w; }
        float sc[16], sel[16];
#pragma unroll
        for (int e = 0; e < 16; ++e) { float a = 0.f;
#pragma unroll
            for (int j = 0; j < 4; ++j) { const f32x4 w = *(const LAS f32x4*)(wr_l + e * 1024 + 4 * F.lane + 256 * j); a += (v[j].x * w.x + v[j].y * w.y) + (v[j].z * w.z + v[j].w * w.w); }
            a = wave_sum(a); sc[e] = 1.f / (1.f + __expf(-a)); sel[e] = sc[e] + br[e]; }
        int best = 0; float bestv = -3.0e38f; int ci0[4], ci1[4]; float cw0[4], cw1[4];
#pragma unroll
        for (int g = 0; g < 4; ++g) {
            const float a = sel[4 * g], b = sel[4 * g + 1], c2 = sel[4 * g + 2], d = sel[4 * g + 3];
            int i0 = 0; float m0 = a; if (b > m0) { m0 = b; i0 = 1; } if (c2 > m0) { m0 = c2; i0 = 2; } if (d > m0) { m0 = d; i0 = 3; }
            int i1 = -1; float m1 = -3.0e38f;
            if (i0 != 0 && a > m1) { m1 = a; i1 = 0; } if (i0 != 1 && b > m1) { m1 = b; i1 = 1; } if (i0 != 2 && c2 > m1) { m1 = c2; i1 = 2; } if (i0 != 3 && d > m1) { m1 = d; i1 = 3; }
            const float gs = m0 + m1; if (gs > bestv) { bestv = gs; best = g; }
            ci0[g] = 4 * g + i0; ci1[g] = 4 * g + i1;
            const float s0 = sc[4 * g], s1 = sc[4 * g + 1], s2_ = sc[4 * g + 2], s3 = sc[4 * g + 3];
            cw0[g] = i0 == 0 ? s0 : (i0 == 1 ? s1 : (i0 == 2 ? s2_ : s3)); cw1[g] = i1 == 0 ? s0 : (i1 == 1 ? s1 : (i1 == 2 ? s2_ : s3)); }
        const int e0 = best == 0 ? ci0[0] : (best == 1 ? ci0[1] : (best == 2 ? ci0[2] : ci0[3])), e1 = best == 0 ? ci1[0] : (best == 1 ? ci1[1] : (best == 2 ? ci1[2] : ci1[3]));
        float w0 = best == 0 ? cw0[0] : (best == 1 ? cw0[1] : (best == 2 ? cw0[2] : cw0[3])), w1 = best == 0 ? cw1[0] : (best == 1 ? cw1[1] : (best == 2 ? cw1[2] : cw1[3]));
        const float wn = 1.f / (w0 + w1); w0 *= wn; w1 *= wn;
        if (F.lane == 0 && !dry) {
            const int lp0 = __hip_atomic_fetch_add(F.lc + LC_LCNT + e0, 1, __ATOMIC_RELAXED, __HIP_MEMORY_SCOPE_WORKGROUP);
            const int lp1 = __hip_atomic_fetch_add(F.lc + LC_LCNT + e1, 1, __ATOMIC_RELAXED, __HIP_MEMORY_SCOPE_WORKGROUP);
            LAS int* wt = F.lc + LC_WTAB + (F.wave * 16 + nr) * 8;
            wt[0] = row; wt[1] = e0; wt[2] = lp0; wt[3] = e1; wt[4] = lp1; wt[5] = __float_as_int(w0); wt[6] = __float_as_int(w1); }
    }
    __syncthreads();
    if (dry) return;
    if (F.tid < 16) { const int n = F.lc[LC_LCNT + F.tid];
        const unsigned base = n ? xb_add((unsigned*)(ws + WS_CTL) + CW_CNT + (l * 16 + F.tid) * 64, (unsigned)n) : 0u;
        F.lc[LC_GBASE + F.tid] = (int)base; }
    __syncthreads();
    if (F.lane < nr) {
        const LAS int* wt = F.lc + LC_WTAB + (F.wave * 16 + F.lane) * 8;
        const int row = wt[0], e0 = wt[1], e1 = wt[3]; const int p0 = F.lc[LC_GBASE + e0] + wt[2], p1 = F.lc[LC_GBASE + e1] + wt[4];
        IDX[e0 * MROWS + p0] = row; IDX[e1 * MROWS + p1] = row;
        i32x4 rt; rt.x = (e0 << 15) | p0; rt.y = (e1 << 15) | p1; rt.z = wt[5]; rt.w = wt[6];
        ROUTE[row] = rt; }
}

__global__ void __launch_bounds__(NTHREADS, 2) mk_fwd(Args args) {
    extern __shared__ __attribute__((aligned(16))) unsigned char lds_raw[];
    LAS int* lc0 = (LAS int*)((LAS unsigned char*)lds_raw + LDSCTL_OFF);
    const int wave_s = __builtin_amdgcn_readfirstlane((int)threadIdx.x >> 6);
    for (int u = wave_s * 64 + lane_id(); u < (LDS_BYTES - LDSCTL_OFF) / 4; u += NTHREADS) lc0[u] = 0;
    __syncthreads();
#define IS_T0 (wave_s == 0 && lane_id() == 0)
    unsigned* barw = (unsigned*)(args.ws + WS_CTL) + CW_BAR;
#if MK_MULTI
    XcdBarrier bar; bar.bar = barw; bar.x = 0; bar.st = nullptr;
#define GRID_BAR() do { } while (0)
#else
    XcdBarrier bar = xcd_barrier_post(barw, (volatile LAS unsigned*)(lc0 + LC_BAR), IS_T0);
#define GRID_BAR() xcd_barrier(bar, IS_T0)
#endif
    const int lo = args.ph_lo, hi = args.ph_hi;
#ifndef PHMASK
#define PHMASK 0xFFFF
#endif
#define EN(b) ((PHMASK >> (b)) & 1)
#ifndef REP_MASK
#define REP_MASK 0
#endif
#define REP_CAT2(a, b) a##b
#define REP_CAT(a, b) REP_CAT2(a, b)
#define REP(b) for (int REP_CAT(_rep, __LINE__) = 0; REP_CAT(_rep, __LINE__) < 1 + ((REP_MASK >> (b)) & 1); ++REP_CAT(_rep, __LINE__))
#define IN(k) (lo <= (k) && (k) < hi)
#define SEAM(k) do { if (IN(k) && IN((k) + 1)) GRID_BAR(); } while (0)

    if (IN(0) && EN(0)) REP(0) { const Ctx F = make_ctx(wave_s); p0_prologue(F); } SEAM(0);

    for (int l = 0; l < DEPTH; ++l) {
        const int pb = 1 + 8 * l, li = l >> 1; const bool odd = (l & 1) != 0;
        const int pm_lo = (l == DEPTH - 1) ? 1 : 0;
        if (IN(pb + 0) && EN(1)) REP(1) { const Ctx F = make_ctx(wave_s); phase_a(F, l, nullptr); } SEAM(pb + 0);
        if (IN(pb + 1) && EN(2)) REP(2) {
            const Ctx F = make_ctx(wave_s); unsigned char* ws = F.ws; const int NIN = odd ? ODD_IN : EVEN_IN;
            pg8::DenseSched S; S.init((const bf16_t*)(ws + WS_HB), odd ? (const bf16_t*)(ws + WS_WINO) + (size_t)li * ODD_IN * DM : (const bf16_t*)(ws + WS_WINE) + (size_t)li * EVEN_IN * DM, DM, 0, MROWS / 256, NIN, F.G, F.c);
            pg8::EpiBf16 E{(bf16_t*)(ws + WS_QKV), NIN};
            pg8::gemm_phase<pg8::EpiBf16, pg8::DenseSched>(F.tid, F.lds, DM, S, E);
        } SEAM(pb + 1);
        if (IN(pb + 2) && EN(3)) { const Ctx F = make_ctx(wave_s); if (odd) phase_c_odd(F, li, l); else phase_c_even(F, l); } SEAM(pb + 2);
        if (IN(pb + 3) && EN(4)) REP(4) {
#ifndef ATTSEL
#define ATTSEL 15
#endif
            if (odd) { if (ATTSEL & 8) REP(11) { const Ctx F = make_ctx(wave_s); phase_d_odd(F, l); } }
            else { REP(9) { if (ATTSEL & 1) { const Ctx F = make_ctx(wave_s); phase_d_b0(F, l); } if (ATTSEL & 2) { const Ctx F = make_ctx(wave_s); phase_d_b1(F, li, l); } } if (ATTSEL & 4) REP(10) { const Ctx F = make_ctx(wave_s); phase_d_a(F, li); } }
        } SEAM(pb + 3);
        if (IN(pb + 4) && EN(5)) REP(5) {
            const Ctx F = make_ctx(wave_s); unsigned char* ws = F.ws;
            pg8::DenseSched S; S.init((const bf16_t*)(ws + WS_OB), (const bf16_t*)(ws + WS_WOUT) + (size_t)l * DM * DM, DM, 1, MROWS / 256 - 1, DM, F.G, F.c);
            pg8::EpiBf16 E{(bf16_t*)(ws + WS_YB), DM};
            pg8::gemm_phase<pg8::EpiBf16, pg8::DenseSched>(F.tid, F.lds, DM, S, E);
            if (pm_lo == 0) ctx_outproj_mini(F, (const bf16_t*)(ws + WS_OB), (const bf16_t*)(ws + WS_WOUT) + (size_t)l * DM * DM, (bf16_t*)(ws + WS_YB));
        } SEAM(pb + 4);
#ifdef PF_PROBE
        if (IN(pb + 5) && EN(6)) { const Ctx F = make_ctx(wave_s); phase_f(F, l, pm_lo * 256, true); __syncthreads(); }
#endif
        if (IN(pb + 5) && EN(6)) { const Ctx F = make_ctx(wave_s); phase_f(F, l, pm_lo * 256); } SEAM(pb + 5);
#define MOE_GU_SCHED(S) pg8::MoeSched<true> S; S.Ab = (const bf16_t*)(ws + WS_HB); S.Wb = (const bf16_t*)(ws + WS_WGU) + (size_t)l * NEXP * 1024 * DM; S.idx = (const int*)(ws + WS_IDX); \
            S.tstart = F.lc + LC_TSTART; S.ecnt = F.lc + LC_ECNT; S.K = DM
#define MOE_DN_SCHED(S) pg8::MoeSched<false> S; S.Ab = (const bf16_t*)(ws + WS_YB); S.Wb = (const bf16_t*)(ws + WS_WD) + (size_t)l * NEXP * DM * DEXP; S.idx = nullptr; \
            S.tstart = F.lc + LC_TSTART; S.ecnt = F.lc + LC_ECNT; S.K = DEXP
        int moe_nu = 0, moe_r = 0; bool moe_split = false;
        if ((IN(pb + 6) && EN(7)) || (IN(pb + 7) && EN(8))) { const Ctx F = make_ctx(wave_s); load_tstart(F, l); moe_nu = __builtin_amdgcn_readfirstlane(F.lc[LC_TSTART + 16]) * 4;
            moe_r = moe_nu - 2 * F.G; moe_split = (MK_MULTI == 0) && (REP_MASK == 0) && moe_r > 0 && 3 * moe_r <= F.G; }
        if (IN(pb + 6) && EN(7)) REP(7) {
            const Ctx F = make_ctx(wave_s); unsigned char* ws = F.ws;
            MOE_GU_SCHED(S); S.base = F.c; S.stride = F.G; S.hi = moe_split ? 2 * F.G : moe_nu;
            pg8::EpiGateUp E{(bf16_t*)(ws + WS_YB)};
            pg8::gemm_phase<pg8::EpiGateUp, pg8::MoeSched<true>>(F.tid, F.lds, DM, S, E);
        } SEAM(pb + 6);
        if (IN(pb + 7) && EN(8)) REP(8) {
            if (!moe_split) {
                const Ctx F = make_ctx(wave_s); unsigned char* ws = F.ws;
                MOE_DN_SCHED(S); S.base = F.c; S.stride = F.G; S.hi = moe_nu;
                pg8::EpiBf16 E{(bf16_t*)(ws + WS_QKV), DM};
                pg8::gemm_phase<pg8::EpiBf16, pg8::MoeSched<false>>(F.tid, F.lds, DEXP, S, E);
            } else {
                { const Ctx F = make_ctx(wave_s); unsigned char* ws = F.ws;
                  MOE_GU_SCHED(S); S.base = 2 * F.G + F.c; S.stride = F.G; S.hi = moe_nu;
                  pg8::EpiGateUp E{(bf16_t*)(ws + WS_YB)};
                  pg8::gemm_phase<pg8::EpiGateUp, pg8::MoeSched<true>>(F.tid, F.lds, DM, S, E); }
                { const Ctx F = make_ctx(wave_s); unsigned char* ws = F.ws;
                  MOE_DN_SCHED(S); S.base = F.c >= moe_r ? 2 * (F.c - moe_r) : 0; S.stride = 1; S.hi = F.c >= moe_r ? S.base + 2 : 0;
                  pg8::EpiBf16 E{(bf16_t*)(ws + WS_QKV), DM};
                  pg8::gemm_phase<pg8::EpiBf16, pg8::MoeSched<false>>(F.tid, F.lds, DEXP, S, E); }
                GRID_BAR();
                { const Ctx F = make_ctx(wave_s); unsigned char* ws = F.ws;
                  MOE_DN_SCHED(S); S.base = 2 * (F.G - moe_r) + F.c; S.stride = F.G; S.hi = moe_nu;
                  pg8::EpiBf16 E{(bf16_t*)(ws + WS_QKV), DM};
                  pg8::gemm_phase<pg8::EpiBf16, pg8::MoeSched<false>>(F.tid, F.lds, DEXP, S, E); }
            }
        } SEAM(pb + 7);
    }
    if (IN(33) && EN(1)) { const Ctx F = make_ctx(wave_s); float* outp = (float*)*(GAS float* const CAS*)((const CAS char*)F.in + 200); phase_a(F, 4, outp); }
#undef IN
#undef SEAM
}

constexpr int NPHASE = 34;
extern "C" void kernel_launch(void* const* d_in, const int* in_sizes, int n_in, void* d_out, int out_size, void* d_ws, size_t ws_size, hipStream_t stream) {
    static int grid = 0;
    if (grid == 0) {
        if (n_in != 25 || out_size != SEQ * DM || ws_size < WS_END) { fprintf(stderr, "kernel_launch: shape mismatch n_in %d out %d ws %zu (need %zu)\n", n_in, out_size, ws_size, (size_t)WS_END); grid = -1; return; }
        int dev = 0, cus = 0, per_cu = 0;
        if (hipGetDevice(&dev) != hipSuccess || hipDeviceGetAttribute(&cus, hipDeviceAttributeMultiprocessorCount, dev) != hipSuccess) { grid = -1; return; }
        if (hipFuncSetAttribute((const void*)mk_fwd, hipFuncAttributeMaxDynamicSharedMemorySize, LDS_BYTES) != hipSuccess) { fprintf(stderr, "kernel_launch: hipFuncSetAttribute failed\n"); grid = -1; return; }
        if (hipOccupancyMaxActiveBlocksPerMultiprocessor(&per_cu, (const void*)mk_fwd, NTHREADS, LDS_BYTES) != hipSuccess || per_cu < 1) { fprintf(stderr, "kernel_launch: occupancy query says %d\n", per_cu); }
        (void)hipGetLastError();
        grid = cus;
    }
    if (grid < 0) return;
    if (hipMemsetAsync((char*)d_ws + WS_CTL, 0, CTL_ZERO_BYTES, stream) != hipSuccess) return;
    Args a{};
    for (int i = 0; i < 25; ++i) a.in[i] = (const float*)d_in[i];
    a.out = (float*)d_out; a.ws = (unsigned char*)d_ws;
#if MK_MULTI
    for (int p = 0; p < NPHASE; ++p) { a.ph_lo = p; a.ph_hi = p + 1; hipLaunchKernelGGL(mk_fwd, dim3(grid), dim3(NTHREADS), LDS_BYTES, stream, a); }
#else
    a.ph_lo = 0; a.ph_hi = NPHASE;
    hipLaunchKernelGGL(mk_fwd, dim3(grid), dim3(NTHREADS), LDS_BYTES, stream, a);
#endif
    const hipError_t le = hipPeekAtLastError();
    if (le != hipSuccess) fprintf(stderr, "kernel_launch: launch failed: %s\n", hipGetErrorName(le));
}
```

```cpp
#include <hip/hip_runtime.h>
#include <cstdio>
#include <cstdint>

#ifndef ATT_F8
#define ATT_F8 1
#endif
#ifndef MK_MULTI
#define MK_MULTI 0
#endif

#define LAS __attribute__((address_space(3)))
#define GAS __attribute__((address_space(1)))
#define CAS __attribute__((address_space(4)))
typedef unsigned short bf16_t;
typedef short bf16x8 __attribute__((ext_vector_type(8)));
typedef short s16x4 __attribute__((ext_vector_type(4)));
typedef float f32x2 __attribute__((ext_vector_type(2)));
typedef float f32x4 __attribute__((ext_vector_type(4)));
typedef float f32x16 __attribute__((ext_vector_type(16)));
typedef unsigned u32x2 __attribute__((ext_vector_type(2)));
typedef unsigned u32x4 __attribute__((ext_vector_type(4)));
typedef int i32x4 __attribute__((ext_vector_type(4)));

constexpr int DM = 1024, SEQ = 16384, NCTX = 256, MROWS = SEQ + NCTX, DEPTH = 4;
constexpr int EVEN_IN = 2304, ODD_IN = 1536;
constexpr int NEXP = 16, DEXP = 512;
constexpr float ALPHA = 1.681792830507429f;
constexpr float LN_EPS = 1e-5f, QK_EPS = 1e-6f, SUBLN_EPS = 1e-5f;
constexpr int NWAVES = 8, NTHREADS = 512;
constexpr int MAXSLOT = 37376;
constexpr float LOG2E = 1.4426950408889634f;

constexpr size_t al256(size_t x) { return (x + 255) / 256 * 256; }
constexpr size_t WS_CTL = 0, CTL_ZERO_BYTES = 1u << 20;
constexpr int CW_BAR = 4096;
constexpr int CW_KMAX = 24576;
constexpr int CW_CNT = 16384;
constexpr size_t WS_MODV = CTL_ZERO_BYTES;
constexpr size_t WS_TAB64 = WS_MODV + al256((size_t)4 * 2 * 6144 * 4);
constexpr size_t WS_TAB128 = WS_TAB64 + al256((size_t)256 * 16 * 2 * 4);
constexpr size_t WS_LAM = WS_TAB128 + al256((size_t)256 * 32 * 2 * 4);
constexpr size_t WS_ROUTE = WS_LAM + 256;
constexpr size_t WS_IDX = WS_ROUTE + al256((size_t)MROWS * 16);
constexpr size_t WS_WINE = al256(WS_IDX + (size_t)NEXP * MROWS * 4);
constexpr size_t WS_WINO = WS_WINE + (size_t)2 * EVEN_IN * DM * 2;
constexpr size_t WS_WOUT = WS_WINO + (size_t)2 * ODD_IN * DM * 2;
constexpr size_t WS_WGU = WS_WOUT + (size_t)4 * DM * DM * 2;
constexpr size_t WS_WD = WS_WGU + (size_t)4 * NEXP * 1024 * DM * 2;
constexpr size_t WS_XB = WS_WD + (size_t)4 * NEXP * DM * DEXP * 2;
constexpr size_t WS_X1B = WS_XB + (size_t)MROWS * DM * 4;
constexpr size_t WS_HB = WS_X1B + (size_t)MROWS * DM * 4;
constexpr size_t WS_QKV = WS_HB + (size_t)MROWS * DM * 2;
constexpr size_t WS_OB = WS_QKV + (size_t)MROWS * EVEN_IN * 2;
constexpr size_t WS_YB = WS_OB + (size_t)MROWS * DM * 2;
constexpr int NTILE = MROWS / 64;
constexpr size_t WS_KF8 = WS_YB + (size_t)MROWS * DM * 4;
constexpr size_t WS_VF8 = WS_KF8 + (size_t)8 * NTILE * 4096;
constexpr size_t WS_END = WS_VF8 + (size_t)4 * NTILE * 8192;
static_assert((size_t)MAXSLOT * DM * 2 <= (size_t)MROWS * EVEN_IN * 2, "moe out fits qkv region");
static_assert((size_t)MAXSLOT * DEXP * 2 <= (size_t)MROWS * DM * 4, "A2 fits y region");

constexpr int RING_BYTES = 131072;
constexpr int LDSCTL_OFF = RING_BYTES;
constexpr int LC_BAR = 0;
constexpr int LC_TSTART = 16;
constexpr int LC_ECNT = 40;
constexpr int LC_LCNT = 56;
constexpr int LC_GBASE = 72;
constexpr int LC_WTAB = 96;
constexpr int LC_KMAX = 1120;
constexpr int LDS_BYTES = 147456;
static_assert(LDSCTL_OFF + (LC_KMAX + 16) * 4 <= 139264 && 139264 + 8192 <= LDS_BYTES, "LDS map");

__device__ __forceinline__ unsigned cvt_pk_bf16(float lo, float hi) { unsigned r; asm volatile("v_cvt_pk_bf16_f32 %0, %1, %2" : "=v"(r) : "v"(lo), "v"(hi)); return r; }
__device__ __forceinline__ float bf_lo(unsigned w) { return __uint_as_float(w << 16); }
__device__ __forceinline__ float bf_hi(unsigned w) { return __uint_as_float(w & 0xffff0000u); }
__device__ __forceinline__ float wave_sum(float v) {
#pragma unroll
    for (int o = 1; o < 64; o <<= 1) v += __shfl_xor(v, o);
    return v;
}
#define LDS_WAIT() asm volatile("s_waitcnt lgkmcnt(0)" ::: "memory")
#define VM_WAIT() asm volatile("s_waitcnt vmcnt(0)" ::: "memory")
#define RLX_AGENT __ATOMIC_RELAXED, __HIP_MEMORY_SCOPE_AGENT

#define XB_TMO      128
#define XB_XCNT(j)  (256  + 64 * (j))
#define XB_XSUB(j)  (1280 + 64 * (j))
#define XB_XGEN(j)  (2304 + 64 * (j))
#define XB_TOP      3328
#define XB_TOPGEN   3392
#define XCD_BAR_WORDS 3456
#define XB_SPIN_CAP (1u << 18)
__device__ __forceinline__ unsigned xb_ld(unsigned* p)              { return __hip_atomic_load(p, __ATOMIC_RELAXED, __HIP_MEMORY_SCOPE_AGENT); }
__device__ __forceinline__ unsigned xb_add(unsigned* p, unsigned v) { return __hip_atomic_fetch_add(p, v, __ATOMIC_RELAXED, __HIP_MEMORY_SCOPE_AGENT); }
__device__ __forceinline__ unsigned xb_xcc_id() { return (unsigned)__builtin_amdgcn_s_getreg((3 << 11) | 20) & 0xFu; }
#define XB_SPIN(cond, bar) do { unsigned _sp = 0; while (cond) { __builtin_amdgcn_s_sleep(1); \
    if ((++_sp & 255u) == 0u) { if (xb_ld(&(bar)[XB_TMO])) break; if (_sp > XB_SPIN_CAP) { atomicAdd(&(bar)[XB_TMO], 1u); break; } } } } while (0)
struct XcdBarrier { unsigned* bar; unsigned x; volatile LAS unsigned* st; };
__device__ __forceinline__ XcdBarrier xcd_barrier_post(unsigned* bar, volatile LAS unsigned* st, bool is_t0) {
    XcdBarrier b; b.bar = bar; b.x = xb_xcc_id(); b.st = st;
    if (is_t0) (void)xb_add(&bar[XB_XCNT(b.x)], 1u);
    return b;
}
__device__ __forceinline__ void xcd_barrier_complete(unsigned* bar, unsigned x, unsigned& nloc, unsigned& nx) {
    const unsigned G = gridDim.x * gridDim.y * gridDim.z;
    unsigned sum, cnt, mine, sp = 0u;
    for (;;) {
        sum = 0u; cnt = 0u; mine = 0u;
#pragma unroll
        for (unsigned j = 0; j < 16; ++j) { const unsigned c = xb_ld(&bar[XB_XCNT(j)]); sum += c; cnt += (c > 0u) ? 1u : 0u; mine = (j == x) ? c : mine; }
        if (sum == G) break;
        __builtin_amdgcn_s_sleep(1);
        if ((++sp & 255u) == 0u) { if (xb_ld(&bar[XB_TMO])) break; if (sp > XB_SPIN_CAP) { atomicAdd(&bar[XB_TMO], 1u); break; } }
    }
    nloc = mine > 0u ? mine : 1u; nx = cnt > 0u ? cnt : 1u;
}
__device__ __forceinline__ void xcd_barrier(const XcdBarrier& b, bool is_t0) {
    asm volatile("s_waitcnt vmcnt(0)" ::: "memory");
    __syncthreads();
    if (is_t0) {
        unsigned* bar = b.bar;
        __builtin_amdgcn_s_waitcnt(0);
        unsigned nloc = b.st[0], nx = b.st[1];
        if (nloc == 0u) { xcd_barrier_complete(bar, b.x, nloc, nx); b.st[0] = nloc; b.st[1] = nx; }
        const unsigned old = xb_add(&bar[XB_XSUB(b.x)], 1u);
        const unsigned gen = old / nloc;
        if (old + 1u == (gen + 1u) * nloc) {
            __builtin_amdgcn_fence(__ATOMIC_RELEASE, "agent");
            asm volatile("s_waitcnt vmcnt(0)" ::: "memory");
            const unsigned og = xb_add(&bar[XB_TOP], 1u);
            const unsigned tg = og / nx;
            if (og + 1u == (tg + 1u) * nx) xb_add(&bar[XB_TOPGEN], 1u);
            else XB_SPIN(xb_ld(&bar[XB_TOPGEN]) == tg, bar);
            __builtin_amdgcn_fence(__ATOMIC_ACQUIRE, "agent");
            xb_add(&bar[XB_XGEN(b.x)], 1u);
            asm volatile("s_waitcnt vmcnt(0)" ::: "memory");
        } else {
            XB_SPIN(xb_ld(&bar[XB_XGEN(b.x)]) == gen, bar);
            __builtin_amdgcn_fence(__ATOMIC_ACQUIRE, "agent");
            asm volatile("s_waitcnt vmcnt(0)" ::: "memory");
        }
    }
    __syncthreads();
}

namespace pg8 {
constexpr int BM = 256, BK = 64, HALF = 128, HTB = HALF * BK * 2, NXCD = 8, WGM = 8;
constexpr int NV_OFF = 139264;
__host__ __device__ __forceinline__ int lds_byte(int r, int c) { const int st = (r >> 4) * 2 + (c >> 5), rr = r & 15, cc = c & 31, ob = rr * 64 + cc * 2; return st * 1024 + (ob ^ (((ob >> 9) & 1) << 5)); }
__host__ __device__ __forceinline__ void stage_rc(int b, int& R, int& C) { const int st = b / 1024, sb = b % 1024, swz = sb ^ (((sb >> 9) & 1) << 5); R = (st >> 1) * 16 + swz / 64; C = (st & 1) * 32 + (swz % 64) / 2; }
__host__ __device__ __forceinline__ int perm32(int rho) { const int n = rho >> 4, i = rho & 15; return 8 * (i >> 2) + 4 * n + (i & 3); }

struct Unit { int pm, pn, e, lrow; };

struct DenseSched {
    static constexpr bool GATHER = false;
    const bf16_t* A; const bf16_t* Bt; int K, nM, nN, nwg, G, c, pm_lo;
    __device__ void init(const bf16_t* A_, const bf16_t* Bt_, int K_, int pm_lo_, int nM_, int N, int G_, int c_) { A = A_; Bt = Bt_; K = K_; pm_lo = pm_lo_; nM = nM_; nN = N / BM; nwg = nM * nN; G = G_; c = c_; }
    __device__ __forceinline__ bool next(int i, Unit& u) const {
        const long L = (long)i * G + c; if (L >= nwg) return false;
        int wgid = (int)L; { const int q = nwg / NXCD, r = nwg % NXCD, xcd = wgid % NXCD, off = wgid / NXCD; wgid = (xcd < r ? xcd * (q + 1) : r * (q + 1) + (xcd - r) * q) + off; }
        const int nig = WGM * nN, gid = wgid / nig, fm = gid * WGM, gsz = (nM - fm) < WGM ? (nM - fm) : WGM;
        u.pm = pm_lo + fm + ((wgid % nig) % gsz); u.pn = (wgid % nig) / gsz; u.e = 0; u.lrow = 0; return true;
    }
    __device__ __forceinline__ const char* a_base(const Unit& u) const { return (const char*)A + (size_t)u.pm * BM * K * 2; }
    __device__ __forceinline__ const char* b_base(const Unit& u) const { return (const char*)Bt + (size_t)u.pn * BM * K * 2; }
    __device__ __forceinline__ void voffs(const Unit&, const int (&R)[2], const int (&C)[2], unsigned (&v0)[2], unsigned (&v1)[2]) const {
#pragma unroll
        for (int i = 0; i < 2; ++i) { v0[i] = (unsigned)(R[i] * K + C[i]) * 2u; v1[i] = v0[i] + (unsigned)(HALF * K) * 2u; }
    }
};
template <bool GATHER_> struct MoeSched {
    static constexpr bool GATHER = GATHER_;
    const bf16_t* Ab; const bf16_t* Wb; const int* idx; const LAS int* tstart; const LAS int* ecnt; int K, base, stride, hi;
    __device__ __forceinline__ bool next(int i, Unit& u) const {
        const int L = base + i * stride; if (L >= hi) return false;
        const int tile = L >> 2; u.pn = L & 3; u.pm = tile;
        int e = 0;
#pragma unroll
        for (int k = 1; k < 16; ++k) e += (tile >= tstart[k]) ? 1 : 0;
        e = __builtin_amdgcn_readfirstlane(e);
        u.e = e; u.lrow = __builtin_amdgcn_readfirstlane((tile - tstart[e]) * 256); return true;
    }
    __device__ __forceinline__ const char* a_base(const Unit& u) const { return GATHER ? (const char*)Ab : (const char*)Ab + (size_t)u.pm * BM * K * 2; }
    __device__ __forceinline__ const char* b_base(const Unit& u) const { return (const char*)Wb + ((size_t)u.e * 1024 + (size_t)u.pn * BM) * K * 2; }
    __device__ __forceinline__ void voffs(const Unit& u, const int (&R)[2], const int (&C)[2], unsigned (&v0)[2], unsigned (&v1)[2]) const {
        if constexpr (GATHER) {
            const int n = ecnt[u.e];
#pragma unroll
            for (int i = 0; i < 2; ++i) {
                const int p0 = u.lrow + R[i], p1 = p0 + HALF;
                const int t0 = p0 < n ? idx[u.e * MROWS + p0] : 0, t1 = p1 < n ? idx[u.e * MROWS + p1] : 0;
                v0[i] = (unsigned)(t0 * K + C[i]) * 2u; v1[i] = (unsigned)(t1 * K + C[i]) * 2u; }
        } else {
#pragma unroll
            for (int i = 0; i < 2; ++i) { v0[i] = (unsigned)(R[i] * K + C[i]) * 2u; v1[i] = v0[i] + (unsigned)(HALF * K) * 2u; }
        }
    }
};

struct EpiF32 {
    static constexpr bool PERM = false;
    float* C; int ldc;
    __device__ __forceinline__ void operator()(const f32x4 (&acc)[2][2][4][2], const Unit& u, int wr, int wc, int fr, int fq) const {
        const int row0 = u.pm * BM + wr * 64 + fr, col0 = u.pn * BM + wc * 32 + 4 * fq;
#pragma unroll
        for (int ai = 0; ai < 2; ++ai)
#pragma unroll
            for (int m = 0; m < 4; ++m) { float* rowp = C + (size_t)(row0 + ai * HALF + m * 16) * ldc + col0;
#pragma unroll
                for (int bj = 0; bj < 2; ++bj)
#pragma unroll
                    for (int n = 0; n < 2; ++n) *(f32x4*)(rowp + bj * HALF + n * 16) = acc[ai][bj][m][n]; }
    }
};
struct EpiBf16 {
    static constexpr bool PERM = true;
    bf16_t* O; int ldc;
    __device__ __forceinline__ void operator()(const f32x4 (&acc)[2][2][4][2], const Unit& u, int wr, int wc, int fr, int fq) const {
        const int row0 = u.pm * BM + wr * 64 + fr, col0 = u.pn * BM + wc * 32 + 8 * fq;
#pragma unroll
        for (int ai = 0; ai < 2; ++ai)
#pragma unroll
            for (int m = 0; m < 4; ++m) { bf16_t* rowp = O + (size_t)(row0 + ai * HALF + m * 16) * ldc + col0;
#pragma unroll
                for (int bj = 0; bj < 2; ++bj) { const f32x4 v0 = acc[ai][bj][m][0], v1 = acc[ai][bj][m][1];
                    u32x4 w; w.x = cvt_pk_bf16(v0[0], v0[1]); w.y = cvt_pk_bf16(v0[2], v0[3]); w.z = cvt_pk_bf16(v1[0], v1[1]); w.w = cvt_pk_bf16(v1[2], v1[3]);
                    *(u32x4*)(rowp + bj * HALF) = w; } }
    }
};
struct EpiGateUp {
    static constexpr bool PERM = true;
    bf16_t* O;
    __device__ __forceinline__ void operator()(const f32x4 (&acc)[2][2][4][2], const Unit& u, int wr, int wc, int fr, int fq) const {
        const int row0 = u.pm * BM + wr * 64 + fr, col0 = u.pn * BM + wc * 32 + 8 * fq;
#pragma unroll
        for (int ai = 0; ai < 2; ++ai)
#pragma unroll
            for (int m = 0; m < 4; ++m) { bf16_t* rowp = O + (size_t)(row0 + ai * HALF + m * 16) * DEXP;
#pragma unroll
                for (int bj = 0; bj < 2; ++bj) { const f32x4 g = acc[ai][bj][m][0], uu = acc[ai][bj][m][1]; float a[4];
#pragma unroll
                    for (int k = 0; k < 4; ++k) { const float s = __builtin_amdgcn_rcpf(1.f + __builtin_amdgcn_exp2f(-g[k] * LOG2E)); a[k] = g[k] * s * uu[k]; }
                    u32x2 w; w.x = cvt_pk_bf16(a[0], a[1]); w.y = cvt_pk_bf16(a[2], a[3]);
                    *(u32x2*)(rowp + ((col0 + bj * HALF) >> 1)) = w; } }
    }
};

template <class Epi, class Sched>
__device__ __forceinline__ void gemm_phase(const int tid, LAS unsigned char* lds, const int K, const Sched& S, const Epi& E) {
    const int wid = __builtin_amdgcn_readfirstlane(tid >> 6), lane = tid & 63, wr = wid >> 2, wc = wid & 3, fr = lane & 15, fq = lane >> 4;
    const int nt = K / BK;
    int Ra[2], Ca[2]; unsigned voffB[2];
#pragma unroll
    for (int i = 0; i < 2; ++i) { int R, C; stage_rc(tid * 16 + i * 8192, R, C); Ra[i] = R; Ca[i] = C; const int Rb = Epi::PERM ? ((R & ~31) + perm32(R & 31)) : R;
        voffB[i] = (unsigned)(Rb * K + C) * 2u; }
    const size_t kstep = (size_t)(BK * 2);
    const size_t hstep = (size_t)HALF * K * 2;
    const unsigned ldsw = (unsigned)wid * 1024u;
    const int aoff = lds_byte(wr * 64 + fr, fq * 8), boff = lds_byte(wc * 32 + fr, fq * 8);
#define PG8_SA(b, h) (((b) * 2 + (h)) * HTB)
#define PG8_SB(b, h) ((4 + (b) * 2 + (h)) * HTB)
#define PG8_STAGE(bufoff, gbase, voff) do { _Pragma("unroll") for (int _i = 0; _i < 2; ++_i) \
        __builtin_amdgcn_global_load_lds((const unsigned*)((const char*)(gbase) + (voff)[_i]), (LAS unsigned*)(lds + (bufoff) + ldsw + _i * 8192), 16, 0, 0); } while (0)
#define PG8_LDA(dst, b, h) do { _Pragma("unroll") for (int m = 0; m < 4; ++m) _Pragma("unroll") for (int k = 0; k < 2; ++k) dst[m][k] = *(const LAS bf16x8*)(lds + PG8_SA(b, h) + aoff + m * 2048 + k * 1024); } while (0)
#define PG8_LDB(dst, b, h) do { _Pragma("unroll") for (int n = 0; n < 2; ++n) _Pragma("unroll") for (int k = 0; k < 2; ++k) dst[n][k] = *(const LAS bf16x8*)(lds + PG8_SB(b, h) + boff + n * 2048 + k * 1024); } while (0)
#define PG8_MMA(ai, bj, At, Bt) do { __builtin_amdgcn_s_setprio(1); _Pragma("unroll") for (int m = 0; m < 4; ++m) _Pragma("unroll") for (int n = 0; n < 2; ++n) _Pragma("unroll") for (int k = 0; k < 2; ++k) \
        acc[ai][bj][m][n] = __builtin_amdgcn_mfma_f32_16x16x32_bf16(Bt[n][k], At[m][k], acc[ai][bj][m][n], 0, 0, 0); __builtin_amdgcn_s_setprio(0); } while (0)
#define PG8_WAIT_V(n) asm volatile("s_waitcnt vmcnt(" #n ")" ::: "memory")
#define PG8_WAIT_L(n) asm volatile("s_waitcnt lgkmcnt(" #n ")" ::: "memory")
#define PG8_BAR __builtin_amdgcn_s_barrier()
#define PG8_SCHED __builtin_amdgcn_sched_barrier(0)
    Unit cur, nxt; int ui = 0;
    if (!S.next(0, cur)) return;
    f32x4 acc[2][2][4][2];
#pragma unroll
    for (int a = 0; a < 2; ++a)
#pragma unroll
        for (int b = 0; b < 2; ++b)
#pragma unroll
            for (int m = 0; m < 4; ++m)
#pragma unroll
                for (int n = 0; n < 2; ++n) acc[a][b][m][n] = (f32x4){0.f, 0.f, 0.f, 0.f};
    bf16x8 At[4][2], B0[2][2], B1[2][2];
    const char* cA = S.a_base(cur); const char* cB = S.b_base(cur);
    unsigned cv0[2], cv1[2], sv0[2], sv1[2];
    S.voffs(cur, Ra, Ca, cv0, cv1);
#define PG8_STAGE_A(bufoff, gbase, half, sel) do { if constexpr (Sched::GATHER) { if (half) { if (sel) PG8_STAGE(bufoff, gbase, sv1); else PG8_STAGE(bufoff, gbase, cv1); } else { if (sel) PG8_STAGE(bufoff, gbase, sv0); else PG8_STAGE(bufoff, gbase, cv0); } } \
        else PG8_STAGE(bufoff, (gbase) + (half) * hstep, cv0); } while (0)
    PG8_STAGE(PG8_SB(0, 0), cB, voffB); PG8_STAGE(PG8_SB(0, 1), cB + hstep, voffB); PG8_STAGE_A(PG8_SA(0, 0), cA, 0, 0); PG8_STAGE_A(PG8_SA(0, 1), cA, 1, 0);
    if (wr == 1) PG8_BAR;
    PG8_WAIT_V(2); PG8_BAR;
    PG8_STAGE(PG8_SB(1, 0), cB + kstep, voffB); PG8_STAGE_A(PG8_SA(1, 0), cA + kstep, 0, 0); PG8_STAGE(PG8_SB(1, 1), cB + hstep + kstep, voffB);
    PG8_WAIT_V(6); PG8_BAR;
    for (;;) {
        const bool has_next = S.next(ui + 1, nxt);
        const char* nA = cA; const char* nB = cB;
        if (has_next) { nA = S.a_base(nxt); nB = S.b_base(nxt); }
        if constexpr (Sched::GATHER) {
            u32x4 q = {cv0[0], cv0[1], cv1[0], cv1[1]};
            if (has_next) { unsigned t0[2], t1[2]; S.voffs(nxt, Ra, Ca, t0, t1); q = (u32x4){t0[0], t0[1], t1[0], t1[1]}; }
            *(LAS u32x4*)(lds + NV_OFF + tid * 16) = q;
        }
        for (int t = 0; t < nt; t += 2) {
            const bool last = (t == nt - 2);
            const char* a1 = cA + (size_t)(t + 1) * kstep;
            const char* a2 = last ? nA : cA + (size_t)(t + 2) * kstep; const char* b2 = last ? nB : cB + (size_t)(t + 2) * kstep;
            const char* a3 = a2 + kstep; const char* b3 = b2 + kstep;
            if constexpr (Sched::GATHER) {
                sv0[0] = cv0[0]; sv0[1] = cv0[1]; sv1[0] = cv1[0]; sv1[1] = cv1[1];
                if (last) { const u32x4 q = *(const LAS u32x4*)(lds + NV_OFF + tid * 16); sv0[0] = q.x; sv0[1] = q.y; sv1[0] = q.z; sv1[1] = q.w; }
            }
            PG8_LDB(B0, 0, 0); PG8_LDB(B1, 0, 1); PG8_SCHED; PG8_LDA(At, 0, 0); PG8_STAGE_A(PG8_SA(1, 1), a1, 1, 0);
            PG8_WAIT_V(8); PG8_WAIT_L(0); PG8_BAR; PG8_MMA(0, 0, At, B0); PG8_MMA(0, 1, At, B1); PG8_BAR; PG8_SCHED;
            PG8_LDA(At, 0, 1); PG8_STAGE(PG8_SB(0, 0), b2, voffB); PG8_STAGE(PG8_SB(0, 1), b2 + hstep, voffB); PG8_STAGE_A(PG8_SA(0, 0), a2, 0, 1);
            PG8_WAIT_V(8); PG8_WAIT_L(0); PG8_BAR; PG8_MMA(1, 0, At, B0); PG8_MMA(1, 1, At, B1); PG8_BAR; PG8_SCHED;
            PG8_LDB(B0, 1, 0); PG8_LDB(B1, 1, 1); PG8_SCHED; PG8_LDA(At, 1, 0); PG8_STAGE_A(PG8_SA(0, 1), a2, 1, 1);
            PG8_WAIT_V(8); PG8_WAIT_L(0); PG8_BAR; PG8_MMA(0, 0, At, B0); PG8_MMA(0, 1, At, B1); PG8_BAR; PG8_SCHED;
            PG8_LDA(At, 1, 1); PG8_STAGE(PG8_SB(1, 0), b3, voffB); PG8_STAGE(PG8_SB(1, 1), b3 + hstep, voffB); PG8_STAGE_A(PG8_SA(1, 0), a3, 0, 1);
            PG8_WAIT_V(8); PG8_WAIT_L(0); PG8_BAR; PG8_MMA(1, 0, At, B0); PG8_MMA(1, 1, At, B1); PG8_BAR; PG8_SCHED;
        }
        if (wr == 0) PG8_BAR;
        E(acc, cur, wr, wc, fr, fq);
        if (!has_next) break;
#pragma unroll
        for (int a = 0; a < 2; ++a)
#pragma unroll
            for (int b = 0; b < 2; ++b)
#pragma unroll
                for (int m = 0; m < 4; ++m)
#pragma unroll
                    for (int n = 0; n < 2; ++n) acc[a][b][m][n] = (f32x4){0.f, 0.f, 0.f, 0.f};
        cur = nxt; cA = nA; cB = nB; ++ui;
        if constexpr (Sched::GATHER) { cv0[0] = sv0[0]; cv0[1] = sv0[1]; cv1[0] = sv1[0]; cv1[1] = sv1[1]; }
        if (wr == 1) PG8_BAR;
    }
    PG8_WAIT_V(0);
    PG8_BAR;
#undef PG8_SA
#undef PG8_SB
#undef PG8_STAGE
#undef PG8_STAGE_A
#undef PG8_LDA
#undef PG8_LDB
#undef PG8_MMA
#undef PG8_WAIT_V
#undef PG8_WAIT_L
#undef PG8_BAR
#undef PG8_SCHED
}
}

namespace att {
constexpr int NW = 8, QBLK = 32, KVBLK = 64;
constexpr int SHM_V = 16384, SHM_K = 16384;
constexpr int SHM_ATTN = 2 * SHM_V + 2 * SHM_K + NW * 64 * 4;
constexpr float THR = 8.f;
#define SBAR() __builtin_amdgcn_sched_barrier(0)
__device__ __forceinline__ int crow(int r, int hi) { return (r & 3) + 8 * (r >> 2) + 4 * hi; }
__device__ __forceinline__ unsigned cvtpk(float lo, float hi) { unsigned r; asm volatile("v_cvt_pk_bf16_f32 %0, %1, %2" : "=v"(r) : "v"(lo), "v"(hi)); return r; }
template <int DQK> __device__ __forceinline__ int kswz(int row, int colB) {
    if constexpr (DQK == 128) return row * 256 + (colB ^ ((row & 7) << 4));
    else return row * 128 + (colB ^ (((row >> 1) & 7) << 4));
}
template <int DQK> __device__ __forceinline__ void partialSM(f32x16& p0, f32x16& p1, float& m_reg, float& mn, float& alpha) {
    constexpr float SCALE = (DQK == 128) ? 0.088388347648318440f : 0.125f;
    constexpr float C = SCALE * LOG2E;
    float pmax = p0[0];
#pragma unroll
    for (int r = 1; r < 16; ++r) pmax = fmaxf(pmax, p0[r]);
#pragma unroll
    for (int r = 0; r < 16; ++r) pmax = fmaxf(pmax, p1[r]);
    { auto rr = __builtin_amdgcn_permlane32_swap(__float_as_uint(pmax), __float_as_uint(pmax), false, false);
      pmax = fmaxf(__uint_as_float(rr[0]), __uint_as_float(rr[1])); }
    if (__builtin_expect(__all(pmax - m_reg <= THR / SCALE), 1)) { mn = m_reg; alpha = 1.f; }
    else { mn = fmaxf(m_reg, pmax); alpha = __builtin_amdgcn_exp2f((m_reg - mn) * C); m_reg = mn; }
    const float mnC = -mn * C;
#pragma unroll
    for (int r = 0; r < 16; ++r) p0[r] = fmaf(p0[r], C, mnC);
#pragma unroll
    for (int r = 0; r < 16; ++r) p1[r] = fmaf(p1[r], C, mnC);
#pragma unroll
    for (int r = 0; r < 16; ++r) p0[r] = __builtin_amdgcn_exp2f(p0[r]);
}
__device__ __forceinline__ void finishSM(f32x16& p0, f32x16& p1, float alpha, float& l_reg, bf16x8& pa0, bf16x8& pa1, bf16x8& pa2, bf16x8& pa3) {
#pragma unroll
    for (int r = 0; r < 16; ++r) p1[r] = __builtin_amdgcn_exp2f(p1[r]);
    float ps = 0;
#pragma unroll
    for (int r = 0; r < 16; ++r) ps += p0[r];
#pragma unroll
    for (int r = 0; r < 16; ++r) ps += p1[r];
    { auto rr = __builtin_amdgcn_permlane32_swap(__float_as_uint(ps), __float_as_uint(ps), false, false);
      ps = __uint_as_float(rr[0]) + __uint_as_float(rr[1]); }
    l_reg = l_reg * alpha + ps;
#define PK4(P, BASE, OUT) do { unsigned a0 = cvtpk(P[BASE + 0], P[BASE + 1]), a1 = cvtpk(P[BASE + 2], P[BASE + 3]);   \
    unsigned b0 = cvtpk(P[BASE + 4], P[BASE + 5]), b1 = cvtpk(P[BASE + 6], P[BASE + 7]);                              \
    auto r0 = __builtin_amdgcn_permlane32_swap(a0, b0, false, false); auto r1 = __builtin_amdgcn_permlane32_swap(a1, b1, false, false); \
    u32x4 w = {r0[0], r1[0], r0[1], r1[1]}; OUT = *reinterpret_cast<bf16x8*>(&w); } while (0)
    PK4(p0, 0, pa0); PK4(p0, 8, pa1); PK4(p1, 0, pa2); PK4(p1, 8, pa3);
#undef PK4
}
template <int DQK> __device__ __forceinline__ void qkt(f32x16& p0, f32x16& p1, const char* Ks, const bf16x8* qr, int r32, int hi) {
    p0 = f32x16{}; p1 = f32x16{};
#pragma unroll
    for (int d0 = 0; d0 < DQK / 16; ++d0) { const int cb = (d0 * 16 + hi * 8) * 2;
        bf16x8 b0 = *reinterpret_cast<const bf16x8*>(Ks + kswz<DQK>(r32, cb));
        bf16x8 b1 = *reinterpret_cast<const bf16x8*>(Ks + kswz<DQK>(32 + r32, cb));
        p0 = __builtin_amdgcn_mfma_f32_32x32x16_bf16(b0, qr[d0], p0, 0, 0, 0);
        p1 = __builtin_amdgcn_mfma_f32_32x32x16_bf16(b1, qr[d0], p1, 0, 0, 0); }
}
__device__ __forceinline__ void wmask(f32x16& p0, f32x16& p1, int k0, int q0lat, int qrel, int hi) {
    const int dbase = k0 - 384 - qrel, pbase = q0lat + k0 - 384;
#pragma unroll
    for (int r = 0; r < 16; ++r) {
        const int kk = crow(r, hi);
        { const int d = dbase + kk, kp = pbase + kk; const bool ok = (d >= -128) && (d <= 128) && (kp >= 0) && (kp < SEQ); p0[r] = ok ? p0[r] : -1e30f; }
        { const int d = dbase + kk + 32, kp = pbase + kk + 32; const bool ok = (d >= -128) && (d <= 128) && (kp >= 0) && (kp < SEQ); p1[r] = ok ? p1[r] : -1e30f; }
    }
}
template <int NCB> __device__ __forceinline__ int v_st(int k, int c) { const int kk = (k & ~0xC) | ((k & 4) << 1) | ((k & 8) >> 1); return ((kk >> 3) * NCB + (c >> 5)) * 512 + ((kk & 7) * 32 + (c & 31)) * 2; }
__device__ __forceinline__ int v_rd_base(int lane) { return ((lane & 3) << 3) | (((lane >> 2) & 3) << 6) | (((lane >> 4) & 1) << 5) | (((lane >> 5) & 1) << 8); }
template <int NCB> constexpr int v_rd_off(int d0, int ks, int half) { return d0 * 512 + ks * (1024 * NCB) + half * (512 * NCB); }
template <int OFF> __device__ __forceinline__ s16x4 tr_read(int vb) {
    s16x4 r; asm volatile("ds_read_b64_tr_b16 %0, %1 offset:%2" : "=&v"(r) : "v"(vb), "i"(OFF) : "memory"); return r;
}
template <int NCB, int D0> __device__ __forceinline__ void pv_one(f32x16& od, int vb, bf16x8 pa0, bf16x8 pa1, bf16x8 pa2, bf16x8 pa3) {
    const s16x4 l0 = tr_read<v_rd_off<NCB>(D0, 0, 0)>(vb), h0 = tr_read<v_rd_off<NCB>(D0, 0, 1)>(vb), l1 = tr_read<v_rd_off<NCB>(D0, 1, 0)>(vb), h1 = tr_read<v_rd_off<NCB>(D0, 1, 1)>(vb);
    const s16x4 l2 = tr_read<v_rd_off<NCB>(D0, 2, 0)>(vb), h2 = tr_read<v_rd_off<NCB>(D0, 2, 1)>(vb), l3 = tr_read<v_rd_off<NCB>(D0, 3, 0)>(vb), h3 = tr_read<v_rd_off<NCB>(D0, 3, 1)>(vb);
    asm volatile("s_waitcnt lgkmcnt(0)" ::: "memory"); SBAR();
#define PK(L, H) (bf16x8){L[0], L[1], L[2], L[3], H[0], H[1], H[2], H[3]}
    od = __builtin_amdgcn_mfma_f32_32x32x16_bf16(pa0, PK(l0, h0), od, 0, 0, 0);
    od = __builtin_amdgcn_mfma_f32_32x32x16_bf16(pa1, PK(l1, h1), od, 0, 0, 0);
    od = __builtin_amdgcn_mfma_f32_32x32x16_bf16(pa2, PK(l2, h2), od, 0, 0, 0);
    od = __builtin_amdgcn_mfma_f32_32x32x16_bf16(pa3, PK(l3, h3), od, 0, 0, 0);
#undef PK
}
template <int NCB> __device__ __forceinline__ void pv_d0(f32x16* o, int vb, bf16x8 pa0, bf16x8 pa1, bf16x8 pa2, bf16x8 pa3) {
    pv_one<NCB, 0>(o[0], vb, pa0, pa1, pa2, pa3); pv_one<NCB, 1>(o[1], vb, pa0, pa1, pa2, pa3);
    if constexpr (NCB == 4) { pv_one<NCB, 2>(o[2], vb, pa0, pa1, pa2, pa3); pv_one<NCB, 3>(o[3], vb, pa0, pa1, pa2, pa3); }
}


template <int DQK>
__device__ __forceinline__ float prep_q_x(float (&x)[DQK / 16][8], const bf16_t* Qw, const float* g, const float* T, int tpos, int hi) {
    constexpr int NQF = DQK / 16, QUART = DQK / 4, NB2 = NQF / 4;
    float ss = 0.f;
#pragma unroll
    for (int b = 0; b < NQF; ++b) { const bf16x8 v = *reinterpret_cast<const bf16x8*>(Qw + b * 16);
#pragma unroll
        for (int j = 0; j < 8; ++j) { x[b][j] = __uint_as_float(((unsigned)(unsigned short)v[j]) << 16); ss = fmaf(x[b][j], x[b][j], ss); } }
    if (g) {
        { auto rr = __builtin_amdgcn_permlane32_swap(__float_as_uint(ss), __float_as_uint(ss), false, false); ss = __uint_as_float(rr[0]) + __uint_as_float(rr[1]); }
        const float rs = 1.f / sqrtf(ss * (1.f / DQK) + QK_EPS); ss = 0.f;
#pragma unroll
        for (int b = 0; b < NQF; ++b) { const f32x4 g0 = *(const f32x4*)(g + b * 16 + hi * 8), g1 = *(const f32x4*)(g + b * 16 + hi * 8 + 4);
#pragma unroll
            for (int j = 0; j < 8; ++j) { x[b][j] *= rs * (j < 4 ? g0[j & 3] : g1[j & 3]); ss = fmaf(x[b][j], x[b][j], ss); } }
    }
    if (tpos >= 0) {
#pragma unroll
        for (int ty = 0; ty < 2; ++ty) { const int pos = ty ? (tpos & 63) : (tpos >> 6);
#pragma unroll
            for (int bb = 0; bb < NB2; ++bb) { const int b1 = ty * 2 * NB2 + bb, b2 = b1 + NB2; const float* tp = T + (pos * QUART + bb * 16 + hi * 8) * 2;
#pragma unroll
                for (int jj = 0; jj < 4; ++jj) { const f32x4 cs = *(const f32x4*)(tp + 4 * jj);
                    { const float x1 = x[b1][2 * jj], x2 = x[b2][2 * jj]; x[b1][2 * jj] = x1 * cs.x - x2 * cs.y; x[b2][2 * jj] = x1 * cs.y + x2 * cs.x; }
                    { const float x1 = x[b1][2 * jj + 1], x2 = x[b2][2 * jj + 1]; x[b1][2 * jj + 1] = x1 * cs.z - x2 * cs.w; x[b2][2 * jj + 1] = x1 * cs.w + x2 * cs.z; } } } }
    }
    { auto rr = __builtin_amdgcn_permlane32_swap(__float_as_uint(ss), __float_as_uint(ss), false, false); ss = __uint_as_float(rr[0]) + __uint_as_float(rr[1]); }
    return ss;
}
template <int DQK>
__device__ __forceinline__ float prep_q(bf16x8 (&qr)[DQK / 16], const bf16_t* Qw, const float* g, const float* T, int tpos, int hi, float pre) {
    constexpr int NQF = DQK / 16;
    float x[NQF][8];
    const float ss = prep_q_x<DQK>(x, Qw, g, T, tpos, hi);
#pragma unroll
    for (int b = 0; b < NQF; ++b) { u32x4 w;
#pragma unroll
        for (int j = 0; j < 4; ++j) w[j] = cvtpk(x[b][2 * j] * pre, x[b][2 * j + 1] * pre);
        qr[b] = *reinterpret_cast<bf16x8*>(&w); }
    return ss;
}
template <int DQK, int DV, bool WINDOW, int SDEPTH>
__device__ __forceinline__ void attn_core(const int tid, const bf16_t* Qb, int ldq, const bf16_t* Kb, const bf16_t* Vb, int ldk, int seq, int q0lat, float m_init, float l_init, char* lds, f32x16 (&o)[DV / 32], const float* ropeT, int tpos0) {
    constexpr int NCB = DV / 32, NQF = DQK / 16, NKL = DQK / 64, NVL = DV / 64;
    constexpr float SCALE = (DQK == 128) ? 0.088388347648318440f : 0.125f;
    constexpr float C = SCALE * LOG2E;
    const int wid = tid >> 6, lane = tid & 63, r32 = lane & 31, hi = lane >> 5;
    char* V_lds = lds; char* K_lds = lds + 2 * SHM_V;
    float* ws = (float*)(lds + 2 * SHM_V + 2 * SHM_K) + wid * 64; float* li_l = ws; float* al_l = ws + 32;
    float m_reg = m_init, l_reg = l_init; bf16x8 qr[NQF];
#pragma unroll
    for (int d = 0; d < NCB; ++d) o[d] = f32x16{};
    const bf16_t* Qw = Qb + (long)(wid * QBLK + r32) * ldq + hi * 8;
    (void)prep_q<DQK>(qr, Qw, nullptr, ropeT, tpos0 >= 0 ? tpos0 + wid * QBLK + r32 : -1, hi, 1.f);
    int krow[NKL], vrow[NVL], kst[NKL], vst[NVL]; int kcol, vcol;
    if constexpr (DQK == 128) { kcol = (tid & 15) * 8; krow[0] = tid >> 4; krow[1] = 32 + (tid >> 4); } else { kcol = (tid & 7) * 8; krow[0] = tid >> 3; }
    if constexpr (DV == 128) { vcol = (tid & 15) * 8; vrow[0] = tid >> 4; vrow[1] = 32 + (tid >> 4); } else { vcol = (tid & 7) * 8; vrow[0] = tid >> 3; }
#pragma unroll
    for (int i = 0; i < NKL; ++i) kst[i] = kswz<DQK>(krow[i], kcol * 2);
#pragma unroll
    for (int i = 0; i < NVL; ++i) vst[i] = v_st<NCB>(vrow[i], vcol);
    const int vb0 = (int)(uintptr_t)V_lds + v_rd_base(lane);
    struct { bf16x8 v[NVL]; bf16x8 k[NKL]; } sr_[SDEPTH];
    unsigned voffv[NVL], voffk[NKL];
#pragma unroll
    for (int i = 0; i < NVL; ++i) voffv[i] = (unsigned)(vrow[i] * ldk + vcol) * 2u;
#pragma unroll
    for (int i = 0; i < NKL; ++i) voffk[i] = (unsigned)(krow[i] * ldk + kcol) * 2u;
#define TROW(k0) (WINDOW ? (((k0) < 256) ? (k0) : (((q0lat + (k0) - 128) > (MROWS - 64)) ? (MROWS - 64) : (q0lat + (k0) - 128))) : (k0))
#define SLOAD(i, k0) do { const size_t _tb = (size_t)TROW(k0) * (size_t)ldk * 2; const char* _vb = (const char*)Vb + _tb; const char* _kb = (const char*)Kb + _tb; \
    _Pragma("unroll") for (int _j = 0; _j < NVL; ++_j) sr_[i].v[_j] = *reinterpret_cast<const bf16x8*>(_vb + voffv[_j]); \
    _Pragma("unroll") for (int _j = 0; _j < NKL; ++_j) sr_[i].k[_j] = *reinterpret_cast<const bf16x8*>(_kb + voffk[_j]); } while (0)
#define SWRITE(b, i) do { _Pragma("unroll") for (int _j = 0; _j < NVL; ++_j) *(bf16x8*)(V_lds + (b) * SHM_V + vst[_j]) = sr_[i].v[_j]; \
    _Pragma("unroll") for (int _j = 0; _j < NKL; ++_j) *(bf16x8*)(K_lds + (b) * SHM_K + kst[_j]) = sr_[i].k[_j]; } while (0)
#define SWAIT() do { if constexpr (SDEPTH == 1) asm volatile("s_waitcnt vmcnt(0)" ::: "memory"); else if constexpr (NKL + NVL == 4) asm volatile("s_waitcnt vmcnt(4)" ::: "memory"); else if constexpr (NKL + NVL == 3) asm volatile("s_waitcnt vmcnt(3)" ::: "memory"); else asm volatile("s_waitcnt vmcnt(2)" ::: "memory"); } while (0)
#define RESC(a) do { if (__any((a) < 1.f)) { if (hi == 0) al_l[r32] = (a); asm volatile("s_waitcnt lgkmcnt(0)" ::: "memory"); \
    _Pragma("unroll") for (int d = 0; d < NCB; ++d) _Pragma("unroll") for (int r = 0; r < 16; ++r) o[d][r] *= al_l[crow(r, hi)]; } } while (0)
#define WMASK(p0, p1, jt) do { if constexpr (WINDOW) { if ((jt) * KVBLK >= 256) wmask(p0, p1, (jt) * KVBLK, q0lat, wid * QBLK + r32, hi); } } while (0)
    f32x16 pA0, pA1, pB0, pB1; float mnA, mnB, alA, alB; bf16x8 pa0, pa1, pa2, pa3; const int NT = seq / KVBLK;
    constexpr int SE = 0, SO = SDEPTH - 1;
    SLOAD(SE, 0); asm volatile("s_waitcnt vmcnt(0)" ::: "memory"); SWRITE(0, SE); __syncthreads();
    qkt<DQK>(pA0, pA1, K_lds, qr, r32, hi); WMASK(pA0, pA1, 0); partialSM<DQK>(pA0, pA1, m_reg, mnA, alA);
    SLOAD(SO, KVBLK); if constexpr (SDEPTH == 2) { if (2 < NT) SLOAD(SE, 2 * KVBLK); }
    SWAIT(); SWRITE(1, SO); __syncthreads();
    for (int j = 1; j + 1 < NT; j += 2) {
        SBAR(); qkt<DQK>(pB0, pB1, K_lds + SHM_K, qr, r32, hi); WMASK(pB0, pB1, j);
        finishSM(pA0, pA1, alA, l_reg, pa0, pa1, pa2, pa3); SBAR();
        SLOAD(SO, (j + SDEPTH) * KVBLK); SBAR();
        pv_d0<NCB>(o, vb0, pa0, pa1, pa2, pa3); partialSM<DQK>(pB0, pB1, m_reg, mnB, alB);
        __syncthreads(); SWAIT(); SWRITE(0, SE);
        RESC(alB); __syncthreads();
        SBAR(); qkt<DQK>(pA0, pA1, K_lds, qr, r32, hi); WMASK(pA0, pA1, j + 1);
        finishSM(pB0, pB1, alB, l_reg, pa0, pa1, pa2, pa3); SBAR();
        if (SDEPTH == 1 || j + 3 < NT) SLOAD(SE, (j + 1 + SDEPTH) * KVBLK); SBAR();
        pv_d0<NCB>(o, vb0 + SHM_V, pa0, pa1, pa2, pa3); partialSM<DQK>(pA0, pA1, m_reg, mnA, alA);
        __syncthreads(); SWAIT(); SWRITE(1, SO);
        RESC(alA); __syncthreads();
    }
    SBAR(); qkt<DQK>(pB0, pB1, K_lds + SHM_K, qr, r32, hi); WMASK(pB0, pB1, NT - 1);
    finishSM(pA0, pA1, alA, l_reg, pa0, pa1, pa2, pa3); SBAR();
    pv_d0<NCB>(o, vb0, pa0, pa1, pa2, pa3); partialSM<DQK>(pB0, pB1, m_reg, mnB, alB);
    __syncthreads(); RESC(alB);
    finishSM(pB0, pB1, alB, l_reg, pa0, pa1, pa2, pa3); SBAR();
    pv_d0<NCB>(o, vb0 + SHM_V, pa0, pa1, pa2, pa3);
    if (hi == 0) li_l[r32] = l_reg; asm volatile("s_waitcnt lgkmcnt(0)" ::: "memory");
#pragma unroll
    for (int r = 0; r < 16; ++r) { const float rl = __builtin_amdgcn_rcpf(li_l[crow(r, hi)]);
#pragma unroll
        for (int d = 0; d < NCB; ++d) o[d][r] *= rl; }
    __syncthreads();
#undef TROW
#undef SLOAD
#undef SWRITE
#undef SWAIT
#undef RESC
#undef WMASK
}
template <int NCB> __device__ __forceinline__ void store_o_bf16(const int tid, const f32x16 (&o)[NCB], bf16_t* O, int ldo) {
    const int wid = tid >> 6, lane = tid & 63, r32 = lane & 31, hi = lane >> 5;
    bf16_t* Ow = O + (long)(wid * QBLK) * ldo + r32;
#pragma unroll
    for (int r = 0; r < 16; ++r) { const int orow = crow(r, hi);
#pragma unroll
        for (int d = 0; d < NCB; ++d) Ow[(long)orow * ldo + d * 32] = (bf16_t)(cvtpk(o[d][r], 0.f) & 0xffffu); }
}

typedef float f32x2_t __attribute__((ext_vector_type(2)));
typedef __bf16 bf16x2_t __attribute__((ext_vector_type(2)));
typedef short v4i16_t __attribute__((ext_vector_type(4)));
__device__ __forceinline__ unsigned cvtpk_s(float lo, float hi) { f32x2_t v = {lo, hi}; bf16x2_t b = __builtin_convertvector(v, bf16x2_t); return __builtin_bit_cast(unsigned, b); }
__device__ __forceinline__ s16x4 vtr(int addr) { return __builtin_bit_cast(s16x4, __builtin_amdgcn_ds_read_tr16_b64_v4i16((LAS v4i16_t*)(uintptr_t)(unsigned)addr)); }
__device__ __forceinline__ float bfv(short x) { return __uint_as_float(((unsigned)(unsigned short)x) << 16); }
template <int DQK> __device__ __forceinline__ void qkt_init(f32x16& p0, f32x16& p1, float init, const char* Ks, const bf16x8* qr, int r32, int hi) {
#pragma unroll
    for (int r = 0; r < 16; ++r) { p0[r] = init; p1[r] = init; }
#pragma unroll
    for (int d0 = 0; d0 < DQK / 16; ++d0) { const int cb = (d0 * 16 + hi * 8) * 2;
        bf16x8 b0 = *reinterpret_cast<const bf16x8*>(Ks + kswz<DQK>(r32, cb));
        bf16x8 b1 = *reinterpret_cast<const bf16x8*>(Ks + kswz<DQK>(32 + r32, cb));
        p0 = __builtin_amdgcn_mfma_f32_32x32x16_bf16(b0, qr[d0], p0, 0, 0, 0);
        p1 = __builtin_amdgcn_mfma_f32_32x32x16_bf16(b1, qr[d0], p1, 0, 0, 0); }
}
__device__ __forceinline__ void exp_half(f32x16& p) {
#pragma unroll
    for (int r = 0; r < 16; ++r) p[r] = __builtin_amdgcn_exp2f(p[r]);
}
__device__ __forceinline__ void finish_fixed(f32x16& p0, f32x16& p1, float& l_reg, bf16x8& pa0, bf16x8& pa1, bf16x8& pa2, bf16x8& pa3) {
    exp_half(p1);
    float ps = 0;
#pragma unroll
    for (int r = 0; r < 16; ++r) ps += p0[r];
#pragma unroll
    for (int r = 0; r < 16; ++r) ps += p1[r];
    l_reg += ps;
#define PK4(P, BASE, OUT) do { unsigned a0 = cvtpk(P[BASE + 0], P[BASE + 1]), a1 = cvtpk(P[BASE + 2], P[BASE + 3]);   \
    unsigned b0 = cvtpk(P[BASE + 4], P[BASE + 5]), b1 = cvtpk(P[BASE + 6], P[BASE + 7]);                              \
    auto r0 = __builtin_amdgcn_permlane32_swap(a0, b0, false, false); auto r1 = __builtin_amdgcn_permlane32_swap(a1, b1, false, false); \
    u32x4 w = {r0[0], r1[0], r0[1], r1[1]}; OUT = *reinterpret_cast<bf16x8*>(&w); } while (0)
    PK4(p0, 0, pa0); PK4(p0, 8, pa1); PK4(p1, 0, pa2); PK4(p1, 8, pa3);
#undef PK4
}
template <int DQK, int DV, int SDEPTH>
__device__ __forceinline__ void attn_core_fixed(const int tid, const bf16_t* Qb, int ldq, const bf16_t* Kb, const bf16_t* Vb, int ldk, int seq, float kmaxC, char* lds, f32x16 (&o)[DV / 32]) {
    constexpr int NCB = DV / 32, NQF = DQK / 16, NKL = DQK / 64, NVL = DV / 64;
    constexpr float SCALE = (DQK == 128) ? 0.088388347648318440f : 0.125f;
    constexpr float C = SCALE * LOG2E;
    const int wid = tid >> 6, lane = tid & 63, r32 = lane & 31, hi = lane >> 5;
    char* V_lds = lds; char* K_lds = lds + 2 * SHM_V;
    float* li_l = (float*)(lds + 2 * SHM_V + 2 * SHM_K) + wid * 64;
    float l_reg = 0.f; bf16x8 qr[NQF];
#pragma unroll
    for (int d = 0; d < NCB; ++d) o[d] = f32x16{};
    const bf16_t* Qw = Qb + (long)(wid * QBLK + r32) * ldq + hi * 8;
#pragma unroll
    for (int d0 = 0; d0 < NQF; ++d0) qr[d0] = *reinterpret_cast<const bf16x8*>(Qw + d0 * 16);
    float ssq = 0.f;
#pragma unroll
    for (int d0 = 0; d0 < NQF; ++d0) { u32x4 w;
#pragma unroll
        for (int j = 0; j < 4; ++j) { const float a = bfv(qr[d0][2 * j]), b = bfv(qr[d0][2 * j + 1]); ssq = fmaf(a, a, ssq); ssq = fmaf(b, b, ssq); w[j] = cvtpk(a * C, b * C); }
        qr[d0] = *reinterpret_cast<bf16x8*>(&w); }
    { auto rr = __builtin_amdgcn_permlane32_swap(__float_as_uint(ssq), __float_as_uint(ssq), false, false); ssq = __uint_as_float(rr[0]) + __uint_as_float(rr[1]); }
    const float ninit = -fmaxf(0.f, sqrtf(ssq) * kmaxC - 60.f);
    int krow[NKL], vrow[NVL], kst[NKL], vst[NVL]; int kcol, vcol;
    if constexpr (DQK == 128) { kcol = (tid & 15) * 8; krow[0] = tid >> 4; krow[1] = 32 + (tid >> 4); } else { kcol = (tid & 7) * 8; krow[0] = tid >> 3; }
    if constexpr (DV == 128) { vcol = (tid & 15) * 8; vrow[0] = tid >> 4; vrow[1] = 32 + (tid >> 4); } else { vcol = (tid & 7) * 8; vrow[0] = tid >> 3; }
#pragma unroll
    for (int i = 0; i < NKL; ++i) kst[i] = kswz<DQK>(krow[i], kcol * 2);
#pragma unroll
    for (int i = 0; i < NVL; ++i) vst[i] = v_st<NCB>(vrow[i], vcol);
    const int vb0 = (int)(uintptr_t)V_lds + v_rd_base(lane);
    struct { bf16x8 v[NVL]; bf16x8 k[NKL]; } sr_[SDEPTH];
    unsigned voffv[NVL], voffk[NKL];
#pragma unroll
    for (int i = 0; i < NVL; ++i) voffv[i] = (unsigned)(vrow[i] * ldk + vcol) * 2u;
#pragma unroll
    for (int i = 0; i < NKL; ++i) voffk[i] = (unsigned)(krow[i] * ldk + kcol) * 2u;
#define SLOAD(i, k0) do { const size_t _tb = (size_t)(k0) * (size_t)ldk * 2; const char* _vb = (const char*)Vb + _tb; const char* _kb = (const char*)Kb + _tb; \
    _Pragma("unroll") for (int _j = 0; _j < NVL; ++_j) sr_[i].v[_j] = *reinterpret_cast<const bf16x8*>(_vb + voffv[_j]); \
    _Pragma("unroll") for (int _j = 0; _j < NKL; ++_j) sr_[i].k[_j] = *reinterpret_cast<const bf16x8*>(_kb + voffk[_j]); } while (0)
#define SWRITE(b, i) do { _Pragma("unroll") for (int _j = 0; _j < NVL; ++_j) *(bf16x8*)(V_lds + (b) * SHM_V + vst[_j]) = sr_[i].v[_j]; \
    _Pragma("unroll") for (int _j = 0; _j < NKL; ++_j) *(bf16x8*)(K_lds + (b) * SHM_K + kst[_j]) = sr_[i].k[_j]; } while (0)
#define SWAIT() do { if constexpr (SDEPTH == 1) asm volatile("s_waitcnt vmcnt(0)" ::: "memory"); else if constexpr (NKL + NVL == 4) asm volatile("s_waitcnt vmcnt(4)" ::: "memory"); else if constexpr (NKL + NVL == 3) asm volatile("s_waitcnt vmcnt(3)" ::: "memory"); else asm volatile("s_waitcnt vmcnt(2)" ::: "memory"); } while (0)
    f32x16 pA0, pA1, pB0, pB1; bf16x8 pa0, pa1, pa2, pa3; const int NT = seq / KVBLK;
    constexpr int SE = 0, SO = SDEPTH - 1;
    SLOAD(SE, 0); asm volatile("s_waitcnt vmcnt(0)" ::: "memory"); SWRITE(0, SE); __syncthreads();
    qkt_init<DQK>(pA0, pA1, ninit, K_lds, qr, r32, hi); exp_half(pA0);
    SLOAD(SO, KVBLK); if constexpr (SDEPTH == 2) { if (2 < NT) SLOAD(SE, 2 * KVBLK); }
    SWAIT(); SWRITE(1, SO); __syncthreads();
    for (int j = 1; j + 1 < NT; j += 2) {
        SBAR(); qkt_init<DQK>(pB0, pB1, ninit, K_lds + SHM_K, qr, r32, hi);
        finish_fixed(pA0, pA1, l_reg, pa0, pa1, pa2, pa3); SBAR();
        SLOAD(SO, (j + SDEPTH) * KVBLK); SBAR();
        pv_d0<NCB>(o, vb0, pa0, pa1, pa2, pa3); SBAR(); exp_half(pB0); SBAR();
        __syncthreads(); SWAIT(); SWRITE(0, SE);
        __syncthreads();
        SBAR(); qkt_init<DQK>(pA0, pA1, ninit, K_lds, qr, r32, hi);
        finish_fixed(pB0, pB1, l_reg, pa0, pa1, pa2, pa3); SBAR();
        if (SDEPTH == 1 || j + 3 < NT) SLOAD(SE, (j + 1 + SDEPTH) * KVBLK); SBAR();
        pv_d0<NCB>(o, vb0 + SHM_V, pa0, pa1, pa2, pa3); SBAR(); exp_half(pA0); SBAR();
        __syncthreads(); SWAIT(); SWRITE(1, SO);
        __syncthreads();
    }
    SBAR(); qkt_init<DQK>(pB0, pB1, ninit, K_lds + SHM_K, qr, r32, hi);
    finish_fixed(pA0, pA1, l_reg, pa0, pa1, pa2, pa3); SBAR();
    pv_d0<NCB>(o, vb0, pa0, pa1, pa2, pa3); exp_half(pB0);
    __syncthreads();
    finish_fixed(pB0, pB1, l_reg, pa0, pa1, pa2, pa3); SBAR();
    pv_d0<NCB>(o, vb0 + SHM_V, pa0, pa1, pa2, pa3);
    { auto rr = __builtin_amdgcn_permlane32_swap(__float_as_uint(l_reg), __float_as_uint(l_reg), false, false); l_reg = __uint_as_float(rr[0]) + __uint_as_float(rr[1]); }
    if (hi == 0) li_l[r32] = l_reg; asm volatile("s_waitcnt lgkmcnt(0)" ::: "memory");
#pragma unroll
    for (int r = 0; r < 16; ++r) { const float rl = __builtin_amdgcn_rcpf(li_l[crow(r, hi)]);
#pragma unroll
        for (int d = 0; d < NCB; ++d) o[d][r] *= rl; }
    __syncthreads();
#undef SLOAD
#undef SWRITE
#undef SWAIT
}

constexpr int DMA_KRING = 0, DMA_VRING = 3 * SHM_K, DMA_SCR = 3 * SHM_K + 3 * SHM_V;
template <int DQK, int DV>
__device__ __forceinline__ void attn_core_dma(const int tid, const bf16_t* Qb, int ldq, const bf16_t* Kb, const bf16_t* Vb, int ldk, int seq, float kmaxC, LAS unsigned char* ldsl, f32x16 (&o)[DV / 32]) {
    static_assert(DV == 128, "V image is [64][128]");
    constexpr int NCB = DV / 32, NQF = DQK / 16, NKL = DQK / 64, NVL = DV / 64;
    constexpr float SCALE = (DQK == 128) ? 0.088388347648318440f : 0.125f;
    constexpr float C = SCALE * LOG2E;
    const int wid = __builtin_amdgcn_readfirstlane(tid >> 6), lane = tid & 63, r32 = lane & 31, hi = lane >> 5;
    char* lds = (char*)(unsigned char*)ldsl;
    char* K_lds = lds + DMA_KRING; char* V_lds = lds + DMA_VRING;
    float* li_l = (float*)(lds + DMA_SCR) + wid * 64;
    float l_reg = 0.f; bf16x8 qr[NQF];
#pragma unroll
    for (int d = 0; d < NCB; ++d) o[d] = f32x16{};
    const bf16_t* Qw = Qb + (long)(wid * QBLK + r32) * ldq + hi * 8;
#pragma unroll
    for (int d0 = 0; d0 < NQF; ++d0) qr[d0] = *reinterpret_cast<const bf16x8*>(Qw + d0 * 16);
    float ssq = 0.f;
#pragma unroll
    for (int d0 = 0; d0 < NQF; ++d0) { u32x4 w;
#pragma unroll
        for (int j = 0; j < 4; ++j) { const float a = bfv(qr[d0][2 * j]), b = bfv(qr[d0][2 * j + 1]); ssq = fmaf(a, a, ssq); ssq = fmaf(b, b, ssq); w[j] = cvtpk(a * C, b * C); }
        qr[d0] = *reinterpret_cast<bf16x8*>(&w); }
    { auto rr = __builtin_amdgcn_permlane32_swap(__float_as_uint(ssq), __float_as_uint(ssq), false, false); ssq = __uint_as_float(rr[0]) + __uint_as_float(rr[1]); }
    const float ninit = -fmaxf(0.f, sqrtf(ssq) * kmaxC - 60.f);
    unsigned srck[NKL], srcv[NVL];
#pragma unroll
    for (int i = 0; i < NKL; ++i) { const int b = (wid * NKL + i) * 1024 + lane * 16;
        if constexpr (DQK == 128) { const int row = b >> 8, colB = (b & 255) ^ ((row & 7) << 4); srck[i] = (unsigned)(row * ldk * 2 + colB); }
        else { const int row = b >> 7, colB = (b & 127) ^ (((row >> 1) & 7) << 4); srck[i] = (unsigned)(row * ldk * 2 + colB); } }
#pragma unroll
    for (int i = 0; i < NVL; ++i) { const int b = (wid * NVL + i) * 1024 + lane * 16; const int sub = b >> 9, kk = (sub >> 2) * 8 + ((b & 511) >> 6);
        const int k = (kk & ~0xC) | ((kk & 4) << 1) | ((kk & 8) >> 1), c = (sub & 3) * 32 + ((b & 63) >> 1); srcv[i] = (unsigned)(k * ldk * 2 + c * 2); }
    const int vb0 = (int)(uintptr_t)V_lds + v_rd_base(lane);
    const int NT = seq / KVBLK;
#define DMA_K(t, slot) do { const int _t = (t) < NT ? (t) : NT - 1; const char* _kb = (const char*)Kb + (size_t)_t * KVBLK * (size_t)ldk * 2; \
    _Pragma("unroll") for (int _i = 0; _i < NKL; ++_i) __builtin_amdgcn_global_load_lds((const unsigned*)(_kb + srck[_i]), (LAS unsigned*)(ldsl + DMA_KRING + (slot) * SHM_K + (wid * NKL + _i) * 1024), 16, 0, 0); } while (0)
#define DMA_V(t, slot) do { const int _t = (t) < NT ? (t) : NT - 1; const char* _vb = (const char*)Vb + (size_t)_t * KVBLK * (size_t)ldk * 2; \
    _Pragma("unroll") for (int _i = 0; _i < NVL; ++_i) __builtin_amdgcn_global_load_lds((const unsigned*)(_vb + srcv[_i]), (LAS unsigned*)(ldsl + DMA_VRING + (slot) * SHM_V + (wid * NVL + _i) * 1024), 16, 0, 0); } while (0)
#define DMA_WAIT_BAR() do { if constexpr (NKL + NVL == 4) asm volatile("s_waitcnt vmcnt(4)" ::: "memory"); else asm volatile("s_waitcnt vmcnt(3)" ::: "memory"); \
    __builtin_amdgcn_s_barrier(); SBAR(); } while (0)
#define NEXT3(x) ((x) == 2 ? 0 : (x) + 1)
    f32x16 pA0, pA1, pB0, pB1; bf16x8 pa0, pa1, pa2, pa3;
    DMA_K(0, 0); DMA_K(1, 1); DMA_V(0, 0);
    asm volatile("s_waitcnt vmcnt(0)" ::: "memory"); __builtin_amdgcn_s_barrier(); SBAR();
    DMA_K(2, 2); DMA_V(1, 1);
    qkt_init<DQK>(pA0, pA1, ninit, K_lds, qr, r32, hi); exp_half(pA0);
    DMA_WAIT_BAR();
    int ks = 1, vs = 0;
    for (int j = 1; j + 1 < NT; j += 2) {
        { const int kd = ks == 0 ? 2 : ks - 1, vd = vs == 0 ? 2 : vs - 1; DMA_K(j + 2, kd); DMA_V(j + 1, vd); }
        SBAR(); qkt_init<DQK>(pB0, pB1, ninit, K_lds + ks * SHM_K, qr, r32, hi);
        finish_fixed(pA0, pA1, l_reg, pa0, pa1, pa2, pa3); SBAR();
        pv_d0<NCB>(o, vb0 + vs * SHM_V, pa0, pa1, pa2, pa3); SBAR(); exp_half(pB0); SBAR();
        DMA_WAIT_BAR();
        ks = NEXT3(ks); vs = NEXT3(vs);
        { const int kd = ks == 0 ? 2 : ks - 1, vd = vs == 0 ? 2 : vs - 1; DMA_K(j + 3, kd); DMA_V(j + 2, vd); }
        SBAR(); qkt_init<DQK>(pA0, pA1, ninit, K_lds + ks * SHM_K, qr, r32, hi);
        finish_fixed(pB0, pB1, l_reg, pa0, pa1, pa2, pa3); SBAR();
        pv_d0<NCB>(o, vb0 + vs * SHM_V, pa0, pa1, pa2, pa3); SBAR(); exp_half(pA0); SBAR();
        DMA_WAIT_BAR();
        ks = NEXT3(ks); vs = NEXT3(vs);
    }
    SBAR(); qkt_init<DQK>(pB0, pB1, ninit, K_lds + ks * SHM_K, qr, r32, hi);
    finish_fixed(pA0, pA1, l_reg, pa0, pa1, pa2, pa3); SBAR();
    pv_d0<NCB>(o, vb0 + vs * SHM_V, pa0, pa1, pa2, pa3); SBAR(); exp_half(pB0); SBAR();
    asm volatile("s_waitcnt vmcnt(0)" ::: "memory"); __builtin_amdgcn_s_barrier(); SBAR();
    vs = NEXT3(vs);
    finish_fixed(pB0, pB1, l_reg, pa0, pa1, pa2, pa3); SBAR();
    pv_d0<NCB>(o, vb0 + vs * SHM_V, pa0, pa1, pa2, pa3);
    { auto rr = __builtin_amdgcn_permlane32_swap(__float_as_uint(l_reg), __float_as_uint(l_reg), false, false); l_reg = __uint_as_float(rr[0]) + __uint_as_float(rr[1]); }
    if (hi == 0) li_l[r32] = l_reg; asm volatile("s_waitcnt lgkmcnt(0)" ::: "memory");
#pragma unroll
    for (int r = 0; r < 16; ++r) { const float rl = __builtin_amdgcn_rcpf(li_l[crow(r, hi)]);
#pragma unroll
        for (int d = 0; d < NCB; ++d) o[d][r] *= rl; }
    __syncthreads();
#undef DMA_K
#undef DMA_V
#undef DMA_WAIT_BAR
#undef NEXT3
}

__device__ __forceinline__ void glds16(const void* gsrc, unsigned lds_dst) { unsigned keep;
    asm volatile("s_mov_b32 %0, m0\n\ts_mov_b32 m0, %2\n\ts_nop 0\n\tglobal_load_lds_dwordx4 %1, off\n\ts_mov_b32 m0, %0" : "=&s"(keep) : "v"(gsrc), "s"(lds_dst) : "memory"); }
template <int DQK>
__device__ __forceinline__ void attn_core_il(const int tid, const bf16_t* Qb, int ldq, const bf16_t* Kb, const bf16_t* Vb, int ldk, int seq, float kmaxC, LAS unsigned char* ldsl, f32x16 (&o)[4], const float* qgain, const float* ropeT, int tpos0) {
    constexpr int NQF = DQK / 16, NKL = DQK / 64, NVL = 2, NGA = 2 * NQF, NADD = 32 / NGA, NPK = 16 / NGA, NCG = DQK / 32;
    constexpr float SCALE = (DQK == 128) ? 0.088388347648318440f : 0.125f;
    constexpr float C = SCALE * LOG2E;
    typedef const LAS char* lds_cptr;
    const int wid = __builtin_amdgcn_readfirstlane(tid >> 6), lane = tid & 63, r32 = lane & 31, hi = lane >> 5;
    char* lds = (char*)(unsigned char*)ldsl; const unsigned ldsb = (unsigned)(uintptr_t)ldsl;
    float* li_l = (float*)(lds + DMA_SCR) + wid * 64;
    float l_reg = 0.f; bf16x8 qr[NQF];
#pragma unroll
    for (int d = 0; d < 4; ++d) o[d] = f32x16{};
    const bf16_t* Qw = Qb + (long)(wid * QBLK + r32) * ldq + hi * 8;
    const float ssq = prep_q<DQK>(qr, Qw, qgain, ropeT, tpos0 >= 0 ? tpos0 + wid * QBLK + r32 : -1, hi, C);
    f32x16 negm;
    { const float ninit = -fmaxf(0.f, sqrtf(ssq) * kmaxC - 60.f);
#pragma unroll
      for (int r = 0; r < 16; ++r) negm[r] = ninit; }
    asm volatile("" : "+v"(negm));
    unsigned srck[2 * NKL], srcv[2 * NVL];
#pragma unroll
    for (int i = 0; i < 2 * NKL; ++i) { const int p = (wid & 3) + 4 * i, rg = p / NCG, cg = p % NCG; srck[i] = (unsigned)((rg * 16 + (lane & 15)) * ldk + (cg * 4 + (lane >> 4)) * 8) * 2u; }
#pragma unroll
    for (int i = 0; i < 2 * NVL; ++i) { const int p = (wid & 3) + 4 * i; srcv[i] = (unsigned)((16 * (p & 3) + (lane >> 2)) * ldk + (p >> 2) * 32 + (lane & 3) * 8) * 2u; }
    const lds_cptr kp0 = (lds_cptr)ldsl + DMA_KRING + (r32 >> 4) * (NCG * 1024) + hi * 256 + (r32 & 15) * 16;
    const lds_cptr vp0 = (lds_cptr)ldsl + DMA_VRING + ((lane >> 4) & 1) * 32 + (lane & 3) * 8 + (4 * hi + ((lane & 15) >> 2)) * 64;
    const int NT = seq / KVBLK;
#define DMA_K(t, slot) do { const int _t = (t) < NT ? (t) : NT - 1; const char* _kb = (const char*)Kb + (size_t)_t * KVBLK * (size_t)ldk * 2; \
    if (wid < 4) { _Pragma("unroll") for (int _i = 0; _i < 2 * NKL; ++_i) glds16(_kb + srck[_i], (unsigned)__builtin_amdgcn_readfirstlane((int)(ldsb + DMA_KRING + (slot) * SHM_K + (wid + 4 * _i) * 1024))); } } while (0)
#define DMA_V(t, slot) do { const int _t = (t) < NT ? (t) : NT - 1; const char* _vb = (const char*)Vb + (size_t)_t * KVBLK * (size_t)ldk * 2; \
    if (wid < 4) { _Pragma("unroll") for (int _i = 0; _i < 2 * NVL; ++_i) glds16(_vb + srcv[_i], (unsigned)__builtin_amdgcn_readfirstlane((int)(ldsb + DMA_VRING + (slot) * SHM_V + (wid + 4 * _i) * 1024))); } } while (0)
#define WAIT_BAR_N() do { if constexpr (NKL + NVL == 4) asm volatile("s_waitcnt vmcnt(8) lgkmcnt(0)\n\ts_barrier" ::: "memory"); else asm volatile("s_waitcnt vmcnt(6) lgkmcnt(0)\n\ts_barrier" ::: "memory"); SBAR(); } while (0)
#define WAIT_BAR_0() do { asm volatile("s_waitcnt vmcnt(0) lgkmcnt(0)\n\ts_barrier" ::: "memory"); SBAR(); } while (0)
#define PIN(x) asm volatile("" : "+v"(x))
#define KFR(kp, g) (*(const LAS bf16x8*)((kp) + ((g) & 1) * (2 * NCG * 1024) + ((g) >> 2) * 1024 + (((g) >> 1) & 1) * 512))
#define NEXT3(x) ((x) == 2 ? 0 : (x) + 1)
    f32x16 pA0, pA1, pB0, pB1; u32x4 pw0, pw1, pw2, pw3;
#define STEP(C0, C1, P0, P1, kso, vso) do { SBAR(); \
    const lds_cptr kp_ = kp0 + (kso); const lds_cptr vp_ = vp0 + (vso); \
    bf16x8 kf_[3]; s16x4 vl_[3], vh_[3]; float sacc = 0.f; \
    kf_[0] = KFR(kp_, 0); kf_[1] = KFR(kp_, 1); SBAR(); \
    _Pragma("unroll") for (int g = 0; g < NGA; ++g) { \
        if (g + 2 < NGA) kf_[(g + 2) % 3] = KFR(kp_, g + 2); \
        if (g == NGA - 2) { vl_[0] = vtr((int)(uintptr_t)(vp_)); vh_[0] = vtr((int)(uintptr_t)(vp_ + 512)); } \
        if (g == NGA - 1) { vl_[1] = vtr((int)(uintptr_t)(vp_ + 4096)); vh_[1] = vtr((int)(uintptr_t)(vp_ + 4096 + 512)); } \
        SBAR(); \
        if ((g & 1) == 0) C0 = __builtin_amdgcn_mfma_f32_32x32x16_bf16(kf_[g % 3], qr[g >> 1], (g < 2) ? negm : C0, 0, 0, 0); \
        else              C1 = __builtin_amdgcn_mfma_f32_32x32x16_bf16(kf_[g % 3], qr[g >> 1], (g < 2) ? negm : C1, 0, 0, 0); \
        _Pragma("unroll") for (int a_ = 0; a_ < NADD; ++a_) { const int v_ = g * NADD + a_; sacc += (v_ < 16) ? P0[v_ & 15] : P1[v_ & 15]; } \
        PIN(sacc); \
        _Pragma("unroll") for (int k_ = 0; k_ < NPK; ++k_) { const int w_ = g * NPK + k_; const int e_ = (2 * w_) & 15; const unsigned pk_ = (w_ < 8) ? cvtpk_s(P0[e_], P0[e_ + 1]) : cvtpk_s(P1[e_], P1[e_ + 1]); \
            if ((w_ >> 2) == 0) pw0[w_ & 3] = pk_; else if ((w_ >> 2) == 1) pw1[w_ & 3] = pk_; else if ((w_ >> 2) == 2) pw2[w_ & 3] = pk_; else pw3[w_ & 3] = pk_; } \
        PIN(pw0); PIN(pw1); PIN(pw2); PIN(pw3); SBAR(); } \
    l_reg += sacc; \
    _Pragma("unroll") for (int g = 0; g < 16; ++g) { \
        if (g + 2 < 16) { const int g2 = g + 2; vl_[g2 % 3] = vtr((int)(uintptr_t)(vp_ + (g2 & 3) * 4096 + (g2 >> 2) * 1024)); vh_[g2 % 3] = vtr((int)(uintptr_t)(vp_ + (g2 & 3) * 4096 + (g2 >> 2) * 1024 + 512)); } \
        SBAR(); \
        { const s16x4 l_ = vl_[g % 3], h_ = vh_[g % 3]; const bf16x8 vf_ = (bf16x8){l_[0], l_[1], l_[2], l_[3], h_[0], h_[1], h_[2], h_[3]}; \
          const bf16x8 pa_ = __builtin_bit_cast(bf16x8, (g >> 2) == 0 ? pw0 : ((g >> 2) == 1 ? pw1 : ((g >> 2) == 2 ? pw2 : pw3))); \
          o[g & 3] = __builtin_amdgcn_mfma_f32_32x32x16_bf16(pa_, vf_, o[g & 3], 0, 0, 0); } \
        if (g < 8) { C0[2 * g] = __builtin_amdgcn_exp2f(C0[2 * g]); C0[2 * g + 1] = __builtin_amdgcn_exp2f(C0[2 * g + 1]); PIN(C0); } \
        else { C1[2 * g - 16] = __builtin_amdgcn_exp2f(C1[2 * g - 16]); C1[2 * g - 15] = __builtin_amdgcn_exp2f(C1[2 * g - 15]); PIN(C1); } \
        SBAR(); } \
    } while (0)
    DMA_K(0, 0); DMA_K(1, 1); DMA_V(0, 0);
    WAIT_BAR_0();
    DMA_K(2, 2); DMA_V(1, 1);
    { const lds_cptr kp_ = kp0;
#pragma unroll
      for (int g = 0; g < NGA; ++g) { const bf16x8 kf = KFR(kp_, g);
          if ((g & 1) == 0) pA0 = __builtin_amdgcn_mfma_f32_32x32x16_bf16(kf, qr[g >> 1], (g < 2) ? negm : pA0, 0, 0, 0);
          else              pA1 = __builtin_amdgcn_mfma_f32_32x32x16_bf16(kf, qr[g >> 1], (g < 2) ? negm : pA1, 0, 0, 0); } }
    exp_half(pA0); exp_half(pA1);
    WAIT_BAR_N();
    int ks = 1, vs = 0;
    for (int t = 1; t + 1 < NT; t += 2) {
        { const int kd = ks == 0 ? 2 : ks - 1, vd = vs == 0 ? 2 : vs - 1; DMA_K(t + 2, kd); DMA_V(t + 1, vd); }
        STEP(pB0, pB1, pA0, pA1, ks * SHM_K, vs * SHM_V); WAIT_BAR_N(); ks = NEXT3(ks); vs = NEXT3(vs);
        { const int kd = ks == 0 ? 2 : ks - 1, vd = vs == 0 ? 2 : vs - 1; DMA_K(t + 3, kd); DMA_V(t + 2, vd); }
        STEP(pA0, pA1, pB0, pB1, ks * SHM_K, vs * SHM_V); WAIT_BAR_N(); ks = NEXT3(ks); vs = NEXT3(vs);
    }
    STEP(pB0, pB1, pA0, pA1, ks * SHM_K, vs * SHM_V); WAIT_BAR_0(); vs = NEXT3(vs);
    { float sacc = 0.f;
#pragma unroll
      for (int r = 0; r < 16; ++r) sacc += pB0[r];
#pragma unroll
      for (int r = 0; r < 16; ++r) sacc += pB1[r];
      l_reg += sacc;
      pw0 = (u32x4){cvtpk_s(pB0[0], pB0[1]), cvtpk_s(pB0[2], pB0[3]), cvtpk_s(pB0[4], pB0[5]), cvtpk_s(pB0[6], pB0[7])};
      pw1 = (u32x4){cvtpk_s(pB0[8], pB0[9]), cvtpk_s(pB0[10], pB0[11]), cvtpk_s(pB0[12], pB0[13]), cvtpk_s(pB0[14], pB0[15])};
      pw2 = (u32x4){cvtpk_s(pB1[0], pB1[1]), cvtpk_s(pB1[2], pB1[3]), cvtpk_s(pB1[4], pB1[5]), cvtpk_s(pB1[6], pB1[7])};
      pw3 = (u32x4){cvtpk_s(pB1[8], pB1[9]), cvtpk_s(pB1[10], pB1[11]), cvtpk_s(pB1[12], pB1[13]), cvtpk_s(pB1[14], pB1[15])};
      const lds_cptr vp_ = vp0 + vs * SHM_V;
#pragma unroll
      for (int g = 0; g < 16; ++g) { const s16x4 l_ = vtr((int)(uintptr_t)(vp_ + (g & 3) * 4096 + (g >> 2) * 1024)), h_ = vtr((int)(uintptr_t)(vp_ + (g & 3) * 4096 + (g >> 2) * 1024 + 512));
          const bf16x8 vf_ = (bf16x8){l_[0], l_[1], l_[2], l_[3], h_[0], h_[1], h_[2], h_[3]};
          const bf16x8 pa_ = __builtin_bit_cast(bf16x8, (g >> 2) == 0 ? pw0 : ((g >> 2) == 1 ? pw1 : ((g >> 2) == 2 ? pw2 : pw3)));
          o[g & 3] = __builtin_amdgcn_mfma_f32_32x32x16_bf16(pa_, vf_, o[g & 3], 0, 0, 0); } }
    { auto rr = __builtin_amdgcn_permlane32_swap(__float_as_uint(l_reg), __float_as_uint(l_reg), false, false); l_reg = __uint_as_float(rr[0]) + __uint_as_float(rr[1]); }
    if (hi == 0) li_l[r32] = l_reg; asm volatile("s_waitcnt lgkmcnt(0)" ::: "memory");
#pragma unroll
    for (int r = 0; r < 16; ++r) { const float rl = __builtin_amdgcn_rcpf(li_l[crow(r, hi)]);
#pragma unroll
        for (int d = 0; d < 4; ++d) o[d][r] *= rl; }
    __syncthreads();
#undef DMA_K
#undef DMA_V
#undef WAIT_BAR_N
#undef WAIT_BAR_0
#undef PIN
#undef KFR
#undef NEXT3
#undef STEP
}

typedef int i32x8 __attribute__((ext_vector_type(8)));
constexpr int F8_KRING = 0, F8_VRING = 4 * 8192, F8_SCR = 8 * 8192, F8_Q = 8 * 8192 + 2048;
constexpr float THR8 = 8.f;
__device__ __forceinline__ unsigned f8x4u(float a, float b, float c, float d) {
    int p = __builtin_amdgcn_cvt_pk_fp8_f32(a, b, 0, false); p = __builtin_amdgcn_cvt_pk_fp8_f32(c, d, p, true); return (unsigned)p; }
__device__ __forceinline__ void f8x8u(float a0, float a1, float a2, float a3, float b0, float b1, float b2, float b3, int& pa, int& pb) {
    asm volatile("v_cvt_pk_fp8_f32 %0, %2, %3\n\tv_cvt_pk_fp8_f32 %1, %6, %7\n\tv_cvt_pk_fp8_f32 %0, %4, %5 op_sel:[0,0,1]\n\tv_cvt_pk_fp8_f32 %1, %8, %9 op_sel:[0,0,1]\n\ts_nop 0"
                 : "=&v"(pa), "=&v"(pb) : "v"(a0), "v"(a1), "v"(a2), "v"(a3), "v"(b0), "v"(b1), "v"(b2), "v"(b3)); }
__device__ __forceinline__ float cl448(float x) { return __builtin_amdgcn_fmed3f(x, -448.f, 448.f); }
__device__ __forceinline__ unsigned f8x4(float a, float b, float c, float d) { return f8x4u(cl448(a), cl448(b), cl448(c), cl448(d)); }
template <int DQK> __device__ __forceinline__ int kimg_off(int key, int d) { const int g = (DQK == 128) ? ((key >> 1) & 7) : ((key >> 2) & 3); return key * DQK + ((((d >> 4) ^ g)) << 4) + (d & 15); }
__device__ __forceinline__ int vimg_off(int n, int j) { return n * 64 + ((((j >> 4) ^ ((n >> 2) & 3))) << 4) + (j & 15); }
__device__ __forceinline__ int kap(int h, int e) { return e < 16 ? crow(e, h) : 32 + crow(e - 16, h); }
template <int DQK>
__device__ __forceinline__ void attn_core_f8(const int tid, const bf16_t* Qb, int ldq, const unsigned char* Kimg, const unsigned char* Vimg, int seq, LAS unsigned char* ldsl, f32x16 (&o)[4],
                                             const float* qgain, const float* ropeT, int tpos0, float kmaxC) {
    constexpr int NQF = DQK / 16, NKS = DQK / 64, KTB = 64 * DQK, NKP = KTB / 1024;
    constexpr float SCALE = (DQK == 128) ? 0.088388347648318440f : 0.125f;
    constexpr float C = SCALE * LOG2E;
    typedef const LAS char* lds_cptr;
    const int wid = __builtin_amdgcn_readfirstlane(tid >> 6), lane = tid & 63, r32 = lane & 31, hi = lane >> 5;
    char* lds = (char*)(unsigned char*)ldsl; const unsigned ldsb = (unsigned)(uintptr_t)ldsl;
    float l_reg = 0.f;
#pragma unroll
    for (int d = 0; d < 4; ++d) o[d] = f32x16{};
    i32x8 qf[NKS]; float qn2;
    { float x[NQF][8];
      qn2 = prep_q_x<DQK>(x, Qb + (long)(wid * QBLK + r32) * ldq + hi * 8, qgain, ropeT, tpos0 >= 0 ? tpos0 + wid * QBLK + r32 : -1, hi);
#pragma unroll
      for (int ks = 0; ks < NKS; ++ks)
#pragma unroll
          for (int i = 0; i < 2; ++i) { const int da = 4 * ks + i, db = 4 * ks + 2 + i;
              unsigned a0 = f8x4(x[da][0] * C, x[da][1] * C, x[da][2] * C, x[da][3] * C), a1 = f8x4(x[da][4] * C, x[da][5] * C, x[da][6] * C, x[da][7] * C);
              unsigned b0 = f8x4(x[db][0] * C, x[db][1] * C, x[db][2] * C, x[db][3] * C), b1 = f8x4(x[db][4] * C, x[db][5] * C, x[db][6] * C, x[db][7] * C);
              auto r0 = __builtin_amdgcn_permlane32_swap(a0, b0, false, false); auto r1 = __builtin_amdgcn_permlane32_swap(a1, b1, false, false);
              qf[ks][4 * i + 0] = (int)r0[0]; qf[ks][4 * i + 1] = (int)r1[0]; qf[ks][4 * i + 2] = (int)r0[1]; qf[ks][4 * i + 3] = (int)r1[1]; } }
    const int gk = (DQK == 128) ? ((r32 >> 1) & 7) : ((r32 >> 2) & 3), gv = (r32 >> 2) & 3;
    int kc2[2], vco[2];
#pragma unroll
    for (int i = 0; i < 2; ++i) kc2[i] = (((2 * hi + i) ^ gk) << 4);
#define kco(i) (((i) >> 1) ? (kc2[(i) & 1] ^ 64) : kc2[(i) & 1])
#pragma unroll
    for (int i = 0; i < 2; ++i) vco[i] = (((2 * hi + i) ^ gv) << 4);
    const lds_cptr qp0 = (lds_cptr)ldsl + F8_Q + wid * 4096 + r32 * DQK;
#pragma unroll
    for (int ks = 0; ks < NKS; ++ks) { *(LAS u32x4*)(qp0 + kco(2 * ks)) = (u32x4){(unsigned)qf[ks][0], (unsigned)qf[ks][1], (unsigned)qf[ks][2], (unsigned)qf[ks][3]};
        *(LAS u32x4*)(qp0 + kco(2 * ks + 1)) = (u32x4){(unsigned)qf[ks][4], (unsigned)qf[ks][5], (unsigned)qf[ks][6], (unsigned)qf[ks][7]}; }
    asm volatile("s_waitcnt lgkmcnt(0)" ::: "memory");
    const lds_cptr kp0 = (lds_cptr)ldsl + F8_KRING + r32 * DQK;
    const lds_cptr vp0 = (lds_cptr)ldsl + F8_VRING + r32 * 64;
    const int NT = seq / KVBLK;
    const unsigned char* kimgw = Kimg + (wid % NKP) * 1024; const unsigned char* vimgw = Vimg + wid * 1024;
#define ksrc (kimgw + (unsigned)(lane * 16))
#define vsrc (vimgw + (unsigned)(lane * 16))
#define DMA8(t, kslot, vslot) do { const int _t = (t) < NT ? (t) : NT - 1; \
    glds16(ksrc + (size_t)_t * KTB, (unsigned)__builtin_amdgcn_readfirstlane((int)(ldsb + F8_KRING + (kslot) * 8192 + (wid % NKP) * 1024))); \
    glds16(vsrc + (size_t)_t * 8192, (unsigned)__builtin_amdgcn_readfirstlane((int)(ldsb + F8_VRING + (vslot) * 8192 + wid * 1024))); } while (0)
#define DMA8K(t, kslot) do { const int _t = (t) < NT ? (t) : NT - 1; glds16(ksrc + (size_t)_t * KTB, (unsigned)__builtin_amdgcn_readfirstlane((int)(ldsb + F8_KRING + (kslot) * 8192 + (wid % NKP) * 1024))); } while (0)
#define WB8(n) do { asm volatile("s_waitcnt vmcnt(" #n ") lgkmcnt(0)\n\ts_barrier" ::: "memory"); SBAR(); } while (0)
#define QKT8(C0, C1, kso) do { const lds_cptr kp_ = kp0 + (kso); \
    _Pragma("unroll") for (int ks = 0; ks < NKS; ++ks) { \
        const u32x4 a0 = *(const LAS u32x4*)(kp_ + kco(2 * ks)), a1 = *(const LAS u32x4*)(kp_ + kco(2 * ks + 1)); \
        const u32x4 b0 = *(const LAS u32x4*)(kp_ + 32 * DQK + kco(2 * ks)), b1 = *(const LAS u32x4*)(kp_ + 32 * DQK + kco(2 * ks + 1)); \
        const i32x8 ka = {(int)a0[0], (int)a0[1], (int)a0[2], (int)a0[3], (int)a1[0], (int)a1[1], (int)a1[2], (int)a1[3]}; \
        const i32x8 kb = {(int)b0[0], (int)b0[1], (int)b0[2], (int)b0[3], (int)b1[0], (int)b1[1], (int)b1[2], (int)b1[3]}; \
        const u32x4 q0 = *(const LAS u32x4*)(qp0 + kco(2 * ks)), q1 = *(const LAS u32x4*)(qp0 + kco(2 * ks + 1)); \
        const i32x8 qq = {(int)q0[0], (int)q0[1], (int)q0[2], (int)q0[3], (int)q1[0], (int)q1[1], (int)q1[2], (int)q1[3]}; \
        C0 = __builtin_amdgcn_mfma_scale_f32_32x32x64_f8f6f4(ka, qq, ks == 0 ? negm : C0, 0, 0, 0, 0, 0, 0); \
        C1 = __builtin_amdgcn_mfma_scale_f32_32x32x64_f8f6f4(kb, qq, ks == 0 ? negm : C1, 0, 0, 0, 0, 0, 0); SBAR(); } } while (0)
#define PV8(vso) do { const lds_cptr vp_ = vp0 + (vso); \
    _Pragma("unroll") for (int d = 0; d < 4; ++d) { const u32x4 v0 = *(const LAS u32x4*)(vp_ + d * 2048 + vco[0]), v1 = *(const LAS u32x4*)(vp_ + d * 2048 + vco[1]); \
        const i32x8 vf = {(int)v0[0], (int)v0[1], (int)v0[2], (int)v0[3], (int)v1[0], (int)v1[1], (int)v1[2], (int)v1[3]}; \
        o[d] = __builtin_amdgcn_mfma_scale_f32_32x32x64_f8f6f4(pw, vf, o[d], 0, 0, 0, 0, 0, 0); } } while (0)
#define PART8(P0, P1, AL) do { float pm = P0[0]; \
    _Pragma("unroll") for (int r = 1; r < 16; ++r) pm = fmaxf(pm, P0[r]); \
    _Pragma("unroll") for (int r = 0; r < 16; ++r) pm = fmaxf(pm, P1[r]); \
    { auto rr = __builtin_amdgcn_permlane32_swap(__float_as_uint(pm), __float_as_uint(pm), false, false); pm = fmaxf(__uint_as_float(rr[0]), __uint_as_float(rr[1])); } \
    AL = 1.f; \
    if (!__builtin_expect(__all(pm <= THR8), 1)) { const float dl = fmaxf(pm, 0.f); AL = __builtin_amdgcn_exp2f(-dl); \
        _Pragma("unroll") for (int r = 0; r < 16; ++r) { P0[r] -= dl; P1[r] -= dl; negm[r] -= dl; } } \
    _Pragma("unroll") for (int r = 0; r < 16; ++r) P0[r] = __builtin_amdgcn_exp2f(P0[r]); } while (0)
#define FIN8(P0, P1, AL) do { \
    _Pragma("unroll") for (int r = 0; r < 16; ++r) P1[r] = __builtin_amdgcn_exp2f(P1[r]); \
    float ps = 0.f; \
    _Pragma("unroll") for (int r = 0; r < 16; ++r) ps += P0[r]; \
    _Pragma("unroll") for (int r = 0; r < 16; ++r) ps += P1[r]; \
    l_reg = l_reg * AL + ps; \
    _Pragma("unroll") for (int v = 0; v < 4; ++v) { pw[v] = (int)f8x4u(P0[4 * v], P0[4 * v + 1], P0[4 * v + 2], P0[4 * v + 3]); pw[4 + v] = (int)f8x4u(P1[4 * v], P1[4 * v + 1], P1[4 * v + 2], P1[4 * v + 3]); } } while (0)
#define RESC8(a) do { if (__any((a) < 1.f)) { int t2 = tid; asm volatile("" : "+v"(t2)); const int h2 = (t2 >> 5) & 1, r2 = t2 & 31; float* al2 = (float*)(lds + F8_SCR) + (t2 >> 6) * 64 + 32;   \
    if (h2 == 0) al2[r2] = (a); asm volatile("s_waitcnt lgkmcnt(0)" ::: "memory"); \
    _Pragma("unroll") for (int d = 0; d < 4; ++d) _Pragma("unroll") for (int r = 0; r < 16; ++r) o[d][r] *= al2[crow(r, h2)]; } } while (0)
#define NEXT3(x) ((x) == 2 ? 0 : (x) + 1)
    f32x16 pA0, pA1, pB0, pB1, negm = f32x16{}; float alA = 1.f, alB = 1.f; i32x8 pw;
    DMA8(0, 0, 0); DMA8K(1, 1); DMA8K(2, 2);
    WB8(0);
    { const int tk = 3 < NT ? 3 : NT - 1, tv = 1;
      glds16(ksrc + (size_t)tk * KTB, (unsigned)__builtin_amdgcn_readfirstlane((int)(ldsb + F8_KRING + 3 * 8192 + (wid % NKP) * 1024)));
      glds16(vsrc + (size_t)tv * 8192, (unsigned)__builtin_amdgcn_readfirstlane((int)(ldsb + F8_VRING + 1 * 8192 + wid * 1024))); }
    QKT8(pA0, pA1, 0);
    { float pm = pA0[0];
#pragma unroll
      for (int r = 1; r < 16; ++r) pm = fmaxf(pm, pA0[r]);
#pragma unroll
      for (int r = 0; r < 16; ++r) pm = fmaxf(pm, pA1[r]);
      { auto rr = __builtin_amdgcn_permlane32_swap(__float_as_uint(pm), __float_as_uint(pm), false, false); pm = fmaxf(__uint_as_float(rr[0]), __uint_as_float(rr[1])); }
      pm = fmaxf(pm, sqrtf(qn2) * kmaxC * 1.1f - 100.f);
#pragma unroll
      for (int r = 0; r < 16; ++r) { pA0[r] -= pm; pA1[r] -= pm; negm[r] = -pm; }
#pragma unroll
      for (int r = 0; r < 16; ++r) pA0[r] = __builtin_amdgcn_exp2f(pA0[r]); }
#pragma unroll
    for (int r = 0; r < 16; ++r) pA1[r] = __builtin_amdgcn_exp2f(pA1[r]);
#define PIN(x) asm volatile("" : "+v"(x))
#define KF8(kp, g) ({ const u32x4 _a = *(const LAS u32x4*)((kp) + ((g) & 1) * (32 * DQK) + kco(2 * ((g) >> 1))), _b = *(const LAS u32x4*)((kp) + ((g) & 1) * (32 * DQK) + kco(2 * ((g) >> 1) + 1)); \
    (i32x8){(int)_a[0], (int)_a[1], (int)_a[2], (int)_a[3], (int)_b[0], (int)_b[1], (int)_b[2], (int)_b[3]}; })
#define QF8(ks) ({ const u32x4 _a = *(const LAS u32x4*)(qp0 + kco(2 * (ks))), _b = *(const LAS u32x4*)(qp0 + kco(2 * (ks) + 1)); \
    (i32x8){(int)_a[0], (int)_a[1], (int)_a[2], (int)_a[3], (int)_b[0], (int)_b[1], (int)_b[2], (int)_b[3]}; })
#define VF8(vp, d) ({ const u32x4 _a = *(const LAS u32x4*)((vp) + (d) * 2048 + vco[0]), _b = *(const LAS u32x4*)((vp) + (d) * 2048 + vco[1]); \
    (i32x8){(int)_a[0], (int)_a[1], (int)_a[2], (int)_a[3], (int)_b[0], (int)_b[1], (int)_b[2], (int)_b[3]}; })
    constexpr int NG = 2 * NKS, NPG = (NG == 4) ? 2 : 1, NPK = 8 / NPG;
    constexpr float LIM8 = 448.f;
    bool resc = false; float pdl = 0.f;
    i32x8 sel; { const int sv = ((lane & 15) < 2 && ((lane >> 4) & 1) == (lane & 15)) ? 0x38383838 : 0;
#pragma unroll
      for (int i = 0; i < 8; ++i) sel[i] = sv; }
    f32x4 lacc = {0.f, 0.f, 0.f, 0.f}, srs;
#define PACK8(P0, P1, w_) do { const int e_ = (4 * (w_)) & 15; int pa_, pb_; \
    if ((w_) < 4) f8x8u(P0[e_], P0[e_ + 1], P0[e_ + 2], P0[e_ + 3], P0[e_ + 4], P0[e_ + 5], P0[e_ + 6], P0[e_ + 7], pa_, pb_); \
    else          f8x8u(P1[e_], P1[e_ + 1], P1[e_ + 2], P1[e_ + 3], P1[e_ + 4], P1[e_ + 5], P1[e_ + 6], P1[e_ + 7], pa_, pb_); \
    pw[w_] = pa_; pw[(w_) + 1] = pb_; } while (0)
#define RSUM8() srs = __builtin_amdgcn_mfma_scale_f32_16x16x128_f8f6f4(pw, sel, (f32x4){0.f, 0.f, 0.f, 0.f}, 0, 0, 0, 0, 0, 0)
#define MOVE9(P0, P1) do { float sacc = 0.f; \
    _Pragma("unroll") for (int r = 0; r < 16; ++r) sacc += P0[r]; \
    _Pragma("unroll") for (int r = 0; r < 16; ++r) sacc += P1[r]; \
    float srow; { auto rr = __builtin_amdgcn_permlane32_swap(__float_as_uint(sacc), __float_as_uint(sacc), false, false); srow = __uint_as_float(rr[0]) + __uint_as_float(rr[1]); } \
    pdl = fmaxf(__builtin_ceilf(__builtin_amdgcn_logf(srow)) - 6.f, 0.f); const float f_ = __builtin_amdgcn_exp2f(-pdl); \
    _Pragma("unroll") for (int r = 0; r < 16; ++r) { P0[r] *= f_; P1[r] *= f_; negm[r] -= pdl; } \
    { int t2 = tid; asm volatile("" : "+v"(t2)); float* al2 = (float*)(lds + F8_SCR) + (t2 >> 6) * 64 + 32; if (((t2 >> 5) & 1) == 0) al2[t2 & 31] = f_; asm volatile("s_waitcnt lgkmcnt(0)" ::: "memory"); \
      const int q0 = 16 * (t2 & 1) + 4 * ((t2 >> 4) & 3); \
      _Pragma("unroll") for (int r = 0; r < 4; ++r) lacc[r] *= al2[q0 + r]; } \
    _Pragma("unroll") for (int w_ = 0; w_ < 8; w_ += 2) PACK8(P0, P1, w_); \
    RSUM8(); resc = true; } while (0)
#define MOVE9B(C0, C1) do { int t2 = tid; asm volatile("" : "+v"(t2)); const int h2 = (t2 >> 5) & 1; const float* al2 = (const float*)(lds + F8_SCR) + (t2 >> 6) * 64 + 32; asm volatile("s_waitcnt lgkmcnt(0)" ::: "memory"); \
    _Pragma("unroll") for (int r = 0; r < 16; ++r) { C0[r] -= pdl; C1[r] -= pdl; } \
    _Pragma("unroll") for (int d = 0; d < 4; ++d) _Pragma("unroll") for (int r = 0; r < 16; ++r) o[d][r] *= al2[crow(r, h2)]; resc = false; } while (0)
#define TEST9(P0, P1) do { const float mx_ = (srs[0] + srs[1]) + (srs[2] + srs[3]);     \
    if (__builtin_expect(__any(!(mx_ < LIM8)), 0)) MOVE9(P0, P1); \
    lacc += srs; } while (0)
#define DMAK_(tk_, kd_) do { const int tk = (tk_) < NT ? (tk_) : NT - 1; glds16(ksrc + (size_t)tk * KTB, (unsigned)__builtin_amdgcn_readfirstlane((int)(ldsb + F8_KRING + (kd_) * 8192 + (wid % NKP) * 1024))); } while (0)
#define DMAV_(tv_, vd_) do { const int tv = (tv_) < NT ? (tv_) : NT - 1; glds16(vsrc + (size_t)tv * 8192, (unsigned)__builtin_amdgcn_readfirstlane((int)(ldsb + F8_VRING + (vd_) * 8192 + wid * 1024))); } while (0)
#define STEP8(C0, C1, P0, P1, kso, vso, knext, tk_, kd_, tv_, vd_) do { SBAR(); \
    const lds_cptr kp_ = kp0 + (kso); const lds_cptr vp_ = vp0 + (vso); \
    i32x8 vf_[2]; \
      \
    C0 = __builtin_amdgcn_mfma_scale_f32_32x32x64_f8f6f4(kc0_, qc0_, negm, 0, 0, 0, 0, 0, 0); SBAR(); \
    if (NG == 4) { kc0_ = KF8(kp_, 2); } else { vf_[0] = VF8(vp_, 0); } \
    if (NG == 4) { PACK8(P0, P1, 0); PACK8(P0, P1, 2); } else { PACK8(P0, P1, 0); PACK8(P0, P1, 2); PACK8(P0, P1, 4); PACK8(P0, P1, 6); SBAR(); RSUM8(); } \
    SBAR(); \
      \
    C1 = __builtin_amdgcn_mfma_scale_f32_32x32x64_f8f6f4(kc1_, qc0_, negm, 0, 0, 0, 0, 0, 0); SBAR(); \
    if (NG == 4) { kc1_ = KF8(kp_, 3); PACK8(P0, P1, 4); PACK8(P0, P1, 6); SBAR(); RSUM8(); } \
    else { DMAK_(tk_, kd_); DMAV_(tv_, vd_); SBAR(); TEST9(P0, P1); } \
    SBAR(); \
    if (NG == 4) { \
          \
        C0 = __builtin_amdgcn_mfma_scale_f32_32x32x64_f8f6f4(kc0_, qc1_, C0, 0, 0, 0, 0, 0, 0); SBAR(); \
        DMAK_(tk_, kd_); vf_[0] = VF8(vp_, 0); SBAR(); \
          \
        C1 = __builtin_amdgcn_mfma_scale_f32_32x32x64_f8f6f4(kc1_, qc1_, C1, 0, 0, 0, 0, 0, 0); SBAR(); \
        DMAV_(tv_, vd_); SBAR(); TEST9(P0, P1); SBAR(); } \
    if (__builtin_expect(resc, 0)) MOVE9B(C0, C1); \
    SBAR(); \
    _Pragma("unroll") for (int d = 0; d < 4; ++d) { \
        if (d + 1 < 4) vf_[(d + 1) & 1] = VF8(vp_, d + 1); \
        if (d == 3) { const lds_cptr kn_ = kp0 + (knext); kc0_ = KF8(kn_, 0); kc1_ = KF8(kn_, 1); }     \
        SBAR(); \
        o[d] = __builtin_amdgcn_mfma_scale_f32_32x32x64_f8f6f4(pw, vf_[d & 1], o[d], 0, 0, 0, 0, 0, 0); \
        if (d < 2) { _Pragma("unroll") for (int e_ = 0; e_ < 8; ++e_) C0[8 * d + e_] = __builtin_amdgcn_exp2f(C0[8 * d + e_]); PIN(C0); } \
        else       { _Pragma("unroll") for (int e_ = 0; e_ < 8; ++e_) C1[8 * (d - 2) + e_] = __builtin_amdgcn_exp2f(C1[8 * (d - 2) + e_]); PIN(C1); } \
        SBAR(); } \
    } while (0)
    i32x8 kc0_, kc1_, qc0_, qc1_;
    { const lds_cptr kn_ = kp0 + 1 * 8192; kc0_ = KF8(kn_, 0); qc0_ = QF8(0); kc1_ = KF8(kn_, 1); if (NG == 4) qc1_ = QF8(1); else qc1_ = qc0_; }
    WB8(2);
#define STEPQ(C0, C1, P0, P1, t_, q_) STEP8(C0, C1, P0, P1, ((q_) & 3) * 8192, (((q_) + 3) & 3) * 8192, (((q_) + 1) & 3) * 8192, (t_) + 3, ((q_) + 3) & 3, (t_) + 1, ((q_) + 1) & 3)
    int t = 1;
    for (; t + 6 < NT; t += 4) {
        STEPQ(pB0, pB1, pA0, pA1, t, 1); WB8(2);
        STEPQ(pA0, pA1, pB0, pB1, t + 1, 2); WB8(2);
        STEPQ(pB0, pB1, pA0, pA1, t + 2, 3); WB8(2);
        STEPQ(pA0, pA1, pB0, pB1, t + 3, 0); WB8(2);
    }
    STEPQ(pB0, pB1, pA0, pA1, t, 1); WB8(2);
    STEPQ(pA0, pA1, pB0, pB1, t + 1, 2); WB8(2);
    STEP8(pB0, pB1, pA0, pA1, 3 * 8192, 2 * 8192, 0 * 8192, NT, 2, NT, 0); WB8(0);
    const int vs_ = 3;
    {
#pragma unroll
      for (int w_ = 0; w_ < 8; w_ += 2) PACK8(pB0, pB1, w_);
      RSUM8();
      TEST9(pB0, pB1);
      if (resc) MOVE9B(pA0, pA1);
      PV8(vs_ * 8192); }
    { int t2 = tid; asm volatile("" : "+v"(t2)); const int h2 = (t2 >> 5) & 1; float* li2 = (float*)(lds + F8_SCR) + (t2 >> 6) * 64;
      if ((t2 & 15) < 2) { const int q0 = 16 * (t2 & 15) + 4 * ((t2 >> 4) & 3);
#pragma unroll
          for (int r = 0; r < 4; ++r) li2[q0 + r] = lacc[r]; }
      asm volatile("s_waitcnt lgkmcnt(0)" ::: "memory");
#pragma unroll
      for (int r = 0; r < 16; ++r) { const float rl = __builtin_amdgcn_rcpf(li2[crow(r, h2)]);
#pragma unroll
          for (int d = 0; d < 4; ++d) o[d][r] *= rl; } }
    __syncthreads();
#undef DMA8
#undef PIN
#undef KF8
#undef QF8
#undef VF8
#undef STEP8
#undef MOVE9
#undef MOVE9B
#undef TEST9
#undef PACK8
#undef RSUM8
#undef DMAK_
#undef DMAV_
#undef STEPQ
#undef kco
#undef ksrc
#undef vsrc
#undef DMA8K
#undef WB8
#undef QKT8
#undef PV8
#undef PART8
#undef FIN8
#undef RESC8
#undef NEXT3
}
template <int NCB> __device__ __forceinline__ void store_o_lds(const int tid, const f32x16 (&o)[NCB], bf16_t* O, int ldo, char* lds) {
    const int wid = tid >> 6, lane = tid & 63, r32 = lane & 31, hi = lane >> 5;
    constexpr int RB = NCB * 64;
    char* st = lds + wid * 8192;
#pragma unroll
    for (int r = 0; r < 16; ++r) { const int orow = crow(r, hi);
#pragma unroll
        for (int d = 0; d < NCB; ++d) *(bf16_t*)(st + orow * RB + (d * 32 + r32) * 2) = (bf16_t)(cvtpk(o[d][r], 0.f) & 0xffffu); }
    asm volatile("s_waitcnt lgkmcnt(0)" ::: "memory");
    constexpr int CPR = RB / 16;
#pragma unroll
    for (int i = 0; i < (32 * CPR) / 64; ++i) { const int c = lane + 64 * i, row = c / CPR, cc = c % CPR;
        const u32x4 v = *(const u32x4*)(st + row * RB + cc * 16);
        *(u32x4*)((char*)(O + (long)(wid * QBLK + row) * ldo) + cc * 16) = v; }
    asm volatile("s_waitcnt lgkmcnt(0)" ::: "memory");
    __syncthreads();
}
}

struct Args { const float* in[25]; float* out; unsigned char* ws; int ph_lo, ph_hi; };
enum { I_X = 0, I_C, I_CTX, I_CCTX, I_WMOD, I_BMOD, I_LNG, I_LNB, I_WINE, I_WOUTE, I_SINK, I_LQ1, I_LK1, I_LQ2, I_LK2, I_SUBG, I_WINO, I_WOUTO, I_QNG, I_KNG, I_WR, I_BR, I_WG, I_WU, I_WDN };

struct Ctx {
    LAS unsigned char* lds; LAS int* lc; int tid, lane, wave, G, c, gw, NGW;
    const GAS float* const CAS* in; unsigned char* ws;
};

#define INP(i) ((const float*)F.in[i])
__device__ __forceinline__ int lane_id() { int l; asm volatile("v_mbcnt_lo_u32_b32 %0, -1, 0\n\tv_mbcnt_hi_u32_b32 %0, -1, %0" : "=v"(l)); return l; }
__device__ __forceinline__ Ctx make_ctx(int wave_s) {
    Ctx F;
    unsigned t = (unsigned)(wave_s * 64 + lane_id()); asm volatile("" : "+v"(t));
    const CAS char* ka = (const CAS char*)__builtin_amdgcn_kernarg_segment_ptr(); asm volatile("" : "+s"(ka));
    unsigned lb = 0u; asm volatile("" : "+s"(lb));
    F.lds = (LAS unsigned char*)(uintptr_t)lb; F.lc = (LAS int*)(F.lds + LDSCTL_OFF);
    F.tid = (int)t; F.lane = F.tid & 63; F.wave = __builtin_amdgcn_readfirstlane(F.tid >> 6);
    F.G = gridDim.x; F.c = blockIdx.x; F.gw = F.c * NWAVES + F.wave; F.NGW = F.G * NWAVES;
    F.in = (const GAS float* const CAS*)ka; F.ws = (unsigned char*)*(GAS unsigned char* const CAS*)(ka + 208);
    return F;
}
__device__ __forceinline__ void p0_transpose_item(const float* W, int K, int N, bf16_t* WT, int mode, LAS float* scr, int item, int lane) {
    const int nblk = N / 32, kb = item / nblk, nb = item % nblk, k0 = 64 * kb, n0 = 32 * nb;
    float w_[32];
#pragma unroll
    for (int i = 0; i < 32; ++i) { const int kk = 2 * i + (lane >> 5); w_[i] = W[(size_t)(k0 + kk) * N + n0 + (lane & 31)]; }
#pragma unroll
    for (int i = 0; i < 32; ++i) { const int kk = 2 * i + (lane >> 5); scr[kk * 33 + (lane & 31)] = w_[i]; }
    LDS_WAIT(); asm volatile("" ::: "memory");
    const int cc = lane & 7;
#pragma unroll
    for (int j = 0; j < 4; ++j) { const int n = (lane >> 3) + 8 * j; const LAS float* s = scr + (8 * cc) * 33 + n;
        u32x4 o; o.x = cvt_pk_bf16(s[0 * 33], s[1 * 33]); o.y = cvt_pk_bf16(s[2 * 33], s[3 * 33]); o.z = cvt_pk_bf16(s[4 * 33], s[5 * 33]); o.w = cvt_pk_bf16(s[6 * 33], s[7 * 33]);
        const int ng = n0 + n; const int nr = (mode == 0) ? ng : ((ng >> 2) * 8 + (ng & 3) + (mode == 2 ? 4 : 0));
        *(u32x4*)(WT + (size_t)nr * K + k0 + 8 * cc) = o; }
    LDS_WAIT(); asm volatile("" ::: "memory");
}
__device__ __forceinline__ void p0_prologue(const Ctx& F) {
    unsigned char* ws = F.ws;
    for (int blk = F.c; blk < 192; blk += F.G) {
        LAS float* cs = (LAS float*)F.lds;
        for (int i = F.tid; i < 2048; i += NTHREADS) { const float v = (i < 1024) ? INP(I_C)[i] : INP(I_CCTX)[i - 1024]; cs[i] = v / (1.f + __expf(-v)); }
        __syncthreads();
        const int l = blk / 48, cb = (blk % 48) * 128, q = F.tid >> 7, cc = F.tid & 127, col = cb + cc;
        const float* wp = INP(I_WMOD) + (size_t)l * DM * 6144 + (size_t)(q * 256) * 6144 + col;
        float a0 = 0.f, a1 = 0.f;
#pragma unroll 8
        for (int k = 0; k < 256; ++k) { const float w = wp[(size_t)k * 6144]; a0 = fmaf(cs[q * 256 + k], w, a0); a1 = fmaf(cs[1024 + q * 256 + k], w, a1); }
        LAS float* red = (LAS float*)F.lds + 2048;
        red[(0 * 4 + q) * 128 + cc] = a0; red[(1 * 4 + q) * 128 + cc] = a1;
        __syncthreads();
        if (F.tid < 256) { const int s = F.tid >> 7; const float b = INP(I_BMOD)[l * 6144 + col];
            const float v = red[(s * 4 + 0) * 128 + cc] + red[(s * 4 + 1) * 128 + cc] + red[(s * 4 + 2) * 128 + cc] + red[(s * 4 + 3) * 128 + cc] + b;
            ((float*)(ws + WS_MODV))[(l * 2 + s) * 6144 + col] = v; }
        __syncthreads();
    }
    if (F.c == F.G - 1) {
        float* t64 = (float*)(ws + WS_TAB64); float* t128 = (float*)(ws + WS_TAB128);
        const float l2t = 13.287712379549449f;
        for (int i = F.tid; i < 256 * 16; i += NTHREADS) { const int pos = i >> 4, f = i & 15; const float inv = exp2f(-(float)f * (1.f / 16.f) * l2t), a = (float)pos * inv; t64[2 * i] = cosf(a); t64[2 * i + 1] = sinf(a); }
        for (int i = F.tid; i < 256 * 32; i += NTHREADS) { const int pos = i >> 5, f = i & 31; const float inv = exp2f(-(float)f * (1.f / 32.f) * l2t), a = (float)pos * inv; t128[2 * i] = cosf(a); t128[2 * i + 1] = sinf(a); }
        if (F.tid < 2) { const int i = F.tid; float s1 = 0.f, s2 = 0.f;
            for (int k = 0; k < 64; ++k) { s1 += INP(I_LQ1)[i * 64 + k] * INP(I_LK1)[i * 64 + k]; s2 += INP(I_LQ2)[i * 64 + k] * INP(I_LK2)[i * 64 + k]; }
            const float lam_init = 0.8f - 0.6f * expf(-0.3f * (float)(2 * i));
            ((float*)(ws + WS_LAM))[i] = expf(s1) - expf(s2) + lam_init; }
    }
    LAS float* scr = (LAS float*)(F.lds + 32768 + F.wave * 8704);
    constexpr int I_INE = 16 * 72, I_INO = 16 * 48, I_OUT = 16 * 32, I_GU = 16 * 16, I_DN = 8 * 32;
    constexpr int N_A = 2 * I_INE, N_B = 2 * I_INO, N_C = 4 * I_OUT, N_D = 64 * I_GU, N_E = 64 * I_GU, N_F = 64 * I_DN;
    constexpr int NITEMS = N_A + N_B + N_C + N_D + N_E + N_F;
    for (int it = F.gw; it < NITEMS; it += F.NGW) {
        int r = it;
        if (r < N_A) { const int i = r / I_INE; p0_transpose_item(INP(I_WINE) + (size_t)i * DM * EVEN_IN, DM, EVEN_IN, (bf16_t*)(ws + WS_WINE) + (size_t)i * EVEN_IN * DM, 0, scr, r % I_INE, F.lane); continue; } r -= N_A;
        if (r < N_B) { const int i = r / I_INO; p0_transpose_item(INP(I_WINO) + (size_t)i * DM * ODD_IN, DM, ODD_IN, (bf16_t*)(ws + WS_WINO) + (size_t)i * ODD_IN * DM, 0, scr, r % I_INO, F.lane); continue; } r -= N_B;
        if (r < N_C) { const int l = r / I_OUT; const float* src = ((l & 1) ? INP(I_WOUTO) : INP(I_WOUTE)) + (size_t)(l >> 1) * DM * DM;
            p0_transpose_item(src, DM, DM, (bf16_t*)(ws + WS_WOUT) + (size_t)l * DM * DM, 0, scr, r % I_OUT, F.lane); continue; } r -= N_C;
        if (r < N_D) { const int m = r / I_GU; p0_transpose_item(INP(I_WG) + (size_t)m * DM * DEXP, DM, DEXP, (bf16_t*)(ws + WS_WGU) + (size_t)m * 1024 * DM, 1, scr, r % I_GU, F.lane); continue; } r -= N_D;
        if (r < N_E) { const int m = r / I_GU; p0_transpose_item(INP(I_WU) + (size_t)m * DM * DEXP, DM, DEXP, (bf16_t*)(ws + WS_WGU) + (size_t)m * 1024 * DM, 2, scr, r % I_GU, F.lane); continue; } r -= N_E;
        { const int m = r / I_DN; p0_transpose_item(INP(I_WDN) + (size_t)m * DEXP * DM, DEXP, DM, (bf16_t*)(ws + WS_WD) + (size_t)m * DM * DEXP, 0, scr, r % I_DN, F.lane); }
    }
}

__device__ __forceinline__ void load_tstart(const Ctx& F, int l) {
    if (F.tid == 0) { unsigned* cw = (unsigned*)(F.ws + WS_CTL) + CW_CNT + l * 16 * 64; int acc = 0;
        for (int e = 0; e < 16; ++e) { const int n = (int)__hip_atomic_load(cw + e * 64, RLX_AGENT); F.lc[LC_ECNT + e] = n; F.lc[LC_TSTART + e] = acc; acc += (n + 255) >> 8; }
        F.lc[LC_TSTART + 16] = acc; }
    __syncthreads();
}

__device__ __forceinline__ void phase_a(const Ctx& F, int l, float* out) {
    unsigned char* ws = F.ws;
    float* XB = (float*)(ws + WS_XB); const float* X1B = (const float*)(ws + WS_X1B); bf16_t* HB = (bf16_t*)(ws + WS_HB);
    const bf16_t* MO = (const bf16_t*)(ws + WS_QKV); const i32x4* ROUTE = (const i32x4*)(ws + WS_ROUTE); const float* MODV = (const float*)(ws + WS_MODV);
    if (l > 0) load_tstart(F, l - 1);
    const int row_lo = (l == 4) ? NCTX : 0;
    for (int row = row_lo + F.gw; row < MROWS; row += F.NGW) {
        const int isctx = row < NCTX ? 1 : 0;
        f32x4 v[4];
        if (l == 0) {
            const float* src = isctx ? INP(I_CTX) + (size_t)row * DM : INP(I_X) + (size_t)(row - NCTX) * DM;
#pragma unroll
            for (int j = 0; j < 4; ++j) v[j] = *(const f32x4*)(src + 4 * F.lane + 256 * j);
        } else {
            const float* mp = MODV + ((l - 1) * 2 + isctx) * 6144;
            const i32x4 rt = ROUTE[row];
            const int e0 = rt.x >> 15, e1 = rt.y >> 15; const float w0 = __int_as_float(rt.z), w1 = __int_as_float(rt.w);
            const bf16_t* m0 = MO + (size_t)(F.lc[LC_TSTART + e0] * 256 + (rt.x & 32767)) * DM; const bf16_t* m1 = MO + (size_t)(F.lc[LC_TSTART + e1] * 256 + (rt.y & 32767)) * DM;
            float s = 0.f;
#pragma unroll
            for (int j = 0; j < 4; ++j) { const int col = 4 * F.lane + 256 * j;
                const f32x4 x1 = *(const f32x4*)(X1B + (size_t)row * DM + col); const f32x4 g2 = *(const f32x4*)(mp + 5120 + col);
                const u32x2 a = *(const u32x2*)(m0 + col), b = *(const u32x2*)(m1 + col);
                f32x4 mo; mo.x = w0 * bf_lo(a.x) + w1 * bf_lo(b.x); mo.y = w0 * bf_hi(a.x) + w1 * bf_hi(b.x); mo.z = w0 * bf_lo(a.y) + w1 * bf_lo(b.y); mo.w = w0 * bf_hi(a.y) + w1 * bf_hi(b.y);
                v[j] = ALPHA * x1 + g2 * mo; s += (v[j].x + v[j].y) + (v[j].z + v[j].w); }
            const float mean = wave_sum(s) * (1.f / DM); float s2 = 0.f;
#pragma unroll
            for (int j = 0; j < 4; ++j) { v[j] = v[j] - mean; s2 += (v[j].x * v[j].x + v[j].y * v[j].y) + (v[j].z * v[j].z + v[j].w * v[j].w); }
            const float rstd = 1.f / sqrtf(wave_sum(s2) * (1.f / DM) + LN_EPS);
#pragma unroll
            for (int j = 0; j < 4; ++j) { const int col = 4 * F.lane + 256 * j;
                const f32x4 g = *(const f32x4*)(INP(I_LNG) + ((l - 1) * 2 + 1) * DM + col), b = *(const f32x4*)(INP(I_LNB) + ((l - 1) * 2 + 1) * DM + col);
                v[j] = v[j] * rstd * g + b; }
        }
        if (l == 4) {
#pragma unroll
            for (int j = 0; j < 4; ++j) *(f32x4*)(out + (size_t)(row - NCTX) * DM + 4 * F.lane + 256 * j) = v[j];
        } else {
            const float* mq = MODV + (l * 2 + isctx) * 6144;
#pragma unroll
            for (int j = 0; j < 4; ++j) { const int col = 4 * F.lane + 256 * j;
                *(f32x4*)(XB + (size_t)row * DM + col) = v[j];
                const f32x4 sh = *(const f32x4*)(mq + col), sc = *(const f32x4*)(mq + 1024 + col);
                const f32x4 h = v[j] * (1.f + sc) + sh;
                u32x2 w; w.x = cvt_pk_bf16(h.x, h.y); w.y = cvt_pk_bf16(h.z, h.w);
                *(u32x2*)(HB + (size_t)row * DM + col) = w; }
        }
    }
}

__device__ __forceinline__ void kmax_begin(const Ctx& F) { if (F.tid < 16) F.lc[LC_KMAX + F.tid] = 0; __syncthreads(); }
__device__ __forceinline__ void kmax_end(const Ctx& F, int l, int nheads) {
    __syncthreads();
    if (F.tid < nheads) { const unsigned v = (unsigned)F.lc[LC_KMAX + F.tid]; if (v) atomicMax((unsigned*)(F.ws + WS_CTL) + CW_KMAX + (l * 16 + F.tid) * 64, v); }
}
__device__ __forceinline__ void rope8(u32x4& a, u32x4& b, const float* T) {
    unsigned* pa = (unsigned*)&a; unsigned* pb = (unsigned*)&b;
#pragma unroll
    for (int j = 0; j < 4; ++j) { const f32x4 cs = *(const f32x4*)(T + 4 * j);
        const float x10 = bf_lo(pa[j]), x11 = bf_hi(pa[j]), x20 = bf_lo(pb[j]), x21 = bf_hi(pb[j]);
        pa[j] = cvt_pk_bf16(x10 * cs.x - x20 * cs.y, x11 * cs.z - x21 * cs.w);
        pb[j] = cvt_pk_bf16(x10 * cs.y + x20 * cs.x, x11 * cs.w + x21 * cs.z); }
}
__device__ __forceinline__ float ss8(const u32x4& a) {
    const unsigned* p = (const unsigned*)&a; float s = 0.f;
#pragma unroll
    for (int j = 0; j < 4; ++j) { const float lo = bf_lo(p[j]), hi = bf_hi(p[j]); s = fmaf(lo, lo, s); s = fmaf(hi, hi, s); }
    return s;
}
__device__ __forceinline__ u32x2 pk8(const u32x4& a) {
    u32x2 w; w.x = att::f8x4(bf_lo(a.x), bf_hi(a.x), bf_lo(a.y), bf_hi(a.y)); w.y = att::f8x4(bf_lo(a.z), bf_hi(a.z), bf_lo(a.w), bf_hi(a.w)); return w; }
__device__ __forceinline__ void vimg_build(const Ctx& F, const bf16_t* QKV, int ld, int col0, int nheads) {
    unsigned char* VF8 = F.ws + WS_VF8;
    for (int it = F.gw; it < nheads * NTILE; it += F.NGW) {
        const int h = it / NTILE, tile = it - h * NTILE;
        unsigned char* img = VF8 + (size_t)it * 8192;
#pragma unroll 1
        for (int pass = 0; pass < 2; ++pass) { const int n = pass * 64 + F.lane;
            const bf16_t* src = QKV + (size_t)(tile * 64) * ld + col0 + h * 128 + n;
            float v[64];
#pragma unroll
            for (int k = 0; k < 64; ++k) v[k] = __uint_as_float(((unsigned)src[(size_t)k * ld]) << 16);
#pragma unroll
            for (int c = 0; c < 4; ++c) { u32x4 w;
#pragma unroll
                for (int d = 0; d < 4; ++d) { const int j = 16 * c + 4 * d, hh = j >> 5, e = j & 31;
                    w[d] = att::f8x4(v[att::kap(hh, e)], v[att::kap(hh, e + 1)], v[att::kap(hh, e + 2)], v[att::kap(hh, e + 3)]); }
                *(u32x4*)(img + att::vimg_off(n, 16 * c)) = w; } }
    }
}
__device__ __forceinline__ void phase_c_even(const Ctx& F, int l) {
    bf16_t* QKV = (bf16_t*)(F.ws + WS_QKV); const float* T = (const float*)(F.ws + WS_TAB64); unsigned char* KF8 = F.ws + WS_KF8;
    kmax_begin(F);
    const int sub = F.lane >> 2, q = F.lane & 3;
    const int e1 = (q >> 1) * 32 + (q & 1) * 8;
    const int nitems = SEQ * 10;
    for (int it = F.gw * 16 + sub; it < nitems; it += F.NGW * 16) {
        const int t = it / 10, hd = it - t * 10;
        const int col = hd < 2 ? 512 + 64 * hd : 1280 + 64 * (hd - 2);
        const int pos = (q >> 1) ? (t & 63) : (t >> 6);
        bf16_t* p = QKV + (size_t)(NCTX + t) * EVEN_IN + col + e1;
        u32x4 a = *(const u32x4*)p, b = *(const u32x4*)(p + 16);
        float ss = ss8(a) + ss8(b);
        rope8(a, b, T + (pos * 16 + (q & 1) * 8) * 2);
        *(u32x4*)p = a; *(u32x4*)(p + 16) = b;
        if (hd >= 2) {
            const int row = NCTX + t; unsigned char* img = KF8 + ((size_t)(hd - 2) * NTILE + (row >> 6)) * 4096;
            *(u32x2*)(img + att::kimg_off<64>(row & 63, e1)) = pk8(a); *(u32x2*)(img + att::kimg_off<64>(row & 63, e1 + 16)) = pk8(b); }
        ss += __shfl_xor(ss, 1); ss += __shfl_xor(ss, 2);
        if (q == 0 && hd >= 2) __hip_atomic_fetch_max((LAS unsigned*)(F.lc + LC_KMAX) + (hd - 2), __float_as_uint(ss), __ATOMIC_RELAXED, __HIP_MEMORY_SCOPE_WORKGROUP);
    }
    for (int it = F.gw * 16 + sub; it < NCTX * 8; it += F.NGW * 16) {
        const int row = it >> 3, hd = it & 7;
        const bf16_t* p = QKV + (size_t)row * EVEN_IN + 1280 + 64 * hd + 16 * q;
        const u32x4 a = *(const u32x4*)p, b = *(const u32x4*)(p + 8);
        float ss = ss8(a) + ss8(b);
        { unsigned char* img = KF8 + ((size_t)hd * NTILE + (row >> 6)) * 4096; const u32x2 w0 = pk8(a), w1 = pk8(b);
          *(u32x4*)(img + att::kimg_off<64>(row & 63, 16 * q)) = (u32x4){w0.x, w0.y, w1.x, w1.y}; }
        ss += __shfl_xor(ss, 1); ss += __shfl_xor(ss, 2);
        if (q == 0) __hip_atomic_fetch_max((LAS unsigned*)(F.lc + LC_KMAX) + hd, __float_as_uint(ss), __ATOMIC_RELAXED, __HIP_MEMORY_SCOPE_WORKGROUP);
    }
    vimg_build(F, QKV, EVEN_IN, 1792, 4);
    kmax_end(F, l, 8);
}
__device__ __forceinline__ void phase_c_odd(const Ctx& F, int li, int l) {
    bf16_t* QKV = (bf16_t*)(F.ws + WS_QKV); const float* T = (const float*)(F.ws + WS_TAB128); unsigned char* KF8 = F.ws + WS_KF8;
    const float* g = INP(I_KNG) + li * 128;
    kmax_begin(F);
    const int sub = F.lane >> 3, q = F.lane & 7;
    const int e1 = (q >> 2) * 64 + (q & 3) * 8;
    const int nitems = MROWS * 2;
    for (int it = F.gw * 8 + sub; it < nitems; it += F.NGW * 8) {
        const int row = it >> 1, hd = it & 1;
        bf16_t* p = QKV + (size_t)row * ODD_IN + 1024 + hd * 128 + e1;
        u32x4 a = *(const u32x4*)p, b = *(const u32x4*)(p + 32);
        float ss = ss8(a) + ss8(b);
        ss += __shfl_xor(ss, 1); ss += __shfl_xor(ss, 2); ss += __shfl_xor(ss, 4);
        const float rs = 1.f / sqrtf(ss * (1.f / 128.f) + QK_EPS);
        { unsigned* pa = (unsigned*)&a; unsigned* pb = (unsigned*)&b;
#pragma unroll
          for (int j = 0; j < 4; ++j) { const f32x2 ga = *(const f32x2*)(g + e1 + 2 * j), gb = *(const f32x2*)(g + e1 + 32 + 2 * j);
              pa[j] = cvt_pk_bf16(bf_lo(pa[j]) * rs * ga.x, bf_hi(pa[j]) * rs * ga.y); pb[j] = cvt_pk_bf16(bf_lo(pb[j]) * rs * gb.x, bf_hi(pb[j]) * rs * gb.y); } }
        float s2 = ss8(a) + ss8(b);
        s2 += __shfl_xor(s2, 1); s2 += __shfl_xor(s2, 2); s2 += __shfl_xor(s2, 4);
        if (q == 0) __hip_atomic_fetch_max((LAS unsigned*)(F.lc + LC_KMAX) + hd, __float_as_uint(s2), __ATOMIC_RELAXED, __HIP_MEMORY_SCOPE_WORKGROUP);
        if (row >= NCTX) { const int t = row - NCTX, pos = (q >> 2) ? (t & 63) : (t >> 6); rope8(a, b, T + (pos * 32 + (q & 3) * 8) * 2); }
        *(u32x4*)p = a; *(u32x4*)(p + 32) = b;
        { unsigned char* img = KF8 + ((size_t)hd * NTILE + (row >> 6)) * 8192;
          *(u32x2*)(img + att::kimg_off<128>(row & 63, e1)) = pk8(a); *(u32x2*)(img + att::kimg_off<128>(row & 63, e1 + 32)) = pk8(b); }
    }
    vimg_build(F, QKV, ODD_IN, 1280, 2);
    kmax_end(F, l, 2);
}

#define ATT_COMMON const bf16_t* QKV = (const bf16_t*)(F.ws + WS_QKV); bf16_t* OB = (bf16_t*)(F.ws + WS_OB); float* SCR = (float*)(F.ws + WS_YB); \
    char* lds = (char*)(unsigned char*)F.lds; (void)SCR; (void)OB;
#define EPI_TID() int te = F.wave * 64 + lane_id(); asm volatile("" : "+v"(te)); const int lane = te & 63, wid = te >> 6, r32 = lane & 31; (void)r32; (void)wid; (void)lane
__device__ __forceinline__ void phase_d_b0(const Ctx& F, int l) {
    ATT_COMMON
    for (int u = F.c; u < 260; u += F.G) {
        const bool isctx = u >= 256; const int h = isctx ? u - 256 : (u >> 6); const int row0 = isctx ? 0 : NCTX + (u & 63) * 256; const int seq = isctx ? NCTX : MROWS;
        f32x16 o[4];
        const float kmaxC = sqrtf(__uint_as_float(__hip_atomic_load((unsigned*)(F.ws + WS_CTL) + CW_KMAX + (l * 16 + 2 * h) * 64, RLX_AGENT))) * (0.125f * LOG2E * 1.02f);
#if ATT_F8
        att::attn_core_f8<64>(F.wave * 64 + lane_id(), QKV + (size_t)row0 * EVEN_IN + 768 + (2 * h) * 64, EVEN_IN, F.ws + WS_KF8 + (size_t)(2 * h) * NTILE * 4096, F.ws + WS_VF8 + (size_t)h * NTILE * 8192, seq, F.lds, o, nullptr, (const float*)(F.ws + WS_TAB64), isctx ? -1 : (u & 63) * 256, kmaxC);
#else
        att::attn_core_il<64>(F.tid, QKV + (size_t)row0 * EVEN_IN + 768 + (2 * h) * 64, EVEN_IN, QKV + 1280 + (2 * h) * 64, QKV + 1792 + h * 128, EVEN_IN, seq, kmaxC, F.lds, o, nullptr, (const float*)(F.ws + WS_TAB64), isctx ? -1 : (u & 63) * 256);
#endif
        EPI_TID();
        float* scr = SCR + (size_t)u * 32768 + (size_t)wid * 4096 + lane;
#pragma unroll
        for (int r = 0; r < 16; ++r)
#pragma unroll
            for (int d = 0; d < 4; ++d) scr[(r * 4 + d) * 64] = o[d][r];
    }
}
__device__ __forceinline__ void phase_d_b1(const Ctx& F, int li, int l) { const int lam_layer = l;
    ATT_COMMON
    for (int u = (F.c + F.G - 4) % F.G; u < 260; u += F.G) {
        const bool isctx = u >= 256; const int h = isctx ? u - 256 : (u >> 6); const int row0 = isctx ? 0 : NCTX + (u & 63) * 256; const int seq = isctx ? NCTX : MROWS;
        f32x16 o[4];
        const float kmaxC = sqrtf(__uint_as_float(__hip_atomic_load((unsigned*)(F.ws + WS_CTL) + CW_KMAX + (l * 16 + 2 * h + 1) * 64, RLX_AGENT))) * (0.125f * LOG2E * 1.02f);
#if ATT_F8
        att::attn_core_f8<64>(F.wave * 64 + lane_id(), QKV + (size_t)row0 * EVEN_IN + 768 + (2 * h + 1) * 64, EVEN_IN, F.ws + WS_KF8 + (size_t)(2 * h + 1) * NTILE * 4096, F.ws + WS_VF8 + (size_t)h * NTILE * 8192, seq, F.lds, o, nullptr, (const float*)(F.ws + WS_TAB64), isctx ? -1 : (u & 63) * 256, kmaxC);
#else
        att::attn_core_il<64>(F.tid, QKV + (size_t)row0 * EVEN_IN + 768 + (2 * h + 1) * 64, EVEN_IN, QKV + 1280 + (2 * h + 1) * 64, QKV + 1792 + h * 128, EVEN_IN, seq, kmaxC, F.lds, o, nullptr, (const float*)(F.ws + WS_TAB64), isctx ? -1 : (u & 63) * 256);
#endif
        EPI_TID();
        const float* scr = SCR + (size_t)u * 32768 + (size_t)wid * 4096 + lane;
        const float lam = __hip_atomic_load((float*)(F.ws + WS_LAM) + li, RLX_AGENT);
        const float lam_init = 0.8f - 0.6f * expf(-0.3f * (float)lam_layer);
        const float* sg = INP(I_SUBG) + li * 128;
#pragma unroll
        for (int r = 0; r < 16; ++r) { float s = 0.f;
#pragma unroll
            for (int d = 0; d < 4; ++d) { const float v = scr[(r * 4 + d) * 64] - lam * o[d][r]; o[d][r] = v; s += v * v; }
#pragma unroll
            for (int mm = 1; mm < 32; mm <<= 1) s += __shfl_xor(s, mm);
            s = (1.f - lam_init) / sqrtf(s * (1.f / 128.f) + SUBLN_EPS);
#pragma unroll
            for (int d = 0; d < 4; ++d) o[d][r] *= s * sg[d * 32 + r32]; }
        att::store_o_lds<4>(te, o, OB + (size_t)row0 * DM + 512 + h * 128, DM, lds);
    }
}
__device__ __forceinline__ void phase_d_a(const Ctx& F, int li) {
    ATT_COMMON
    for (int u = F.c; u < 520; u += F.G) {
        const bool isctx = u >= 512; const int hq = isctx ? u - 512 : (u >> 6); const int q0lat = isctx ? 0 : (u & 63) * 256; const int row0 = isctx ? 0 : NCTX + q0lat; const int seq = isctx ? NCTX : NCTX + 512;
        const int kvh = hq >> 2; const float sink = INP(I_SINK)[li * 8 + hq];
        f32x16 o[2];
        att::attn_core<64, 64, true, 2>(F.wave * 64 + lane_id(), QKV + (size_t)row0 * EVEN_IN + hq * 64, EVEN_IN, QKV + 512 + kvh * 64, QKV + 640 + kvh * 64, EVEN_IN, seq, q0lat, sink * 8.f, 1.f, lds, o, (const float*)(F.ws + WS_TAB64), isctx ? -1 : q0lat);
        EPI_TID();
        att::store_o_lds<2>(te, o, OB + (size_t)row0 * DM + hq * 64, DM, lds);
    }
}
__device__ __forceinline__ void phase_d_odd(const Ctx& F, int l) {
    const bf16_t* QKV = (const bf16_t*)(F.ws + WS_QKV); bf16_t* OB = (bf16_t*)(F.ws + WS_OB);
    char* lds = (char*)(unsigned char*)F.lds;
    const int nun = (l == DEPTH - 1) ? 512 : 520;
    for (int u = F.c; u < nun; u += F.G) {
        const bool isctx = u >= 512; const int hq = isctx ? u - 512 : (u >> 6); const int row0 = isctx ? 0 : NCTX + (u & 63) * 256; const int seq = isctx ? NCTX : MROWS;
        const int kvh = hq >> 2;
        f32x16 o[4];
        const float kmaxC = sqrtf(__uint_as_float(__hip_atomic_load((unsigned*)(F.ws + WS_CTL) + CW_KMAX + (l * 16 + kvh) * 64, RLX_AGENT))) * (0.088388347648318440f * LOG2E * 1.02f);
#if ATT_F8
        att::attn_core_f8<128>(F.wave * 64 + lane_id(), QKV + (size_t)row0 * ODD_IN + hq * 128, ODD_IN, F.ws + WS_KF8 + (size_t)kvh * NTILE * 8192, F.ws + WS_VF8 + (size_t)kvh * NTILE * 8192, seq, F.lds, o, INP(I_QNG) + (l >> 1) * 128, (const float*)(F.ws + WS_TAB128), isctx ? -1 : (u & 63) * 256, kmaxC);
#else
        att::attn_core_il<128>(F.tid, QKV + (size_t)row0 * ODD_IN + hq * 128, ODD_IN, QKV + 1024 + kvh * 128, QKV + 1280 + kvh * 128, ODD_IN, seq, kmaxC, F.lds, o, INP(I_QNG) + (l >> 1) * 128, (const float*)(F.ws + WS_TAB128), isctx ? -1 : (u & 63) * 256);
#endif
        EPI_TID();
        att::store_o_lds<4>(te, o, OB + (size_t)row0 * DM + hq * 128, DM, lds);
    }
}


__device__ __forceinline__ void ctx_outproj_mini(const Ctx& F, const bf16_t* O, const bf16_t* Wt, bf16_t* Y) {
    for (int blk = F.c; blk < 256; blk += F.G) {
        const int rb = blk >> 4, cb = blk & 15, fr = F.lane & 15, fq = F.lane >> 4, kb = F.wave * 128;
        f32x4 acc[4];
#pragma unroll
        for (int n = 0; n < 4; ++n) acc[n] = (f32x4){0.f, 0.f, 0.f, 0.f};
        const bf16_t* ap = O + (size_t)(rb * 16 + fr) * DM + kb + 8 * fq;
        const bf16_t* bp = Wt + (size_t)(cb * 64 + fr) * DM + kb + 8 * fq;
#pragma unroll
        for (int k = 0; k < 4; ++k) { const bf16x8 a = *(const bf16x8*)(ap + 32 * k);
#pragma unroll
            for (int n = 0; n < 4; ++n) { const bf16x8 b = *(const bf16x8*)(bp + (size_t)(16 * n) * DM + 32 * k); acc[n] = __builtin_amdgcn_mfma_f32_16x16x32_bf16(b, a, acc[n], 0, 0, 0); } }
        LAS float* red = (LAS float*)F.lds + F.wave * 1024;
#pragma unroll
        for (int n = 0; n < 4; ++n) *(LAS f32x4*)(red + fr * 64 + 16 * n + 4 * fq) = acc[n];
        __syncthreads();
        { const int e = F.tid * 2; float s0 = 0.f, s1 = 0.f;
#pragma unroll
          for (int w = 0; w < 8; ++w) { const f32x2 v = *(const LAS f32x2*)((LAS float*)F.lds + w * 1024 + e); s0 += v.x; s1 += v.y; }
          const int row = e >> 6, col = e & 63;
          *(unsigned*)(Y + (size_t)(rb * 16 + row) * DM + cb * 64 + col) = cvt_pk_bf16(s0, s1); }
        __syncthreads();
    }
}
__device__ __forceinline__ void phase_f(const Ctx& F, int l, int row_lo, bool dry = false) {
    unsigned char* ws = F.ws;
    const float* XB = (const float*)(ws + WS_XB); const bf16_t* YB = (const bf16_t*)(ws + WS_YB); float* X1B = (float*)(ws + WS_X1B); bf16_t* HB = (bf16_t*)(ws + WS_HB);
    const float* MODV = (const float*)(ws + WS_MODV); i32x4* ROUTE = (i32x4*)(ws + WS_ROUTE); int* IDX = (int*)(ws + WS_IDX);
    LAS float* wr_l = (LAS float*)F.lds;
    for (int i = F.tid; i < 16384; i += NTHREADS) wr_l[(i & 15) * 1024 + (i >> 4)] = INP(I_WR)[i];
    if (F.tid < 16) F.lc[LC_LCNT + F.tid] = 0;
    __syncthreads();
    float br[16];
#pragma unroll
    for (int e = 0; e < 16; ++e) br[e] = INP(I_BR)[e];
    int nr = 0;
    for (int row = row_lo + F.gw; row < MROWS; row += F.NGW, ++nr) {
        const int isctx = row < NCTX ? 1 : 0; const float* mp = MODV + (l * 2 + isctx) * 6144;
        f32x4 v[4]; float s = 0.f;
#pragma unroll
        for (int j = 0; j < 4; ++j) { const int col = 4 * F.lane + 256 * j;
            const f32x4 x = *(const f32x4*)(XB + (size_t)row * DM + col), g1 = *(const f32x4*)(mp + 2048 + col); const u32x2 yw = *(const u32x2*)(YB + (size_t)row * DM + col);
            const f32x4 y = {bf_lo(yw.x), bf_hi(yw.x), bf_lo(yw.y), bf_hi(yw.y)};
            v[j] = ALPHA * x + g1 * y; s += (v[j].x + v[j].y) + (v[j].z + v[j].w); }
        const float mean = wave_sum(s) * (1.f / DM); float s2 = 0.f;
#pragma unroll
        for (int j = 0; j < 4; ++j) { v[j] = v[j] - mean; s2 += (v[j].x * v[j].x + v[j].y * v[j].y) + (v[j].z * v[j].z + v[j].w * v[j].w); }
        const float rstd = 1.f / sqrtf(wave_sum(s2) * (1.f / DM) + LN_EPS);
#pragma unroll
        for (int j = 0; j < 4; ++j) { const int col = 4 * F.lane + 256 * j;
            const f32x4 g = *(const f32x4*)(INP(I_LNG) + (l * 2) * DM + col), b = *(const f32x4*)(INP(I_LNB) + (l * 2) * DM + col);
            v[j] = v[j] * rstd * g + b;
            *(f32x4*)(X1B + (size_t)row * DM + col) = v[j];
            const f32x4 sh = *(const f32x4*)(mp + 3072 + col), sc = *(const f32x4*)(mp + 4096 + col);
            v[j] = v[j] * (1.f + sc) + sh;
            u32x2 w; w.x = cvt_pk_bf16(v[j].x, v[j].y); w.y = cvt_pk_bf16(v[j].z, v[j].w);
            *(u32x2*)(HB + (size_t)row * DM + col) = w; }
        float sc[16], sel[16];
#pragma unroll
        for (int e = 0; e < 16; ++e) { float a = 0.f;
#pragma unroll
            for (int j = 0; j < 4; ++j) { const f32x4 w = *(const LAS f32x4*)(wr_l + e * 1024 + 4 * F.lane + 256 * j); a += (v[j].x * w.x + v[j].y * w.y) + (v[j].z * w.z + v[j].w * w.w); }
            a = wave_sum(a); sc[e] = 1.f / (1.f + __expf(-a)); sel[e] = sc[e] + br[e]; }
        int best = 0; float bestv = -3.0e38f; int ci0[4], ci1[4]; float cw0[4], cw1[4];
#pragma unroll
        for (int g = 0; g < 4; ++g) {
            const float a = sel[4 * g], b = sel[4 * g + 1], c2 = sel[4 * g + 2], d = sel[4 * g + 3];
            int i0 = 0; float m0 = a; if (b > m0) { m0 = b; i0 = 1; } if (c2 > m0) { m0 = c2; i0 = 2; } if (d > m0) { m0 = d; i0 = 3; }
            int i1 = -1; float m1 = -3.0e38f;
            if (i0 != 0 && a > m1) { m1 = a; i1 = 0; } if (i0 != 1 && b > m1) { m1 = b; i1 = 1; } if (i0 != 2 && c2 > m1) { m1 = c2; i1 = 2; } if (i0 != 3 && d > m1) { m1 = d; i1 = 3; }
            const float gs = m0 + m1; if (gs > bestv) { bestv = gs; best = g; }
            ci0[g] = 4 * g + i0; ci1[g] = 4 * g + i1;
            const float s0 = sc[4 * g], s1 = sc[4 * g + 1], s2_ = sc[4 * g + 2], s3 = sc[4 * g + 3];
            cw0[g] = i0 == 0 ? s0 : (i0 == 1 ? s1 : (i0 == 2 ? s2_ : s3)); cw1[g] = i1 == 0 ? s0 : (i1 == 1 ? s1 : (i1 == 2 ? s2_ : s3)); }
        const int e0 = best == 0 ? ci0[0] : (best == 1 ? ci0[1] : (best == 2 ? ci0[2] : ci0[3])), e1 = best == 0 ? ci1[0] : (best == 1 ? ci1[1] : (best == 2 ? ci1[2] : ci1[3]));
        float w0 = best == 0 ? cw0[0] : (best == 1 ? cw0[1] : (best == 2 ? cw0[2] : cw0[3])), w1 = best == 0 ? cw1[0] : (best == 1 ? cw1[1] : (best == 2 ? cw1[2] : cw1[3]));
        const float wn = 1.f / (w0 + w1); w0 *= wn; w1 *= wn;
        if (F.lane == 0 && !dry) {
            const int lp0 = __hip_atomic_fetch_add(F.lc + LC_LCNT + e0, 1, __ATOMIC_RELAXED, __HIP_MEMORY_SCOPE_WORKGROUP);
            const int lp1 = __hip_atomic_fetch_add(F.lc + LC_LCNT + e1, 1, __ATOMIC_RELAXED, __HIP_MEMORY_SCOPE_WORKGROUP);
            LAS int* wt = F.lc + LC_WTAB + (F.wave * 16 + nr) * 8;
            wt[0] = row; wt[1] = e0; wt[2] = lp0; wt[3] = e1; wt[4] = lp1; wt[5] = __float_as_int(w0); wt[6] = __float_as_int(w1); }
    }
    __syncthreads();
    if (dry) return;
    if (F.tid < 16) { const int n = F.lc[LC_LCNT + F.tid];
        const unsigned base = n ? xb_add((unsigned*)(ws + WS_CTL) + CW_CNT + (l * 16 + F.tid) * 64, (unsigned)n) : 0u;
        F.lc[LC_GBASE + F.tid] = (int)base; }
    __syncthreads();
    if (F.lane < nr) {
        const LAS int* wt = F.lc + LC_WTAB + (F.wave * 16 + F.lane) * 8;
        const int row = wt[0], e0 = wt[1], e1 = wt[3]; const int p0 = F.lc[LC_GBASE + e0] + wt[2], p1 = F.lc[LC_GBASE + e1] + wt[4];
        IDX[e0 * MROWS + p0] = row; IDX[e1 * MROWS + p1] = row;
        i32x4 rt; rt.x = (e0 << 15) | p0; rt.y = (e1 << 15) | p1; rt.z = wt[5]; rt.w = wt[6];
        ROUTE[row] = rt; }
}

__global__ void __launch_bounds__(NTHREADS, 2) mk_fwd(Args args) {
    extern __shared__ __attribute__((aligned(16))) unsigned char lds_raw[];
    LAS int* lc0 = (LAS int*)((LAS unsigned char*)lds_raw + LDSCTL_OFF);
    const int wave_s = __builtin_amdgcn_readfirstlane((int)threadIdx.x >> 6);
    for (int u = wave_s * 64 + lane_id(); u < (LDS_BYTES - LDSCTL_OFF) / 4; u += NTHREADS) lc0[u] = 0;
    __syncthreads();
#define IS_T0 (wave_s == 0 && lane_id() == 0)
    unsigned* barw = (unsigned*)(args.ws + WS_CTL) + CW_BAR;
#if MK_MULTI
    XcdBarrier bar; bar.bar = barw; bar.x = 0; bar.st = nullptr;
#define GRID_BAR() do { } while (0)
#else
    XcdBarrier bar = xcd_barrier_post(barw, (volatile LAS unsigned*)(lc0 + LC_BAR), IS_T0);
#define GRID_BAR() xcd_barrier(bar, IS_T0)
#endif
    const int lo = args.ph_lo, hi = args.ph_hi;
#ifndef PHMASK
#define PHMASK 0xFFFF
#endif
#define EN(b) ((PHMASK >> (b)) & 1)
#ifndef REP_MASK
#define REP_MASK 0
#endif
#define REP_CAT2(a, b) a##b
#define REP_CAT(a, b) REP_CAT2(a, b)
#define REP(b) for (int REP_CAT(_rep, __LINE__) = 0; REP_CAT(_rep, __LINE__) < 1 + ((REP_MASK >> (b)) & 1); ++REP_CAT(_rep, __LINE__))
#define IN(k) (lo <= (k) && (k) < hi)
#define SEAM(k) do { if (IN(k) && IN((k) + 1)) GRID_BAR(); } while (0)

    if (IN(0) && EN(0)) REP(0) { const Ctx F = make_ctx(wave_s); p0_prologue(F); } SEAM(0);

    for (int l = 0; l < DEPTH; ++l) {
        const int pb = 1 + 8 * l, li = l >> 1; const bool odd = (l & 1) != 0;
        const int pm_lo = (l == DEPTH - 1) ? 1 : 0;
        if (IN(pb + 0) && EN(1)) REP(1) { const Ctx F = make_ctx(wave_s); phase_a(F, l, nullptr); } SEAM(pb + 0);
        if (IN(pb + 1) && EN(2)) REP(2) {
            const Ctx F = make_ctx(wave_s); unsigned char* ws = F.ws; const int NIN = odd ? ODD_IN : EVEN_IN;
            pg8::DenseSched S; S.init((const bf16_t*)(ws + WS_HB), odd ? (const bf16_t*)(ws + WS_WINO) + (size_t)li * ODD_IN * DM : (const bf16_t*)(ws + WS_WINE) + (size_t)li * EVEN_IN * DM, DM, 0, MROWS / 256, NIN, F.G, F.c);
            pg8::EpiBf16 E{(bf16_t*)(ws + WS_QKV), NIN};
            pg8::gemm_phase<pg8::EpiBf16, pg8::DenseSched>(F.tid, F.lds, DM, S, E);
        } SEAM(pb + 1);
        if (IN(pb + 2) && EN(3)) { const Ctx F = make_ctx(wave_s); if (odd) phase_c_odd(F, li, l); else phase_c_even(F, l); } SEAM(pb + 2);
        if (IN(pb + 3) && EN(4)) REP(4) {
#ifndef ATTSEL
#define ATTSEL 15
#endif
            if (odd) { if (ATTSEL & 8) REP(11) { const Ctx F = make_ctx(wave_s); phase_d_odd(F, l); } }
            else { REP(9) { if (ATTSEL & 1) { const Ctx F = make_ctx(wave_s); phase_d_b0(F, l); } if (ATTSEL & 2) { const Ctx F = make_ctx(wave_s); phase_d_b1(F, li, l); } } if (ATTSEL & 4) REP(10) { const Ctx F = make_ctx(wave_s); phase_d_a(F, li); } }
        } SEAM(pb + 3);
        if (IN(pb + 4) && EN(5)) REP(5) {
            const Ctx F = make_ctx(wave_s); unsigned char* ws = F.ws;
            pg8::DenseSched S; S.init((const bf16_t*)(ws + WS_OB), (const bf16_t*)(ws + WS_WOUT) + (size_t)l * DM * DM, DM, 1, MROWS / 256 - 1, DM, F.G, F.c);
            pg8::EpiBf16 E{(bf16_t*)(ws + WS_YB), DM};
            pg8::gemm_phase<pg8::EpiBf16, pg8::DenseSched>(F.tid, F.lds, DM, S, E);
            if (pm_lo == 0) ctx_outproj_mini(F, (const bf16_t*)(ws + WS_OB), (const bf16_t*)(ws + WS_WOUT) + (size_t)l * DM * DM, (bf16_t*)(ws + WS_YB));
        } SEAM(pb + 4);
#ifdef PF_PROBE
        if (IN(pb + 5) && EN(6)) { const Ctx F = make_ctx(wave_s); phase_f(F, l, pm_lo * 256, true); __syncthreads(); }
#endif
        if (IN(pb + 5) && EN(6)) { const Ctx F = make_ctx(wave_s); phase_f(F, l, pm_lo * 256); } SEAM(pb + 5);
#define MOE_GU_SCHED(S) pg8::MoeSched<true> S; S.Ab = (const bf16_t*)(ws + WS_HB); S.Wb = (const bf16_t*)(ws + WS_WGU) + (size_t)l * NEXP * 1024 * DM; S.idx = (const int*)(ws + WS_IDX); \
            S.tstart = F.lc + LC_TSTART; S.ecnt = F.lc + LC_ECNT; S.K = DM
#define MOE_DN_SCHED(S) pg8::MoeSched<false> S; S.Ab = (const bf16_t*)(ws + WS_YB); S.Wb = (const bf16_t*)(ws + WS_WD) + (size_t)l * NEXP * DM * DEXP; S.idx = nullptr; \
            S.tstart = F.lc + LC_TSTART; S.ecnt = F.lc + LC_ECNT; S.K = DEXP
        int moe_nu = 0, moe_r = 0; bool moe_split = false;
        if ((IN(pb + 6) && EN(7)) || (IN(pb + 7) && EN(8))) { const Ctx F = make_ctx(wave_s); load_tstart(F, l); moe_nu = __builtin_amdgcn_readfirstlane(F.lc[LC_TSTART + 16]) * 4;
            moe_r = moe_nu - 2 * F.G; moe_split = (MK_MULTI == 0) && (REP_MASK == 0) && moe_r > 0 && 3 * moe_r <= F.G; }
        if (IN(pb + 6) && EN(7)) REP(7) {
            const Ctx F = make_ctx(wave_s); unsigned char* ws = F.ws;
            MOE_GU_SCHED(S); S.base = F.c; S.stride = F.G; S.hi = moe_split ? 2 * F.G : moe_nu;
            pg8::EpiGateUp E{(bf16_t*)(ws + WS_YB)};
            pg8::gemm_phase<pg8::EpiGateUp, pg8::MoeSched<true>>(F.tid, F.lds, DM, S, E);
        } SEAM(pb + 6);
        if (IN(pb + 7) && EN(8)) REP(8) {
            if (!moe_split) {
                const Ctx F = make_ctx(wave_s); unsigned char* ws = F.ws;
                MOE_DN_SCHED(S); S.base = F.c; S.stride = F.G; S.hi = moe_nu;
                pg8::EpiBf16 E{(bf16_t*)(ws + WS_QKV), DM};
                pg8::gemm_phase<pg8::EpiBf16, pg8::MoeSched<false>>(F.tid, F.lds, DEXP, S, E);
            } else {
                { const Ctx F = make_ctx(wave_s); unsigned char* ws = F.ws;
                  MOE_GU_SCHED(S); S.base = 2 * F.G + F.c; S.stride = F.G; S.hi = moe_nu;
                  pg8::EpiGateUp E{(bf16_t*)(ws + WS_YB)};
                  pg8::gemm_phase<pg8::EpiGateUp, pg8::MoeSched<true>>(F.tid, F.lds, DM, S, E); }
                { const Ctx F = make_ctx(wave_s); unsigned char* ws = F.ws;
                  MOE_DN_SCHED(S); S.base = F.c >= moe_r ? 2 * (F.c - moe_r) : 0; S.stride = 1; S.hi = F.c >= moe_r ? S.base + 2 : 0;
                  pg8::EpiBf16 E{(bf16_t*)(ws + WS_QKV), DM};
                  pg8::gemm_phase<pg8::EpiBf16, pg8::MoeSched<false>>(F.tid, F.lds, DEXP, S, E); }
                GRID_BAR();
                { const Ctx F = make_ctx(wave_s); unsigned char* ws = F.ws;
                  MOE_DN_SCHED(S); S.base = 2 * (F.G - moe_r) + F.c; S.stride = F.G; S.hi = moe_nu;
                  pg8::EpiBf16 E{(bf16_t*)(ws + WS_QKV), DM};
                  pg8::gemm_phase<pg8::EpiBf16, pg8::MoeSched<false>>(F.tid, F.lds, DEXP, S, E); }
            }
        } SEAM(pb + 7);
    }
    if (IN(33) && EN(1)) { const Ctx F = make_ctx(wave_s); float* outp = (float*)*(GAS float* const CAS*)((const CAS char*)F.in + 200); phase_a(F, 4, outp); }
#undef IN
#undef SEAM
}

constexpr int NPHASE = 34;
extern "C" void kernel_launch(void* const* d_in, const int* in_sizes, int n_in, void* d_out, int out_size, void* d_ws, size_t ws_size, hipStream_t stream) {
    static int grid = 0;
    if (grid == 0) {
        if (n_in != 25 || out_size != SEQ * DM || ws_size < WS_END) { fprintf(stderr, "kernel_launch: shape mismatch n_in %d out %d ws %zu (need %zu)\n", n_in, out_size, ws_size, (size_t)WS_END); grid = -1; return; }
        int dev = 0, cus = 0, per_cu = 0;
        if (hipGetDevice(&dev) != hipSuccess || hipDeviceGetAttribute(&cus, hipDeviceAttributeMultiprocessorCount, dev) != hipSuccess) { grid = -1; return; }
        if (hipFuncSetAttribute((const void*)mk_fwd, hipFuncAttributeMaxDynamicSharedMemorySize, LDS_BYTES) != hipSuccess) { fprintf(stderr, "kernel_launch: hipFuncSetAttribute failed\n"); grid = -1; return; }
        if (hipOccupancyMaxActiveBlocksPerMultiprocessor(&per_cu, (const void*)mk_fwd, NTHREADS, LDS_BYTES) != hipSuccess || per_cu < 1) { fprintf(stderr, "kernel_launch: occupancy query says %d\n", per_cu); }
        (void)hipGetLastError();
        grid = cus;
    }
    if (grid < 0) return;
    if (hipMemsetAsync((char*)d_ws + WS_CTL, 0, CTL_ZERO_BYTES, stream) != hipSuccess) return;
    Args a{};
    for (int i = 0; i < 25; ++i) a.in[i] = (const float*)d_in[i];
    a.out = (float*)d_out; a.ws = (unsigned char*)d_ws;
#if MK_MULTI
    for (int p = 0; p < NPHASE; ++p) { a.ph_lo = p; a.ph_hi = p + 1; hipLaunchKernelGGL(mk_fwd, dim3(grid), dim3(NTHREADS), LDS_BYTES, stream, a); }
#else
    a.ph_lo = 0; a.ph_hi = NPHASE;
    hipLaunchKernelGGL(mk_fwd, dim3(grid), dim3(NTHREADS), LDS_BYTES, stream, a);
#endif
    const hipError_t le = hipPeekAtLastError();
    if (le != hipSuccess) fprintf(stderr, "kernel_launch: launch failed: %s\n", hipGetErrorName(le));
}
```

```cpp
#include <hip/hip_runtime.h>
#include <cstdio>
#include <cstdint>

#ifndef ATT_F8
#define ATT_F8 1
#endif
#ifndef MK_MULTI
#define MK_MULTI 0
#endif

#define LAS __attribute__((address_space(3)))
#define GAS __attribute__((address_space(1)))
#define CAS __attribute__((address_space(4)))
typedef unsigned short bf16_t;
typedef short bf16x8 __attribute__((ext_vector_type(8)));
typedef short s16x4 __attribute__((ext_vector_type(4)));
typedef float f32x2 __attribute__((ext_vector_type(2)));
typedef float f32x4 __attribute__((ext_vector_type(4)));
typedef float f32x16 __attribute__((ext_vector_type(16)));
typedef unsigned u32x2 __attribute__((ext_vector_type(2)));
typedef unsigned u32x4 __attribute__((ext_vector_type(4)));
typedef int i32x4 __attribute__((ext_vector_type(4)));

constexpr int DM = 1024, SEQ = 16384, NCTX = 256, MROWS = SEQ + NCTX, DEPTH = 4;
constexpr int EVEN_IN = 2304, ODD_IN = 1536;
constexpr int NEXP = 16, DEXP = 512;
constexpr float ALPHA = 1.681792830507429f;
constexpr float LN_EPS = 1e-5f, QK_EPS = 1e-6f, SUBLN_EPS = 1e-5f;
constexpr int NWAVES = 8, NTHREADS = 512;
constexpr int MAXSLOT = 37376;
constexpr float LOG2E = 1.4426950408889634f;

constexpr size_t al256(size_t x) { return (x + 255) / 256 * 256; }
constexpr size_t WS_CTL = 0, CTL_ZERO_BYTES = 1u << 20;
constexpr int CW_BAR = 4096;
constexpr int CW_KMAX = 24576;
constexpr int CW_CNT = 16384;
constexpr size_t WS_MODV = CTL_ZERO_BYTES;
constexpr size_t WS_TAB64 = WS_MODV + al256((size_t)4 * 2 * 6144 * 4);
constexpr size_t WS_TAB128 = WS_TAB64 + al256((size_t)256 * 16 * 2 * 4);
constexpr size_t WS_LAM = WS_TAB128 + al256((size_t)256 * 32 * 2 * 4);
constexpr size_t WS_ROUTE = WS_LAM + 256;
constexpr size_t WS_IDX = WS_ROUTE + al256((size_t)MROWS * 16);
constexpr size_t WS_WINE = al256(WS_IDX + (size_t)NEXP * MROWS * 4);
constexpr size_t WS_WINO = WS_WINE + (size_t)2 * EVEN_IN * DM * 2;
constexpr size_t WS_WOUT = WS_WINO + (size_t)2 * ODD_IN * DM * 2;
constexpr size_t WS_WGU = WS_WOUT + (size_t)4 * DM * DM * 2;
constexpr size_t WS_WD = WS_WGU + (size_t)4 * NEXP * 1024 * DM * 2;
constexpr size_t WS_XB = WS_WD + (size_t)4 * NEXP * DM * DEXP * 2;
constexpr size_t WS_X1B = WS_XB + (size_t)MROWS * DM * 4;
constexpr size_t WS_HB = WS_X1B + (size_t)MROWS * DM * 4;
constexpr size_t WS_QKV = WS_HB + (size_t)MROWS * DM * 2;
constexpr size_t WS_OB = WS_QKV + (size_t)MROWS * EVEN_IN * 2;
constexpr size_t WS_YB = WS_OB + (size_t)MROWS * DM * 2;
constexpr int NTILE = MROWS / 64;
constexpr size_t WS_KF8 = WS_YB + (size_t)MROWS * DM * 4;
constexpr size_t WS_VF8 = WS_KF8 + (size_t)8 * NTILE * 4096;
constexpr size_t WS_END = WS_VF8 + (size_t)4 * NTILE * 8192;
static_assert((size_t)MAXSLOT * DM * 2 <= (size_t)MROWS * EVEN_IN * 2, "moe out fits qkv region");
static_assert((size_t)MAXSLOT * DEXP * 2 <= (size_t)MROWS * DM * 4, "A2 fits y region");

constexpr int RING_BYTES = 131072;
constexpr int LDSCTL_OFF = RING_BYTES;
constexpr int LC_BAR = 0;
constexpr int LC_TSTART = 16;
constexpr int LC_ECNT = 40;
constexpr int LC_LCNT = 56;
constexpr int LC_GBASE = 72;
constexpr int LC_WTAB = 96;
constexpr int LC_KMAX = 1120;
constexpr int LDS_BYTES = 147456;
static_assert(LDSCTL_OFF + (LC_KMAX + 16) * 4 <= 139264 && 139264 + 8192 <= LDS_BYTES, "LDS map");

__device__ __forceinline__ unsigned cvt_pk_bf16(float lo, float hi) { unsigned r; asm volatile("v_cvt_pk_bf16_f32 %0, %1, %2" : "=v"(r) : "v"(lo), "v"(hi)); return r; }
__device__ __forceinline__ float bf_lo(unsigned w) { return __uint_as_float(w << 16); }
__device__ __forceinline__ float bf_hi(unsigned w) { return __uint_as_float(w & 0xffff0000u); }
__device__ __forceinline__ float wave_sum(float v) {
#pragma unroll
    for (int o = 1; o < 64; o <<= 1) v += __shfl_xor(v, o);
    return v;
}
#define LDS_WAIT() asm volatile("s_waitcnt lgkmcnt(0)" ::: "memory")
#define VM_WAIT() asm volatile("s_waitcnt vmcnt(0)" ::: "memory")
#define RLX_AGENT __ATOMIC_RELAXED, __HIP_MEMORY_SCOPE_AGENT

#define XB_TMO      128
#define XB_XCNT(j)  (256  + 64 * (j))
#define XB_XSUB(j)  (1280 + 64 * (j))
#define XB_XGEN(j)  (2304 + 64 * (j))
#define XB_TOP      3328
#define XB_TOPGEN   3392
#define XCD_BAR_WORDS 3456
#define XB_SPIN_CAP (1u << 18)
__device__ __forceinline__ unsigned xb_ld(unsigned* p)              { return __hip_atomic_load(p, __ATOMIC_RELAXED, __HIP_MEMORY_SCOPE_AGENT); }
__device__ __forceinline__ unsigned xb_add(unsigned* p, unsigned v) { return __hip_atomic_fetch_add(p, v, __ATOMIC_RELAXED, __HIP_MEMORY_SCOPE_AGENT); }
__device__ __forceinline__ unsigned xb_xcc_id() { return (unsigned)__builtin_amdgcn_s_getreg((3 << 11) | 20) & 0xFu; }
#define XB_SPIN(cond, bar) do { unsigned _sp = 0; while (cond) { __builtin_amdgcn_s_sleep(1); \
    if ((++_sp & 255u) == 0u) { if (xb_ld(&(bar)[XB_TMO])) break; if (_sp > XB_SPIN_CAP) { atomicAdd(&(bar)[XB_TMO], 1u); break; } } } } while (0)
struct XcdBarrier { unsigned* bar; unsigned x; volatile LAS unsigned* st; };
__device__ __forceinline__ XcdBarrier xcd_barrier_post(unsigned* bar, volatile LAS unsigned* st, bool is_t0) {
    XcdBarrier b; b.bar = bar; b.x = xb_xcc_id(); b.st = st;
    if (is_t0) (void)xb_add(&bar[XB_XCNT(b.x)], 1u);
    return b;
}
__device__ __forceinline__ void xcd_barrier_complete(unsigned* bar, unsigned x, unsigned& nloc, unsigned& nx) {
    const unsigned G = gridDim.x * gridDim.y * gridDim.z;
    unsigned sum, cnt, mine, sp = 0u;
    for (;;) {
        sum = 0u; cnt = 0u; mine = 0u;
#pragma unroll
        for (unsigned j = 0; j < 16; ++j) { const unsigned c = xb_ld(&bar[XB_XCNT(j)]); sum += c; cnt += (c > 0u) ? 1u : 0u; mine = (j == x) ? c : mine; }
        if (sum == G) break;
        __builtin_amdgcn_s_sleep(1);
        if ((++sp & 255u) == 0u) { if (xb_ld(&bar[XB_TMO])) break; if (sp > XB_SPIN_CAP) { atomicAdd(&bar[XB_TMO], 1u); break; } }
    }
    nloc = mine > 0u ? mine : 1u; nx = cnt > 0u ? cnt : 1u;
}
__device__ __forceinline__ void xcd_barrier(const XcdBarrier& b, bool is_t0) {
    asm volatile("s_waitcnt vmcnt(0)" ::: "memory");
    __syncthreads();
    if (is_t0) {
        unsigned* bar = b.bar;
        __builtin_amdgcn_s_waitcnt(0);
        unsigned nloc = b.st[0], nx = b.st[1];
        if (nloc == 0u) { xcd_barrier_complete(bar, b.x, nloc, nx); b.st[0] = nloc; b.st[1] = nx; }
        const unsigned old = xb_add(&bar[XB_XSUB(b.x)], 1u);
        const unsigned gen = old / nloc;
        if (old + 1u == (gen + 1u) * nloc) {
            __builtin_amdgcn_fence(__ATOMIC_RELEASE, "agent");
            asm volatile("s_waitcnt vmcnt(0)" ::: "memory");
            const unsigned og = xb_add(&bar[XB_TOP], 1u);
            const unsigned tg = og / nx;
            if (og + 1u == (tg + 1u) * nx) xb_add(&bar[XB_TOPGEN], 1u);
            else XB_SPIN(xb_ld(&bar[XB_TOPGEN]) == tg, bar);
            __builtin_amdgcn_fence(__ATOMIC_ACQUIRE, "agent");
            xb_add(&bar[XB_XGEN(b.x)], 1u);
            asm volatile("s_waitcnt vmcnt(0)" ::: "memory");
        } else {
            XB_SPIN(xb_ld(&bar[XB_XGEN(b.x)]) == gen, bar);
            __builtin_amdgcn_fence(__ATOMIC_ACQUIRE, "agent");
            asm volatile("s_waitcnt vmcnt(0)" ::: "memory");
        }
    }
    __syncthreads();
}

namespace pg8 {
constexpr int BM = 256, BK = 64, HALF = 128, HTB = HALF * BK * 2, NXCD = 8, WGM = 8;
constexpr int NV_OFF = 139264;
__host__ __device__ __forceinline__ int lds_byte(int r, int c) { const int st = (r >> 4) * 2 + (c >> 5), rr = r & 15, cc = c & 31, ob = rr * 64 + cc * 2; return st * 1024 + (ob ^ (((ob >> 9) & 1) << 5)); }
__host__ __device__ __forceinline__ void stage_rc(int b, int& R, int& C) { const int st = b / 1024, sb = b % 1024, swz = sb ^ (((sb >> 9) & 1) << 5); R = (st >> 1) * 16 + swz / 64; C = (st & 1) * 32 + (swz % 64) / 2; }
__host__ __device__ __forceinline__ int perm32(int rho) { const int n = rho >> 4, i = rho & 15; return 8 * (i >> 2) + 4 * n + (i & 3); }

struct Unit { int pm, pn, e, lrow; };

struct DenseSched {
    static constexpr bool GATHER = false;
    const bf16_t* A; const bf16_t* Bt; int K, nM, nN, nwg, G, c, pm_lo;
    __device__ void init(const bf16_t* A_, const bf16_t* Bt_, int K_, int pm_lo_, int nM_, int N, int G_, int c_) { A = A_; Bt = Bt_; K = K_; pm_lo = pm_lo_; nM = nM_; nN = N / BM; nwg = nM * nN; G = G_; c = c_; }
    __device__ __forceinline__ bool next(int i, Unit& u) const {
        const long L = (long)i * G + c; if (L >= nwg) return false;
        int wgid = (int)L; { const int q = nwg / NXCD, r = nwg % NXCD, xcd = wgid % NXCD, off = wgid / NXCD; wgid = (xcd < r ? xcd * (q + 1) : r * (q + 1) + (xcd - r) * q) + off; }
        const int nig = WGM * nN, gid = wgid / nig, fm = gid * WGM, gsz = (nM - fm) < WGM ? (nM - fm) : WGM;
        u.pm = pm_lo + fm + ((wgid % nig) % gsz); u.pn = (wgid % nig) / gsz; u.e = 0; u.lrow = 0; return true;
    }
    __device__ __forceinline__ const char* a_base(const Unit& u) const { return (const char*)A + (size_t)u.pm * BM * K * 2; }
    __device__ __forceinline__ const char* b_base(const Unit& u) const { return (const char*)Bt + (size_t)u.pn * BM * K * 2; }
    __device__ __forceinline__ void voffs(const Unit&, const int (&R)[2], const int (&C)[2], unsigned (&v0)[2], unsigned (&v1)[2]) const {
#pragma unroll
        for (int i = 0; i < 2; ++i) { v0[i] = (unsigned)(R[i] * K + C[i]) * 2u; v1[i] = v0[i] + (unsigned)(HALF * K) * 2u; }
    }
};
template <bool GATHER_> struct MoeSched {
    static constexpr bool GATHER = GATHER_;
    const bf16_t* Ab; const bf16_t* Wb; const int* idx; const LAS int* tstart; const LAS int* ecnt; int K, base, stride, hi;
    __device__ __forceinline__ bool next(int i, Unit& u) const {
        const int L = base + i * stride; if (L >= hi) return false;
        const int tile = L >> 2; u.pn = L & 3; u.pm = tile;
        int e = 0;
#pragma unroll
        for (int k = 1; k < 16; ++k) e += (tile >= tstart[k]) ? 1 : 0;
        e = __builtin_amdgcn_readfirstlane(e);
        u.e = e; u.lrow = __builtin_amdgcn_readfirstlane((tile - tstart[e]) * 256); return true;
    }
    __device__ __forceinline__ const char* a_base(const Unit& u) const { return GATHER ? (const char*)Ab : (const char*)Ab + (size_t)u.pm * BM * K * 2; }
    __device__ __forceinline__ const char* b_base(const Unit& u) const { return (const char*)Wb + ((size_t)u.e * 1024 + (size_t)u.pn * BM) * K * 2; }
    __device__ __forceinline__ void voffs(const Unit& u, const int (&R)[2], const int (&C)[2], unsigned (&v0)[2], unsigned (&v1)[2]) const {
        if constexpr (GATHER) {
            const int n = ecnt[u.e];
#pragma unroll
            for (int i = 0; i < 2; ++i) {
                const int p0 = u.lrow + R[i], p1 = p0 + HALF;
                const int t0 = p0 < n ? idx[u.e * MROWS + p0] : 0, t1 = p1 < n ? idx[u.e * MROWS + p1] : 0;
                v0[i] = (unsigned)(t0 * K + C[i]) * 2u; v1[i] = (unsigned)(t1 * K + C[i]) * 2u; }
        } else {
#pragma unroll
            for (int i = 0; i < 2; ++i) { v0[i] = (unsigned)(R[i] * K + C[i]) * 2u; v1[i] = v0[i] + (unsigned)(HALF * K) * 2u; }
        }
    }
};

struct EpiF32 {
    static constexpr bool PERM = false;
    float* C; int ldc;
    __device__ __forceinline__ void operator()(const f32x4 (&acc)[2][2][4][2], const Unit& u, int wr, int wc, int fr, int fq) const {
        const int row0 = u.pm * BM + wr * 64 + fr, col0 = u.pn * BM + wc * 32 + 4 * fq;
#pragma unroll
        for (int ai = 0; ai < 2; ++ai)
#pragma unroll
            for (int m = 0; m < 4; ++m) { float* rowp = C + (size_t)(row0 + ai * HALF + m * 16) * ldc + col0;
#pragma unroll
                for (int bj = 0; bj < 2; ++bj)
#pragma unroll
                    for (int n = 0; n < 2; ++n) *(f32x4*)(rowp + bj * HALF + n * 16) = acc[ai][bj][m][n]; }
    }
};
struct EpiBf16 {
    static constexpr bool PERM = true;
    bf16_t* O; int ldc;
    __device__ __forceinline__ void operator()(const f32x4 (&acc)[2][2][4][2], const Unit& u, int wr, int wc, int fr, int fq) const {
        const int row0 = u.pm * BM + wr * 64 + fr, col0 = u.pn * BM + wc * 32 + 8 * fq;
#pragma unroll
        for (int ai = 0; ai < 2; ++ai)
#pragma unroll
            for (int m = 0; m < 4; ++m) { bf16_t* rowp = O + (size_t)(row0 + ai * HALF + m * 16) * ldc + col0;
#pragma unroll
                for (int bj = 0; bj < 2; ++bj) { const f32x4 v0 = acc[ai][bj][m][0], v1 = acc[ai][bj][m][1];
                    u32x4 w; w.x = cvt_pk_bf16(v0[0], v0[1]); w.y = cvt_pk_bf16(v0[2], v0[3]); w.z = cvt_pk_bf16(v1[0], v1[1]); w.w = cvt_pk_bf16(v1[2], v1[3]);
                    *(u32x4*)(rowp + bj * HALF) = w; } }
    }
};
struct EpiGateUp {
    static constexpr bool PERM = true;
    bf16_t* O;
    __device__ __forceinline__ void operator()(const f32x4 (&acc)[2][2][4][2], const Unit& u, int wr, int wc, int fr, int fq) const {
        const int row0 = u.pm * BM + wr * 64 + fr, col0 = u.pn * BM + wc * 32 + 8 * fq;
#pragma unroll
        for (int ai = 0; ai < 2; ++ai)
#pragma unroll
            for (int m = 0; m < 4; ++m) { bf16_t* rowp = O + (size_t)(row0 + ai * HALF + m * 16) * DEXP;
#pragma unroll
                for (int bj = 0; bj < 2; ++bj) { const f32x4 g = acc[ai][bj][m][0], uu = acc[ai][bj][m][1]; float a[4];
#pragma unroll
                    for (int k = 0; k < 4; ++k) { const float s = __builtin_amdgcn_rcpf(1.f + __builtin_amdgcn_exp2f(-g[k] * LOG2E)); a[k] = g[k] * s * uu[k]; }
                    u32x2 w; w.x = cvt_pk_bf16(a[0], a[1]); w.y = cvt_pk_bf16(a[2], a[3]);
                    *(u32x2*)(rowp + ((col0 + bj * HALF) >> 1)) = w; } }
    }
};

template <class Epi, class Sched>
__device__ __forceinline__ void gemm_phase(const int tid, LAS unsigned char* lds, const int K, const Sched& S, const Epi& E) {
    const int wid = __builtin_amdgcn_readfirstlane(tid >> 6), lane = tid & 63, wr = wid >> 2, wc = wid & 3, fr = lane & 15, fq = lane >> 4;
    const int nt = K / BK;
    int Ra[2], Ca[2]; unsigned voffB[2];
#pragma unroll
    for (int i = 0; i < 2; ++i) { int R, C; stage_rc(tid * 16 + i * 8192, R, C); Ra[i] = R; Ca[i] = C; const int Rb = Epi::PERM ? ((R & ~31) + perm32(R & 31)) : R;
        voffB[i] = (unsigned)(Rb * K + C) * 2u; }
    const size_t kstep = (size_t)(BK * 2);
    const size_t hstep = (size_t)HALF * K * 2;
    const unsigned ldsw = (unsigned)wid * 1024u;
    const int aoff = lds_byte(wr * 64 + fr, fq * 8), boff = lds_byte(wc * 32 + fr, fq * 8);
#define PG8_SA(b, h) (((b) * 2 + (h)) * HTB)
#define PG8_SB(b, h) ((4 + (b) * 2 + (h)) * HTB)
#define PG8_STAGE(bufoff, gbase, voff) do { _Pragma("unroll") for (int _i = 0; _i < 2; ++_i) \
        __builtin_amdgcn_global_load_lds((const unsigned*)((const char*)(gbase) + (voff)[_i]), (LAS unsigned*)(lds + (bufoff) + ldsw + _i * 8192), 16, 0, 0); } while (0)
#define PG8_LDA(dst, b, h) do { _Pragma("unroll") for (int m = 0; m < 4; ++m) _Pragma("unroll") for (int k = 0; k < 2; ++k) dst[m][k] = *(const LAS bf16x8*)(lds + PG8_SA(b, h) + aoff + m * 2048 + k * 1024); } while (0)
#define PG8_LDB(dst, b, h) do { _Pragma("unroll") for (int n = 0; n < 2; ++n) _Pragma("unroll") for (int k = 0; k < 2; ++k) dst[n][k] = *(const LAS bf16x8*)(lds + PG8_SB(b, h) + boff + n * 2048 + k * 1024); } while (0)
#define PG8_MMA(ai, bj, At, Bt) do { __builtin_amdgcn_s_setprio(1); _Pragma("unroll") for (int m = 0; m < 4; ++m) _Pragma("unroll") for (int n = 0; n < 2; ++n) _Pragma("unroll") for (int k = 0; k < 2; ++k) \
        acc[ai][bj][m][n] = __builtin_amdgcn_mfma_f32_16x16x32_bf16(Bt[n][k], At[m][k], acc[ai][bj][m][n], 0, 0, 0); __builtin_amdgcn_s_setprio(0); } while (0)
#define PG8_WAIT_V(n) asm volatile("s_waitcnt vmcnt(" #n ")" ::: "memory")
#define PG8_WAIT_L(n) asm volatile("s_waitcnt lgkmcnt(" #n ")" ::: "memory")
#define PG8_BAR __builtin_amdgcn_s_barrier()
#define PG8_SCHED __builtin_amdgcn_sched_barrier(0)
    Unit cur, nxt; int ui = 0;
    if (!S.next(0, cur)) return;
    f32x4 acc[2][2][4][2];
#pragma unroll
    for (int a = 0; a < 2; ++a)
#pragma unroll
        for (int b = 0; b < 2; ++b)
#pragma unroll
            for (int m = 0; m < 4; ++m)
#pragma unroll
                for (int n = 0; n < 2; ++n) acc[a][b][m][n] = (f32x4){0.f, 0.f, 0.f, 0.f};
    bf16x8 At[4][2], B0[2][2], B1[2][2];
    const char* cA = S.a_base(cur); const char* cB = S.b_base(cur);
    unsigned cv0[2], cv1[2], sv0[2], sv1[2];
    S.voffs(cur, Ra, Ca, cv0, cv1);
#define PG8_STAGE_A(bufoff, gbase, half, sel) do { if constexpr (Sched::GATHER) { if (half) { if (sel) PG8_STAGE(bufoff, gbase, sv1); else PG8_STAGE(bufoff, gbase, cv1); } else { if (sel) PG8_STAGE(bufoff, gbase, sv0); else PG8_STAGE(bufoff, gbase, cv0); } } \
        else PG8_STAGE(bufoff, (gbase) + (half) * hstep, cv0); } while (0)
    PG8_STAGE(PG8_SB(0, 0), cB, voffB); PG8_STAGE(PG8_SB(0, 1), cB + hstep, voffB); PG8_STAGE_A(PG8_SA(0, 0), cA, 0, 0); PG8_STAGE_A(PG8_SA(0, 1), cA, 1, 0);
    if (wr == 1) PG8_BAR;
    PG8_WAIT_V(2); PG8_BAR;
    PG8_STAGE(PG8_SB(1, 0), cB + kstep, voffB); PG8_STAGE_A(PG8_SA(1, 0), cA + kstep, 0, 0); PG8_STAGE(PG8_SB(1, 1), cB + hstep + kstep, voffB);
    PG8_WAIT_V(6); PG8_BAR;
    for (;;) {
        const bool has_next = S.next(ui + 1, nxt);
        const char* nA = cA; const char* nB = cB;
        if (has_next) { nA = S.a_base(nxt); nB = S.b_base(nxt); }
        if constexpr (Sched::GATHER) {
            u32x4 q = {cv0[0], cv0[1], cv1[0], cv1[1]};
            if (has_next) { unsigned t0[2], t1[2]; S.voffs(nxt, Ra, Ca, t0, t1); q = (u32x4){t0[0], t0[1], t1[0], t1[1]}; }
            *(LAS u32x4*)(lds + NV_OFF + tid * 16) = q;
        }
        for (int t = 0; t < nt; t += 2) {
            const bool last = (t == nt - 2);
            const char* a1 = cA + (size_t)(t + 1) * kstep;
            const char* a2 = last ? nA : cA + (size_t)(t + 2) * kstep; const char* b2 = last ? nB : cB + (size_t)(t + 2) * kstep;
            const char* a3 = a2 + kstep; const char* b3 = b2 + kstep;
            if constexpr (Sched::GATHER) {
                sv0[0] = cv0[0]; sv0[1] = cv0[1]; sv1[0] = cv1[0]; sv1[1] = cv1[1];
                if (last) { const u32x4 q = *(const LAS u32x4*)(lds + NV_OFF + tid * 16); sv0[0] = q.x; sv0[1] = q.y; sv1[0] = q.z; sv1[1] = q.w; }
            }
            PG8_LDB(B0, 0, 0); PG8_LDB(B1, 0, 1); PG8_SCHED; PG8_LDA(At, 0, 0); PG8_STAGE_A(PG8_SA(1, 1), a1, 1, 0);
            PG8_WAIT_V(8); PG8_WAIT_L(0); PG8_BAR; PG8_MMA(0, 0, At, B0); PG8_MMA(0, 1, At, B1); PG8_BAR; PG8_SCHED;
            PG8_LDA(At, 0, 1); PG8_STAGE(PG8_SB(0, 0), b2, voffB); PG8_STAGE(PG8_SB(0, 1), b2 + hstep, voffB); PG8_STAGE_A(PG8_SA(0, 0), a2, 0, 1);
            PG8_WAIT_V(8); PG8_WAIT_L(0); PG8_BAR; PG8_MMA(1, 0, At, B0); PG8_MMA(1, 1, At, B1); PG8_BAR; PG8_SCHED;
            PG8_LDB(B0, 1, 0); PG8_LDB(B1, 1, 1); PG8_SCHED; PG8_LDA(At, 1, 0); PG8_STAGE_A(PG8_SA(0, 1), a2, 1, 1);
            PG8_WAIT_V(8); PG8_WAIT_L(0); PG8_BAR; PG8_MMA(0, 0, At, B0); PG8_MMA(0, 1, At, B1); PG8_BAR; PG8_SCHED;
            PG8_LDA(At, 1, 1); PG8_STAGE(PG8_SB(1, 0), b3, voffB); PG8_STAGE(PG8_SB(1, 1), b3 + hstep, voffB); PG8_STAGE_A(PG8_SA(1, 0), a3, 0, 1);
            PG8_WAIT_V(8); PG8_WAIT_L(0); PG8_BAR; PG8_MMA(1, 0, At, B0); PG8_MMA(1, 1, At, B1); PG8_BAR; PG8_SCHED;
        }
        if (wr == 0) PG8_BAR;
        E(acc, cur, wr, wc, fr, fq);
        if (!has_next) break;
#pragma unroll
        for (int a = 0; a < 2; ++a)
#pragma unroll
            for (int b = 0; b < 2; ++b)
#pragma unroll
                for (int m = 0; m < 4; ++m)
#pragma unroll
                    for (int n = 0; n < 2; ++n) acc[a][b][m][n] = (f32x4){0.f, 0.f, 0.f, 0.f};
        cur = nxt; cA = nA; cB = nB; ++ui;
        if constexpr (Sched::GATHER) { cv0[0] = sv0[0]; cv0[1] = sv0[1]; cv1[0] = sv1[0]; cv1[1] = sv1[1]; }
        if (wr == 1) PG8_BAR;
    }
    PG8_WAIT_V(0);
    PG8_BAR;
#undef PG8_SA
#undef PG8_SB
#undef PG8_STAGE
#undef PG8_STAGE_A
#undef PG8_LDA
#undef PG8_LDB
#undef PG8_MMA
#undef PG8_WAIT_V
#undef PG8_WAIT_L
#undef PG8_BAR
#undef PG8_SCHED
}
}

namespace att {
constexpr int NW = 8, QBLK = 32, KVBLK = 64;
constexpr int SHM_V = 16384, SHM_K = 16384;
constexpr int SHM_ATTN = 2 * SHM_V + 2 * SHM_K + NW * 64 * 4;
constexpr float THR = 8.f;
#define SBAR() __builtin_amdgcn_sched_barrier(0)
__device__ __forceinline__ int crow(int r, int hi) { return (r & 3) + 8 * (r >> 2) + 4 * hi; }
__device__ __forceinline__ unsigned cvtpk(float lo, float hi) { unsigned r; asm volatile("v_cvt_pk_bf16_f32 %0, %1, %2" : "=v"(r) : "v"(lo), "v"(hi)); return r; }
template <int DQK> __device__ __forceinline__ int kswz(int row, int colB) {
    if constexpr (DQK == 128) return row * 256 + (colB ^ ((row & 7) << 4));
    else return row * 128 + (colB ^ (((row >> 1) & 7) << 4));
}
template <int DQK> __device__ __forceinline__ void partialSM(f32x16& p0, f32x16& p1, float& m_reg, float& mn, float& alpha) {
    constexpr float SCALE = (DQK == 128) ? 0.088388347648318440f : 0.125f;
    constexpr float C = SCALE * LOG2E;
    float pmax = p0[0];
#pragma unroll
    for (int r = 1; r < 16; ++r) pmax = fmaxf(pmax, p0[r]);
#pragma unroll
    for (int r = 0; r < 16; ++r) pmax = fmaxf(pmax, p1[r]);
    { auto rr = __builtin_amdgcn_permlane32_swap(__float_as_uint(pmax), __float_as_uint(pmax), false, false);
      pmax = fmaxf(__uint_as_float(rr[0]), __uint_as_float(rr[1])); }
    if (__builtin_expect(__all(pmax - m_reg <= THR / SCALE), 1)) { mn = m_reg; alpha = 1.f; }
    else { mn = fmaxf(m_reg, pmax); alpha = __builtin_amdgcn_exp2f((m_reg - mn) * C); m_reg = mn; }
    const float mnC = -mn * C;
#pragma unroll
    for (int r = 0; r < 16; ++r) p0[r] = fmaf(p0[r], C, mnC);
#pragma unroll
    for (int r = 0; r < 16; ++r) p1[r] = fmaf(p1[r], C, mnC);
#pragma unroll
    for (int r = 0; r < 16; ++r) p0[r] = __builtin_amdgcn_exp2f(p0[r]);
}
__device__ __forceinline__ void finishSM(f32x16& p0, f32x16& p1, float alpha, float& l_reg, bf16x8& pa0, bf16x8& pa1, bf16x8& pa2, bf16x8& pa3) {
#pragma unroll
    for (int r = 0; r < 16; ++r) p1[r] = __builtin_amdgcn_exp2f(p1[r]);
    float ps = 0;
#pragma unroll
    for (int r = 0; r < 16; ++r) ps += p0[r];
#pragma unroll
    for (int r = 0; r < 16; ++r) ps += p1[r];
    { auto rr = __builtin_amdgcn_permlane32_swap(__float_as_uint(ps), __float_as_uint(ps), false, false);
      ps = __uint_as_float(rr[0]) + __uint_as_float(rr[1]); }
    l_reg = l_reg * alpha + ps;
#define PK4(P, BASE, OUT) do { unsigned a0 = cvtpk(P[BASE + 0], P[BASE + 1]), a1 = cvtpk(P[BASE + 2], P[BASE + 3]);   \
    unsigned b0 = cvtpk(P[BASE + 4], P[BASE + 5]), b1 = cvtpk(P[BASE + 6], P[BASE + 7]);                              \
    auto r0 = __builtin_amdgcn_permlane32_swap(a0, b0, false, false); auto r1 = __builtin_amdgcn_permlane32_swap(a1, b1, false, false); \
    u32x4 w = {r0[0], r1[0], r0[1], r1[1]}; OUT = *reinterpret_cast<bf16x8*>(&w); } while (0)
    PK4(p0, 0, pa0); PK4(p0, 8, pa1); PK4(p1, 0, pa2); PK4(p1, 8, pa3);
#undef PK4
}
template <int DQK> __device__ __forceinline__ void qkt(f32x16& p0, f32x16& p1, const char* Ks, const bf16x8* qr, int r32, int hi) {
    p0 = f32x16{}; p1 = f32x16{};
#pragma unroll
    for (int d0 = 0; d0 < DQK / 16; ++d0) { const int cb = (d0 * 16 + hi * 8) * 2;
        bf16x8 b0 = *reinterpret_cast<const bf16x8*>(Ks + kswz<DQK>(r32, cb));
        bf16x8 b1 = *reinterpret_cast<const bf16x8*>(Ks + kswz<DQK>(32 + r32, cb));
        p0 = __builtin_amdgcn_mfma_f32_32x32x16_bf16(b0, qr[d0], p0, 0, 0, 0);
        p1 = __builtin_amdgcn_mfma_f32_32x32x16_bf16(b1, qr[d0], p1, 0, 0, 0); }
}
__device__ __forceinline__ void wmask(f32x16& p0, f32x16& p1, int k0, int q0lat, int qrel, int hi) {
    const int dbase = k0 - 384 - qrel, pbase = q0lat + k0 - 384;
#pragma unroll
    for (int r = 0; r < 16; ++r) {
        const int kk = crow(r, hi);
        { const int d = dbase + kk, kp = pbase + kk; const bool ok = (d >= -128) && (d <= 128) && (kp >= 0) && (kp < SEQ); p0[r] = ok ? p0[r] : -1e30f; }
        { const int d = dbase + kk + 32, kp = pbase + kk + 32; const bool ok = (d >= -128) && (d <= 128) && (kp >= 0) && (kp < SEQ); p1[r] = ok ? p1[r] : -1e30f; }
    }
}
template <int NCB> __device__ __forceinline__ int v_st(int k, int c) { const int kk = (k & ~0xC) | ((k & 4) << 1) | ((k & 8) >> 1); return ((kk >> 3) * NCB + (c >> 5)) * 512 + ((kk & 7) * 32 + (c & 31)) * 2; }
__device__ __forceinline__ int v_rd_base(int lane) { return ((lane & 3) << 3) | (((lane >> 2) & 3) << 6) | (((lane >> 4) & 1) << 5) | (((lane >> 5) & 1) << 8); }
template <int NCB> constexpr int v_rd_off(int d0, int ks, int half) { return d0 * 512 + ks * (1024 * NCB) + half * (512 * NCB); }
template <int OFF> __device__ __forceinline__ s16x4 tr_read(int vb) {
    s16x4 r; asm volatile("ds_read_b64_tr_b16 %0, %1 offset:%2" : "=&v"(r) : "v"(vb), "i"(OFF) : "memory"); return r;
}
template <int NCB, int D0> __device__ __forceinline__ void pv_one(f32x16& od, int vb, bf16x8 pa0, bf16x8 pa1, bf16x8 pa2, bf16x8 pa3) {
    const s16x4 l0 = tr_read<v_rd_off<NCB>(D0, 0, 0)>(vb), h0 = tr_read<v_rd_off<NCB>(D0, 0, 1)>(vb), l1 = tr_read<v_rd_off<NCB>(D0, 1, 0)>(vb), h1 = tr_read<v_rd_off<NCB>(D0, 1, 1)>(vb);
    const s16x4 l2 = tr_read<v_rd_off<NCB>(D0, 2, 0)>(vb), h2 = tr_read<v_rd_off<NCB>(D0, 2, 1)>(vb), l3 = tr_read<v_rd_off<NCB>(D0, 3, 0)>(vb), h3 = tr_read<v_rd_off<NCB>(D0, 3, 1)>(vb);
    asm volatile("s_waitcnt lgkmcnt(0)" ::: "memory"); SBAR();
#define PK(L, H) (bf16x8){L[0], L[1], L[2], L[3], H[0], H[1], H[2], H[3]}
    od = __builtin_amdgcn_mfma_f32_32x32x16_bf16(pa0, PK(l0, h0), od, 0, 0, 0);
    od = __builtin_amdgcn_mfma_f32_32x32x16_bf16(pa1, PK(l1, h1), od, 0, 0, 0);
    od = __builtin_amdgcn_mfma_f32_32x32x16_bf16(pa2, PK(l2, h2), od, 0, 0, 0);
    od = __builtin_amdgcn_mfma_f32_32x32x16_bf16(pa3, PK(l3, h3), od, 0, 0, 0);
#undef PK
}
template <int NCB> __device__ __forceinline__ void pv_d0(f32x16* o, int vb, bf16x8 pa0, bf16x8 pa1, bf16x8 pa2, bf16x8 pa3) {
    pv_one<NCB, 0>(o[0], vb, pa0, pa1, pa2, pa3); pv_one<NCB, 1>(o[1], vb, pa0, pa1, pa2, pa3);
    if constexpr (NCB == 4) { pv_one<NCB, 2>(o[2], vb, pa0, pa1, pa2, pa3); pv_one<NCB, 3>(o[3], vb, pa0, pa1, pa2, pa3); }
}


template <int DQK>
__device__ __forceinline__ float prep_q_x(float (&x)[DQK / 16][8], const bf16_t* Qw, const float* g, const float* T, int tpos, int hi) {
    constexpr int NQF = DQK / 16, QUART = DQK / 4, NB2 = NQF / 4;
    float ss = 0.f;
#pragma unroll
    for (int b = 0; b < NQF; ++b) { const bf16x8 v = *reinterpret_cast<const bf16x8*>(Qw + b * 16);
#pragma unroll
        for (int j = 0; j < 8; ++j) { x[b][j] = __uint_as_float(((unsigned)(unsigned short)v[j]) << 16); ss = fmaf(x[b][j], x[b][j], ss); } }
    if (g) {
        { auto rr = __builtin_amdgcn_permlane32_swap(__float_as_uint(ss), __float_as_uint(ss), false, false); ss = __uint_as_float(rr[0]) + __uint_as_float(rr[1]); }
        const float rs = 1.f / sqrtf(ss * (1.f / DQK) + QK_EPS); ss = 0.f;
#pragma unroll
        for (int b = 0; b < NQF; ++b) { const f32x4 g0 = *(const f32x4*)(g + b * 16 + hi * 8), g1 = *(const f32x4*)(g + b * 16 + hi * 8 + 4);
#pragma unroll
            for (int j = 0; j < 8; ++j) { x[b][j] *= rs * (j < 4 ? g0[j & 3] : g1[j & 3]); ss = fmaf(x[b][j], x[b][j], ss); } }
    }
    if (tpos >= 0) {
#pragma unroll
        for (int ty = 0; ty < 2; ++ty) { const int pos = ty ? (tpos & 63) : (tpos >> 6);
#pragma unroll
            for (int bb = 0; bb < NB2; ++bb) { const int b1 = ty * 2 * NB2 + bb, b2 = b1 + NB2; const float* tp = T + (pos * QUART + bb * 16 + hi * 8) * 2;
#pragma unroll
                for (int jj = 0; jj < 4; ++jj) { const f32x4 cs = *(const f32x4*)(tp + 4 * jj);
                    { const float x1 = x[b1][2 * jj], x2 = x[b2][2 * jj]; x[b1][2 * jj] = x1 * cs.x - x2 * cs.y; x[b2][2 * jj] = x1 * cs.y + x2 * cs.x; }
                    { const float x1 = x[b1][2 * jj + 1], x2 = x[b2][2 * jj + 1]; x[b1][2 * jj + 1] = x1 * cs.z - x2 * cs.w; x[b2][2 * jj + 1] = x1 * cs.w + x2 * cs.z; } } } }
    }
    { auto rr = __builtin_amdgcn_permlane32_swap(__float_as_uint(ss), __float_as_uint(ss), false, false); ss = __uint_as_float(rr[0]) + __uint_as_float(rr[1]); }
    return ss;
}
template <int DQK>
__device__ __forceinline__ float prep_q(bf16x8 (&qr)[DQK / 16], const bf16_t* Qw, const float* g, const float* T, int tpos, int hi, float pre) {
    constexpr int NQF = DQK / 16;
    float x[NQF][8];
    const float ss = prep_q_x<DQK>(x, Qw, g, T, tpos, hi);
#pragma unroll
    for (int b = 0; b < NQF; ++b) { u32x4 w;
#pragma unroll
        for (int j = 0; j < 4; ++j) w[j] = cvtpk(x[b][2 * j] * pre, x[b][2 * j + 1] * pre);
        qr[b] = *reinterpret_cast<bf16x8*>(&w); }
    return ss;
}
template <int DQK, int DV, bool WINDOW, int SDEPTH>
__device__ __forceinline__ void attn_core(const int tid, const bf16_t* Qb, int ldq, const bf16_t* Kb, const bf16_t* Vb, int ldk, int seq, int q0lat, float m_init, float l_init, char* lds, f32x16 (&o)[DV / 32], const float* ropeT, int tpos0) {
    constexpr int NCB = DV / 32, NQF = DQK / 16, NKL = DQK / 64, NVL = DV / 64;
    constexpr float SCALE = (DQK == 128) ? 0.088388347648318440f : 0.125f;
    constexpr float C = SCALE * LOG2E;
    const int wid = tid >> 6, lane = tid & 63, r32 = lane & 31, hi = lane >> 5;
    char* V_lds = lds; char* K_lds = lds + 2 * SHM_V;
    float* ws = (float*)(lds + 2 * SHM_V + 2 * SHM_K) + wid * 64; float* li_l = ws; float* al_l = ws + 32;
    float m_reg = m_init, l_reg = l_init; bf16x8 qr[NQF];
#pragma unroll
    for (int d = 0; d < NCB; ++d) o[d] = f32x16{};
    const bf16_t* Qw = Qb + (long)(wid * QBLK + r32) * ldq + hi * 8;
    (void)prep_q<DQK>(qr, Qw, nullptr, ropeT, tpos0 >= 0 ? tpos0 + wid * QBLK + r32 : -1, hi, 1.f);
    int krow[NKL], vrow[NVL], kst[NKL], vst[NVL]; int kcol, vcol;
    if constexpr (DQK == 128) { kcol = (tid & 15) * 8; krow[0] = tid >> 4; krow[1] = 32 + (tid >> 4); } else { kcol = (tid & 7) * 8; krow[0] = tid >> 3; }
    if constexpr (DV == 128) { vcol = (tid & 15) * 8; vrow[0] = tid >> 4; vrow[1] = 32 + (tid >> 4); } else { vcol = (tid & 7) * 8; vrow[0] = tid >> 3; }
#pragma unroll
    for (int i = 0; i < NKL; ++i) kst[i] = kswz<DQK>(krow[i], kcol * 2);
#pragma unroll
    for (int i = 0; i < NVL; ++i) vst[i] = v_st<NCB>(vrow[i], vcol);
    const int vb0 = (int)(uintptr_t)V_lds + v_rd_base(lane);
    struct { bf16x8 v[NVL]; bf16x8 k[NKL]; } sr_[SDEPTH];
    unsigned voffv[NVL], voffk[NKL];
#pragma unroll
    for (int i = 0; i < NVL; ++i) voffv[i] = (unsigned)(vrow[i] * ldk + vcol) * 2u;
#pragma unroll
    for (int i = 0; i < NKL; ++i) voffk[i] = (unsigned)(krow[i] * ldk + kcol) * 2u;
#define TROW(k0) (WINDOW ? (((k0) < 256) ? (k0) : (((q0lat + (k0) - 128) > (MROWS - 64)) ? (MROWS - 64) : (q0lat + (k0) - 128))) : (k0))
#define SLOAD(i, k0) do { const size_t _tb = (size_t)TROW(k0) * (size_t)ldk * 2; const char* _vb = (const char*)Vb + _tb; const char* _kb = (const char*)Kb + _tb; \
    _Pragma("unroll") for (int _j = 0; _j < NVL; ++_j) sr_[i].v[_j] = *reinterpret_cast<const bf16x8*>(_vb + voffv[_j]); \
    _Pragma("unroll") for (int _j = 0; _j < NKL; ++_j) sr_[i].k[_j] = *reinterpret_cast<const bf16x8*>(_kb + voffk[_j]); } while (0)
#define SWRITE(b, i) do { _Pragma("unroll") for (int _j = 0; _j < NVL; ++_j) *(bf16x8*)(V_lds + (b) * SHM_V + vst[_j]) = sr_[i].v[_j]; \
    _Pragma("unroll") for (int _j = 0; _j < NKL; ++_j) *(bf16x8*)(K_lds + (b) * SHM_K + kst[_j]) = sr_[i].k[_j]; } while (0)
#define SWAIT() do { if constexpr (SDEPTH == 1) asm volatile("s_waitcnt vmcnt(0)" ::: "memory"); else if constexpr (NKL + NVL == 4) asm volatile("s_waitcnt vmcnt(4)" ::: "memory"); else if constexpr (NKL + NVL == 3) asm volatile("s_waitcnt vmcnt(3)" ::: "memory"); else asm volatile("s_waitcnt vmcnt(2)" ::: "memory"); } while (0)
#define RESC(a) do { if (__any((a) < 1.f)) { if (hi == 0) al_l[r32] = (a); asm volatile("s_waitcnt lgkmcnt(0)" ::: "memory"); \
    _Pragma("unroll") for (int d = 0; d < NCB; ++d) _Pragma("unroll") for (int r = 0; r < 16; ++r) o[d][r] *= al_l[crow(r, hi)]; } } while (0)
#define WMASK(p0, p1, jt) do { if constexpr (WINDOW) { if ((jt) * KVBLK >= 256) wmask(p0, p1, (jt) * KVBLK, q0lat, wid * QBLK + r32, hi); } } while (0)
    f32x16 pA0, pA1, pB0, pB1; float mnA, mnB, alA, alB; bf16x8 pa0, pa1, pa2, pa3; const int NT = seq / KVBLK;
    constexpr int SE = 0, SO = SDEPTH - 1;
    SLOAD(SE, 0); asm volatile("s_waitcnt vmcnt(0)" ::: "memory"); SWRITE(0, SE); __syncthreads();
    qkt<DQK>(pA0, pA1, K_lds, qr, r32, hi); WMASK(pA0, pA1, 0); partialSM<DQK>(pA0, pA1, m_reg, mnA, alA);
    SLOAD(SO, KVBLK); if constexpr (SDEPTH == 2) { if (2 < NT) SLOAD(SE, 2 * KVBLK); }
    SWAIT(); SWRITE(1, SO); __syncthreads();
    for (int j = 1; j + 1 < NT; j += 2) {
        SBAR(); qkt<DQK>(pB0, pB1, K_lds + SHM_K, qr, r32, hi); WMASK(pB0, pB1, j);
        finishSM(pA0, pA1, alA, l_reg, pa0, pa1, pa2, pa3); SBAR();
        SLOAD(SO, (j + SDEPTH) * KVBLK); SBAR();
        pv_d0<NCB>(o, vb0, pa0, pa1, pa2, pa3); partialSM<DQK>(pB0, pB1, m_reg, mnB, alB);
        __syncthreads(); SWAIT(); SWRITE(0, SE);
        RESC(alB); __syncthreads();
        SBAR(); qkt<DQK>(pA0, pA1, K_lds, qr, r32, hi); WMASK(pA0, pA1, j + 1);
        finishSM(pB0, pB1, alB, l_reg, pa0, pa1, pa2, pa3); SBAR();
        if (SDEPTH == 1 || j + 3 < NT) SLOAD(SE, (j + 1 + SDEPTH) * KVBLK); SBAR();
        pv_d0<NCB>(o, vb0 + SHM_V, pa0, pa1, pa2, pa3); partialSM<DQK>(pA0, pA1, m_reg, mnA, alA);
        __syncthreads(); SWAIT(); SWRITE(1, SO);
        RESC(alA); __syncthreads();
    }
    SBAR(); qkt<DQK>(pB0, pB1, K_lds + SHM_K, qr, r32, hi); WMASK(pB0, pB1, NT - 1);
    finishSM(pA0, pA1, alA, l_reg, pa0, pa1, pa2, pa3); SBAR();
    pv_d0<NCB>(o, vb0, pa0, pa1, pa2, pa3); partialSM<DQK>(pB0, pB1, m_reg, mnB, alB);
    __syncthreads(); RESC(alB);
    finishSM(pB0, pB1, alB, l_reg, pa0, pa1, pa2, pa3); SBAR();
    pv_d0<NCB>(o, vb0 + SHM_V, pa0, pa1, pa2, pa3);
    if (hi == 0) li_l[r32] = l_reg; asm volatile("s_waitcnt lgkmcnt(0)" ::: "memory");
#pragma unroll
    for (int r = 0; r < 16; ++r) { const float rl = __builtin_amdgcn_rcpf(li_l[crow(r, hi)]);
#pragma unroll
        for (int d = 0; d < NCB; ++d) o[d][r] *= rl; }
    __syncthreads();
#undef TROW
#undef SLOAD
#undef SWRITE
#undef SWAIT
#undef RESC
#undef WMASK
}
template <int NCB> __device__ __forceinline__ void store_o_bf16(const int tid, const f32x16 (&o)[NCB], bf16_t* O, int ldo) {
    const int wid = tid >> 6, lane = tid & 63, r32 = lane & 31, hi = lane >> 5;
    bf16_t* Ow = O + (long)(wid * QBLK) * ldo + r32;
#pragma unroll
    for (int r = 0; r < 16; ++r) { const int orow = crow(r, hi);
#pragma unroll
        for (int d = 0; d < NCB; ++d) Ow[(long)orow * ldo + d * 32] = (bf16_t)(cvtpk(o[d][r], 0.f) & 0xffffu); }
}

typedef float f32x2_t __attribute__((ext_vector_type(2)));
typedef __bf16 bf16x2_t __attribute__((ext_vector_type(2)));
typedef short v4i16_t __attribute__((ext_vector_type(4)));
__device__ __forceinline__ unsigned cvtpk_s(float lo, float hi) { f32x2_t v = {lo, hi}; bf16x2_t b = __builtin_convertvector(v, bf16x2_t); return __builtin_bit_cast(unsigned, b); }
__device__ __forceinline__ s16x4 vtr(int addr) { return __builtin_bit_cast(s16x4, __builtin_amdgcn_ds_read_tr16_b64_v4i16((LAS v4i16_t*)(uintptr_t)(unsigned)addr)); }
__device__ __forceinline__ float bfv(short x) { return __uint_as_float(((unsigned)(unsigned short)x) << 16); }
template <int DQK> __device__ __forceinline__ void qkt_init(f32x16& p0, f32x16& p1, float init, const char* Ks, const bf16x8* qr, int r32, int hi) {
#pragma unroll
    for (int r = 0; r < 16; ++r) { p0[r] = init; p1[r] = init; }
#pragma unroll
    for (int d0 = 0; d0 < DQK / 16; ++d0) { const int cb = (d0 * 16 + hi * 8) * 2;
        bf16x8 b0 = *reinterpret_cast<const bf16x8*>(Ks + kswz<DQK>(r32, cb));
        bf16x8 b1 = *reinterpret_cast<const bf16x8*>(Ks + kswz<DQK>(32 + r32, cb));
        p0 = __builtin_amdgcn_mfma_f32_32x32x16_bf16(b0, qr[d0], p0, 0, 0, 0);
        p1 = __builtin_amdgcn_mfma_f32_32x32x16_bf16(b1, qr[d0], p1, 0, 0, 0); }
}
__device__ __forceinline__ void exp_half(f32x16& p) {
#pragma unroll
    for (int r = 0; r < 16; ++r) p[r] = __builtin_amdgcn_exp2f(p[r]);
}
__device__ __forceinline__ void finish_fixed(f32x16& p0, f32x16& p1, float& l_reg, bf16x8& pa0, bf16x8& pa1, bf16x8& pa2, bf16x8& pa3) {
    exp_half(p1);
    float ps = 0;
#pragma unroll
    for (int r = 0; r < 16; ++r) ps += p0[r];
#pragma unroll
    for (int r = 0; r < 16; ++r) ps += p1[r];
    l_reg += ps;
#define PK4(P, BASE, OUT) do { unsigned a0 = cvtpk(P[BASE + 0], P[BASE + 1]), a1 = cvtpk(P[BASE + 2], P[BASE + 3]);   \
    unsigned b0 = cvtpk(P[BASE + 4], P[BASE + 5]), b1 = cvtpk(P[BASE + 6], P[BASE + 7]);                              \
    auto r0 = __builtin_amdgcn_permlane32_swap(a0, b0, false, false); auto r1 = __builtin_amdgcn_permlane32_swap(a1, b1, false, false); \
    u32x4 w = {r0[0], r1[0], r0[1], r1[1]}; OUT = *reinterpret_cast<bf16x8*>(&w); } while (0)
    PK4(p0, 0, pa0); PK4(p0, 8, pa1); PK4(p1, 0, pa2); PK4(p1, 8, pa3);
#undef PK4
}
template <int DQK, int DV, int SDEPTH>
__device__ __forceinline__ void attn_core_fixed(const int tid, const bf16_t* Qb, int ldq, const bf16_t* Kb, const bf16_t* Vb, int ldk, int seq, float kmaxC, char* lds, f32x16 (&o)[DV / 32]) {
    constexpr int NCB = DV / 32, NQF = DQK / 16, NKL = DQK / 64, NVL = DV / 64;
    constexpr float SCALE = (DQK == 128) ? 0.088388347648318440f : 0.125f;
    constexpr float C = SCALE * LOG2E;
    const int wid = tid >> 6, lane = tid & 63, r32 = lane & 31, hi = lane >> 5;
    char* V_lds = lds; char* K_lds = lds + 2 * SHM_V;
    float* li_l = (float*)(lds + 2 * SHM_V + 2 * SHM_K) + wid * 64;
    float l_reg = 0.f; bf16x8 qr[NQF];
#pragma unroll
    for (int d = 0; d < NCB; ++d) o[d] = f32x16{};
    const bf16_t* Qw = Qb + (long)(wid * QBLK + r32) * ldq + hi * 8;
#pragma unroll
    for (int d0 = 0; d0 < NQF; ++d0) qr[d0] = *reinterpret_cast<const bf16x8*>(Qw + d0 * 16);
    float ssq = 0.f;
#pragma unroll
    for (int d0 = 0; d0 < NQF; ++d0) { u32x4 w;
#pragma unroll
        for (int j = 0; j < 4; ++j) { const float a = bfv(qr[d0][2 * j]), b = bfv(qr[d0][2 * j + 1]); ssq = fmaf(a, a, ssq); ssq = fmaf(b, b, ssq); w[j] = cvtpk(a * C, b * C); }
        qr[d0] = *reinterpret_cast<bf16x8*>(&w); }
    { auto rr = __builtin_amdgcn_permlane32_swap(__float_as_uint(ssq), __float_as_uint(ssq), false, false); ssq = __uint_as_float(rr[0]) + __uint_as_float(rr[1]); }
    const float ninit = -fmaxf(0.f, sqrtf(ssq) * kmaxC - 60.f);
    int krow[NKL], vrow[NVL], kst[NKL], vst[NVL]; int kcol, vcol;
    if constexpr (DQK == 128) { kcol = (tid & 15) * 8; krow[0] = tid >> 4; krow[1] = 32 + (tid >> 4); } else { kcol = (tid & 7) * 8; krow[0] = tid >> 3; }
    if constexpr (DV == 128) { vcol = (tid & 15) * 8; vrow[0] = tid >> 4; vrow[1] = 32 + (tid >> 4); } else { vcol = (tid & 7) * 8; vrow[0] = tid >> 3; }
#pragma unroll
    for (int i = 0; i < NKL; ++i) kst[i] = kswz<DQK>(krow[i], kcol * 2);
#pragma unroll
    for (int i = 0; i < NVL; ++i) vst[i] = v_st<NCB>(vrow[i], vcol);
    const int vb0 = (int)(uintptr_t)V_lds + v_rd_base(lane);
    struct { bf16x8 v[NVL]; bf16x8 k[NKL]; } sr_[SDEPTH];
    unsigned voffv[NVL], voffk[NKL];
#pragma unroll
    for (int i = 0; i < NVL; ++i) voffv[i] = (unsigned)(vrow[i] * ldk + vcol) * 2u;
#pragma unroll
    for (int i = 0; i < NKL; ++i) voffk[i] = (unsigned)(krow[i] * ldk + kcol) * 2u;
#define SLOAD(i, k0) do { const size_t _tb = (size_t)(k0) * (size_t)ldk * 2; const char* _vb = (const char*)Vb + _tb; const char* _kb = (const char*)Kb + _tb; \
    _Pragma("unroll") for (int _j = 0; _j < NVL; ++_j) sr_[i].v[_j] = *reinterpret_cast<const bf16x8*>(_vb + voffv[_j]); \
    _Pragma("unroll") for (int _j = 0; _j < NKL; ++_j) sr_[i].k[_j] = *reinterpret_cast<const bf16x8*>(_kb + voffk[_j]); } while (0)
#define SWRITE(b, i) do { _Pragma("unroll") for (int _j = 0; _j < NVL; ++_j) *(bf16x8*)(V_lds + (b) * SHM_V + vst[_j]) = sr_[i].v[_j]; \
    _Pragma("unroll") for (int _j = 0; _j < NKL; ++_j) *(bf16x8*)(K_lds + (b) * SHM_K + kst[_j]) = sr_[i].k[_j]; } while (0)
#define SWAIT() do { if constexpr (SDEPTH == 1) asm volatile("s_waitcnt vmcnt(0)" ::: "memory"); else if constexpr (NKL + NVL == 4) asm volatile("s_waitcnt vmcnt(4)" ::: "memory"); else if constexpr (NKL + NVL == 3) asm volatile("s_waitcnt vmcnt(3)" ::: "memory"); else asm volatile("s_waitcnt vmcnt(2)" ::: "memory"); } while (0)
    f32x16 pA0, pA1, pB0, pB1; bf16x8 pa0, pa1, pa2, pa3; const int NT = seq / KVBLK;
    constexpr int SE = 0, SO = SDEPTH - 1;
    SLOAD(SE, 0); asm volatile("s_waitcnt vmcnt(0)" ::: "memory"); SWRITE(0, SE); __syncthreads();
    qkt_init<DQK>(pA0, pA1, ninit, K_lds, qr, r32, hi); exp_half(pA0);
    SLOAD(SO, KVBLK); if constexpr (SDEPTH == 2) { if (2 < NT) SLOAD(SE, 2 * KVBLK); }
    SWAIT(); SWRITE(1, SO); __syncthreads();
    for (int j = 1; j + 1 < NT; j += 2) {
        SBAR(); qkt_init<DQK>(pB0, pB1, ninit, K_lds + SHM_K, qr, r32, hi);
        finish_fixed(pA0, pA1, l_reg, pa0, pa1, pa2, pa3); SBAR();
        SLOAD(SO, (j + SDEPTH) * KVBLK); SBAR();
        pv_d0<NCB>(o, vb0, pa0, pa1, pa2, pa3); SBAR(); exp_half(pB0); SBAR();
        __syncthreads(); SWAIT(); SWRITE(0, SE);
        __syncthreads();
        SBAR(); qkt_init<DQK>(pA0, pA1, ninit, K_lds, qr, r32, hi);
        finish_fixed(pB0, pB1, l_reg, pa0, pa1, pa2, pa3); SBAR();
        if (SDEPTH == 1 || j + 3 < NT) SLOAD(SE, (j + 1 + SDEPTH) * KVBLK); SBAR();
        pv_d0<NCB>(o, vb0 + SHM_V, pa0, pa1, pa2, pa3); SBAR(); exp_half(pA0); SBAR();
        __syncthreads(); SWAIT(); SWRITE(1, SO);
        __syncthreads();
    }
    SBAR(); qkt_init<DQK>(pB0, pB1, ninit, K_lds + SHM_K, qr, r32, hi);
    finish_fixed(pA0, pA1, l_reg, pa0, pa1, pa2, pa3); SBAR();
    pv_d0<NCB>(o, vb0, pa0, pa1, pa2, pa3); exp_half(pB0);
    __syncthreads();
    finish_fixed(pB0, pB1, l_reg, pa0, pa1, pa2, pa3); SBAR();
    pv_d0<NCB>(o, vb0 + SHM_V, pa0, pa1, pa2, pa3);
    { auto rr = __builtin_amdgcn_permlane32_swap(__float_as_uint(l_reg), __float_as_uint(l_reg), false, false); l_reg = __uint_as_float(rr[0]) + __uint_as_float(rr[1]); }
    if (hi == 0) li_l[r32] = l_reg; asm volatile("s_waitcnt lgkmcnt(0)" ::: "memory");
#pragma unroll
    for (int r = 0; r < 16; ++r) { const float rl = __builtin_amdgcn_rcpf(li_l[crow(r, hi)]);
#pragma unroll
        for (int d = 0; d < NCB; ++d) o[d][r] *= rl; }
    __syncthreads();
#undef SLOAD
#undef SWRITE
#undef SWAIT
}

constexpr int DMA_KRING = 0, DMA_VRING = 3 * SHM_K, DMA_SCR = 3 * SHM_K + 3 * SHM_V;
template <int DQK, int DV>
__device__ __forceinline__ void attn_core_dma(const int tid, const bf16_t* Qb, int ldq, const bf16_t* Kb, const bf16_t* Vb, int ldk, int seq, float kmaxC, LAS unsigned char* ldsl, f32x16 (&o)[DV / 32]) {
    static_assert(DV == 128, "V image is [64][128]");
    constexpr int NCB = DV / 32, NQF = DQK / 16, NKL = DQK / 64, NVL = DV / 64;
    constexpr float SCALE = (DQK == 128) ? 0.088388347648318440f : 0.125f;
    constexpr float C = SCALE * LOG2E;
    const int wid = __builtin_amdgcn_readfirstlane(tid >> 6), lane = tid & 63, r32 = lane & 31, hi = lane >> 5;
    char* lds = (char*)(unsigned char*)ldsl;
    char* K_lds = lds + DMA_KRING; char* V_lds = lds + DMA_VRING;
    float* li_l = (float*)(lds + DMA_SCR) + wid * 64;
    float l_reg = 0.f; bf16x8 qr[NQF];
#pragma unroll
    for (int d = 0; d < NCB; ++d) o[d] = f32x16{};
    const bf16_t* Qw = Qb + (long)(wid * QBLK + r32) * ldq + hi * 8;
#pragma unroll
    for (int d0 = 0; d0 < NQF; ++d0) qr[d0] = *reinterpret_cast<const bf16x8*>(Qw + d0 * 16);
    float ssq = 0.f;
#pragma unroll
    for (int d0 = 0; d0 < NQF; ++d0) { u32x4 w;
#pragma unroll
        for (int j = 0; j < 4; ++j) { const float a = bfv(qr[d0][2 * j]), b = bfv(qr[d0][2 * j + 1]); ssq = fmaf(a, a, ssq); ssq = fmaf(b, b, ssq); w[j] = cvtpk(a * C, b * C); }
        qr[d0] = *reinterpret_cast<bf16x8*>(&w); }
    { auto rr = __builtin_amdgcn_permlane32_swap(__float_as_uint(ssq), __float_as_uint(ssq), false, false); ssq = __uint_as_float(rr[0]) + __uint_as_float(rr[1]); }
    const float ninit = -fmaxf(0.f, sqrtf(ssq) * kmaxC - 60.f);
    unsigned srck[NKL], srcv[NVL];
#pragma unroll
    for (int i = 0; i < NKL; ++i) { const int b = (wid * NKL + i) * 1024 + lane * 16;
        if constexpr (DQK == 128) { const int row = b >> 8, colB = (b & 255) ^ ((row & 7) << 4); srck[i] = (unsigned)(row * ldk * 2 + colB); }
        else { const int row = b >> 7, colB = (b & 127) ^ (((row >> 1) & 7) << 4); srck[i] = (unsigned)(row * ldk * 2 + colB); } }
#pragma unroll
    for (int i = 0; i < NVL; ++i) { const int b = (wid * NVL + i) * 1024 + lane * 16; const int sub = b >> 9, kk = (sub >> 2) * 8 + ((b & 511) >> 6);
        const int k = (kk & ~0xC) | ((kk & 4) << 1) | ((kk & 8) >> 1), c = (sub & 3) * 32 + ((b & 63) >> 1); srcv[i] = (unsigned)(k * ldk * 2 + c * 2); }
    const int vb0 = (int)(uintptr_t)V_lds + v_rd_base(lane);
    const int NT = seq / KVBLK;
#define DMA_K(t, slot) do { const int _t = (t) < NT ? (t) : NT - 1; const char* _kb = (const char*)Kb + (size_t)_t * KVBLK * (size_t)ldk * 2; \
    _Pragma("unroll") for (int _i = 0; _i < NKL; ++_i) __builtin_amdgcn_global_load_lds((const unsigned*)(_kb + srck[_i]), (LAS unsigned*)(ldsl + DMA_KRING + (slot) * SHM_K + (wid * NKL + _i) * 1024), 16, 0, 0); } while (0)
#define DMA_V(t, slot) do { const int _t = (t) < NT ? (t) : NT - 1; const char* _vb = (const char*)Vb + (size_t)_t * KVBLK * (size_t)ldk * 2; \
    _Pragma("unroll") for (int _i = 0; _i < NVL; ++_i) __builtin_amdgcn_global_load_lds((const unsigned*)(_vb + srcv[_i]), (LAS unsigned*)(ldsl + DMA_VRING + (slot) * SHM_V + (wid * NVL + _i) * 1024), 16, 0, 0); } while (0)
#define DMA_WAIT_BAR() do { if constexpr (NKL + NVL == 4) asm volatile("s_waitcnt vmcnt(4)" ::: "memory"); else asm volatile("s_waitcnt vmcnt(3)" ::: "memory"); \
    __builtin_amdgcn_s_barrier(); SBAR(); } while (0)
#define NEXT3(x) ((x) == 2 ? 0 : (x) + 1)
    f32x16 pA0, pA1, pB0, pB1; bf16x8 pa0, pa1, pa2, pa3;
    DMA_K(0, 0); DMA_K(1, 1); DMA_V(0, 0);
    asm volatile("s_waitcnt vmcnt(0)" ::: "memory"); __builtin_amdgcn_s_barrier(); SBAR();
    DMA_K(2, 2); DMA_V(1, 1);
    qkt_init<DQK>(pA0, pA1, ninit, K_lds, qr, r32, hi); exp_half(pA0);
    DMA_WAIT_BAR();
    int ks = 1, vs = 0;
    for (int j = 1; j + 1 < NT; j += 2) {
        { const int kd = ks == 0 ? 2 : ks - 1, vd = vs == 0 ? 2 : vs - 1; DMA_K(j + 2, kd); DMA_V(j + 1, vd); }
        SBAR(); qkt_init<DQK>(pB0, pB1, ninit, K_lds + ks * SHM_K, qr, r32, hi);
        finish_fixed(pA0, pA1, l_reg, pa0, pa1, pa2, pa3); SBAR();
        pv_d0<NCB>(o, vb0 + vs * SHM_V, pa0, pa1, pa2, pa3); SBAR(); exp_half(pB0); SBAR();
        DMA_WAIT_BAR();
        ks = NEXT3(ks); vs = NEXT3(vs);
        { const int kd = ks == 0 ? 2 : ks - 1, vd = vs == 0 ? 2 : vs - 1; DMA_K(j + 3, kd); DMA_V(j + 2, vd); }
        SBAR(); qkt_init<DQK>(pA0, pA1, ninit, K_lds + ks * SHM_K, qr, r32, hi);
        finish_fixed(pB0, pB1, l_reg, pa0, pa1, pa2, pa3); SBAR();
        pv_d0<NCB>(o, vb0 + vs * SHM_V, pa0, pa1, pa2, pa3); SBAR(); exp_half(pA0); SBAR();
        DMA_WAIT_BAR();
        ks = NEXT3(ks); vs = NEXT3(vs);
    }
    SBAR(); qkt_init<DQK>(pB0, pB1, ninit, K_lds + ks * SHM_K, qr, r32, hi);
    finish_fixed(pA0, pA1, l_reg, pa0, pa1, pa2, pa3); SBAR();
    pv_d0<NCB>(o, vb0 + vs * SHM_V, pa0, pa1, pa2, pa3); SBAR(); exp_half(pB0); SBAR();
    asm volatile("s_waitcnt vmcnt(0)" ::: "memory"); __builtin_amdgcn_s_barrier(); SBAR();
    vs = NEXT3(vs);
    finish_fixed(pB0, pB1, l_reg, pa0, pa1, pa2, pa3); SBAR();
    pv_d0<NCB>(o, vb0 + vs * SHM_V, pa0, pa1, pa2, pa3);
    { auto rr = __builtin_amdgcn_permlane32_swap(__float_as_uint(l_reg), __float_as_uint(l_reg), false, false); l_reg = __uint_as_float(rr[0]) + __uint_as_float(rr[1]); }
    if (hi == 0) li_l[r32] = l_reg; asm volatile("s_waitcnt lgkmcnt(0)" ::: "memory");
#pragma unroll
    for (int r = 0; r < 16; ++r) { const float rl = __builtin_amdgcn_rcpf(li_l[crow(r, hi)]);
#pragma unroll
        for (int d = 0; d < NCB; ++d) o[d][r] *= rl; }
    __syncthreads();
#undef DMA_K
#undef DMA_V
#undef DMA_WAIT_BAR
#undef NEXT3
}

__device__ __forceinline__ void glds16(const void* gsrc, unsigned lds_dst) { unsigned keep;
    asm volatile("s_mov_b32 %0, m0\n\ts_mov_b32 m0, %2\n\ts_nop 0\n\tglobal_load_lds_dwordx4 %1, off\n\ts_mov_b32 m0, %0" : "=&s"(keep) : "v"(gsrc), "s"(lds_dst) : "memory"); }
template <int DQK>
__device__ __forceinline__ void attn_core_il(const int tid, const bf16_t* Qb, int ldq, const bf16_t* Kb, const bf16_t* Vb, int ldk, int seq, float kmaxC, LAS unsigned char* ldsl, f32x16 (&o)[4], const float* qgain, const float* ropeT, int tpos0) {
    constexpr int NQF = DQK / 16, NKL = DQK / 64, NVL = 2, NGA = 2 * NQF, NADD = 32 / NGA, NPK = 16 / NGA, NCG = DQK / 32;
    constexpr float SCALE = (DQK == 128) ? 0.088388347648318440f : 0.125f;
    constexpr float C = SCALE * LOG2E;
    typedef const LAS char* lds_cptr;
    const int wid = __builtin_amdgcn_readfirstlane(tid >> 6), lane = tid & 63, r32 = lane & 31, hi = lane >> 5;
    char* lds = (char*)(unsigned char*)ldsl; const unsigned ldsb = (unsigned)(uintptr_t)ldsl;
    float* li_l = (float*)(lds + DMA_SCR) + wid * 64;
    float l_reg = 0.f; bf16x8 qr[NQF];
#pragma unroll
    for (int d = 0; d < 4; ++d) o[d] = f32x16{};
    const bf16_t* Qw = Qb + (long)(wid * QBLK + r32) * ldq + hi * 8;
    const float ssq = prep_q<DQK>(qr, Qw, qgain, ropeT, tpos0 >= 0 ? tpos0 + wid * QBLK + r32 : -1, hi, C);
    f32x16 negm;
    { const float ninit = -fmaxf(0.f, sqrtf(ssq) * kmaxC - 60.f);
#pragma unroll
      for (int r = 0; r < 16; ++r) negm[r] = ninit; }
    asm volatile("" : "+v"(negm));
    unsigned srck[2 * NKL], srcv[2 * NVL];
#pragma unroll
    for (int i = 0; i < 2 * NKL; ++i) { const int p = (wid & 3) + 4 * i, rg = p / NCG, cg = p % NCG; srck[i] = (unsigned)((rg * 16 + (lane & 15)) * ldk + (cg * 4 + (lane >> 4)) * 8) * 2u; }
#pragma unroll
    for (int i = 0; i < 2 * NVL; ++i) { const int p = (wid & 3) + 4 * i; srcv[i] = (unsigned)((16 * (p & 3) + (lane >> 2)) * ldk + (p >> 2) * 32 + (lane & 3) * 8) * 2u; }
    const lds_cptr kp0 = (lds_cptr)ldsl + DMA_KRING + (r32 >> 4) * (NCG * 1024) + hi * 256 + (r32 & 15) * 16;
    const lds_cptr vp0 = (lds_cptr)ldsl + DMA_VRING + ((lane >> 4) & 1) * 32 + (lane & 3) * 8 + (4 * hi + ((lane & 15) >> 2)) * 64;
    const int NT = seq / KVBLK;
#define DMA_K(t, slot) do { const int _t = (t) < NT ? (t) : NT - 1; const char* _kb = (const char*)Kb + (size_t)_t * KVBLK * (size_t)ldk * 2; \
    if (wid < 4) { _Pragma("unroll") for (int _i = 0; _i < 2 * NKL; ++_i) glds16(_kb + srck[_i], (unsigned)__builtin_amdgcn_readfirstlane((int)(ldsb + DMA_KRING + (slot) * SHM_K + (wid + 4 * _i) * 1024))); } } while (0)
#define DMA_V(t, slot) do { const int _t = (t) < NT ? (t) : NT - 1; const char* _vb = (const char*)Vb + (size_t)_t * KVBLK * (size_t)ldk * 2; \
    if (wid < 4) { _Pragma("unroll") for (int _i = 0; _i < 2 * NVL; ++_i) glds16(_vb + srcv[_i], (unsigned)__builtin_amdgcn_readfirstlane((int)(ldsb + DMA_VRING + (slot) * SHM_V + (wid + 4 * _i) * 1024))); } } while (0)
#define WAIT_BAR_N() do { if constexpr (NKL + NVL == 4) asm volatile("s_waitcnt vmcnt(8) lgkmcnt(0)\n\ts_barrier" ::: "memory"); else asm volatile("s_waitcnt vmcnt(6) lgkmcnt(0)\n\ts_barrier" ::: "memory"); SBAR(); } while (0)
#define WAIT_BAR_0() do { asm volatile("s_waitcnt vmcnt(0) lgkmcnt(0)\n\ts_barrier" ::: "memory"); SBAR(); } while (0)
#define PIN(x) asm volatile("" : "+v"(x))
#define KFR(kp, g) (*(const LAS bf16x8*)((kp) + ((g) & 1) * (2 * NCG * 1024) + ((g) >> 2) * 1024 + (((g) >> 1) & 1) * 512))
#define NEXT3(x) ((x) == 2 ? 0 : (x) + 1)
    f32x16 pA0, pA1, pB0, pB1; u32x4 pw0, pw1, pw2, pw3;
#define STEP(C0, C1, P0, P1, kso, vso) do { SBAR(); \
    const lds_cptr kp_ = kp0 + (kso); const lds_cptr vp_ = vp0 + (vso); \
    bf16x8 kf_[3]; s16x4 vl_[3], vh_[3]; float sacc = 0.f; \
    kf_[0] = KFR(kp_, 0); kf_[1] = KFR(kp_, 1); SBAR(); \
    _Pragma("unroll") for (int g = 0; g < NGA; ++g) { \
        if (g + 2 < NGA) kf_[(g + 2) % 3] = KFR(kp_, g + 2); \
        if (g == NGA - 2) { vl_[0] = vtr((int)(uintptr_t)(vp_)); vh_[0] = vtr((int)(uintptr_t)(vp_ + 512)); } \
        if (g == NGA - 1) { vl_[1] = vtr((int)(uintptr_t)(vp_ + 4096)); vh_[1] = vtr((int)(uintptr_t)(vp_ + 4096 + 512)); } \
        SBAR(); \
        if ((g & 1) == 0) C0 = __builtin_amdgcn_mfma_f32_32x32x16_bf16(kf_[g % 3], qr[g >> 1], (g < 2) ? negm : C0, 0, 0, 0); \
        else              C1 = __builtin_amdgcn_mfma_f32_32x32x16_bf16(kf_[g % 3], qr[g >> 1], (g < 2) ? negm : C1, 0, 0, 0); \
        _Pragma("unroll") for (int a_ = 0; a_ < NADD; ++a_) { const int v_ = g * NADD + a_; sacc += (v_ < 16) ? P0[v_ & 15] : P1[v_ & 15]; } \
        PIN(sacc); \
        _Pragma("unroll") for (int k_ = 0; k_ < NPK; ++k_) { const int w_ = g * NPK + k_; const int e_ = (2 * w_) & 15; const unsigned pk_ = (w_ < 8) ? cvtpk_s(P0[e_], P0[e_ + 1]) : cvtpk_s(P1[e_], P1[e_ + 1]); \
            if ((w_ >> 2) == 0) pw0[w_ & 3] = pk_; else if ((w_ >> 2) == 1) pw1[w_ & 3] = pk_; else if ((w_ >> 2) == 2) pw2[w_ & 3] = pk_; else pw3[w_ & 3] = pk_; } \
        PIN(pw0); PIN(pw1); PIN(pw2); PIN(pw3); SBAR(); } \
    l_reg += sacc; \
    _Pragma("unroll") for (int g = 0; g < 16; ++g) { \
        if (g + 2 < 16) { const int g2 = g + 2; vl_[g2 % 3] = vtr((int)(uintptr_t)(vp_ + (g2 & 3) * 4096 + (g2 >> 2) * 1024)); vh_[g2 % 3] = vtr((int)(uintptr_t)(vp_ + (g2 & 3) * 4096 + (g2 >> 2) * 1024 + 512)); } \
        SBAR(); \
        { const s16x4 l_ = vl_[g % 3], h_ = vh_[g % 3]; const bf16x8 vf_ = (bf16x8){l_[0], l_[1], l_[2], l_[3], h_[0], h_[1], h_[2], h_[3]}; \
          const bf16x8 pa_ = __builtin_bit_cast(bf16x8, (g >> 2) == 0 ? pw0 : ((g >> 2) == 1 ? pw1 : ((g >> 2) == 2 ? pw2 : pw3))); \
          o[g & 3] = __builtin_amdgcn_mfma_f32_32x32x16_bf16(pa_, vf_, o[g & 3], 0, 0, 0); } \
        if (g < 8) { C0[2 * g] = __builtin_amdgcn_exp2f(C0[2 * g]); C0[2 * g + 1] = __builtin_amdgcn_exp2f(C0[2 * g + 1]); PIN(C0); } \
        else { C1[2 * g - 16] = __builtin_amdgcn_exp2f(C1[2 * g - 16]); C1[2 * g - 15] = __builtin_amdgcn_exp2f(C1[2 * g - 15]); PIN(C1); } \
        SBAR(); } \
    } while (0)
    DMA_K(0, 0); DMA_K(1, 1); DMA_V(0, 0);
    WAIT_BAR_0();
    DMA_K(2, 2); DMA_V(1, 1);
    { const lds_cptr kp_ = kp0;
#pragma unroll
      for (int g = 0; g < NGA; ++g) { const bf16x8 kf = KFR(kp_, g);
          if ((g & 1) == 0) pA0 = __builtin_amdgcn_mfma_f32_32x32x16_bf16(kf, qr[g >> 1], (g < 2) ? negm : pA0, 0, 0, 0);
          else              pA1 = __builtin_amdgcn_mfma_f32_32x32x16_bf16(kf, qr[g >> 1], (g < 2) ? negm : pA1, 0, 0, 0); } }
    exp_half(pA0); exp_half(pA1);
    WAIT_BAR_N();
    int ks = 1, vs = 0;
    for (int t = 1; t + 1 < NT; t += 2) {
        { const int kd = ks == 0 ? 2 : ks - 1, vd = vs == 0 ? 2 : vs - 1; DMA_K(t + 2, kd); DMA_V(t + 1, vd); }
        STEP(pB0, pB1, pA0, pA1, ks * SHM_K, vs * SHM_V); WAIT_BAR_N(); ks = NEXT3(ks); vs = NEXT3(vs);
        { const int kd = ks == 0 ? 2 : ks - 1, vd = vs == 0 ? 2 : vs - 1; DMA_K(t + 3, kd); DMA_V(t + 2, vd); }
        STEP(pA0, pA1, pB0, pB1, ks * SHM_K, vs * SHM_V); WAIT_BAR_N(); ks = NEXT3(ks); vs = NEXT3(vs);
    }
    STEP(pB0, pB1, pA0, pA1, ks * SHM_K, vs * SHM_V); WAIT_BAR_0(); vs = NEXT3(vs);
    { float sacc = 0.f;
#pragma unroll
      for (int r = 0; r < 16; ++r) sacc += pB0[r];
#pragma unroll
      for (int r = 0; r < 16; ++r) sacc += pB1[r];
      l_reg += sacc;
      pw0 = (u32x4){cvtpk_s(pB0[0], pB0[1]), cvtpk_s(pB0[2], pB0[3]), cvtpk_s(pB0[4], pB0[5]), cvtpk_s(pB0[6], pB0[7])};
      pw1 = (u32x4){cvtpk_s(pB0[8], pB0[9]), cvtpk_s(pB0[10], pB0[11]), cvtpk_s(pB0[12], pB0[13]), cvtpk_s(pB0[14], pB0[15])};
      pw2 = (u32x4){cvtpk_s(pB1[0], pB1[1]), cvtpk_s(pB1[2], pB1[3]), cvtpk_s(pB1[4], pB1[5]), cvtpk_s(pB1[6], pB1[7])};
      pw3 = (u32x4){cvtpk_s(pB1[8], pB1[9]), cvtpk_s(pB1[10], pB1[11]), cvtpk_s(pB1[12], pB1[13]), cvtpk_s(pB1[14], pB1[15])};
      const lds_cptr vp_ = vp0 + vs * SHM_V;
#pragma unroll
      for (int g = 0; g < 16; ++g) { const s16x4 l_ = vtr((int)(uintptr_t)(vp_ + (g & 3) * 4096 + (g >> 2) * 1024)), h_ = vtr((int)(uintptr_t)(vp_ + (g & 3) * 4096 + (g >> 2) * 1024 + 512));
          const bf16x8 vf_ = (bf16x8){l_[0], l_[1], l_[2], l_[3], h_[0], h_[1], h_[2], h_[3]};
          const bf16x8 pa_ = __builtin_bit_cast(bf16x8, (g >> 2) == 0 ? pw0 : ((g >> 2) == 1 ? pw1 : ((g >> 2) == 2 ? pw2 : pw3)));
          o[g & 3] = __builtin_amdgcn_mfma_f32_32x32x16_bf16(pa_, vf_, o[g & 3], 0, 0, 0); } }
    { auto rr = __builtin_amdgcn_permlane32_swap(__float_as_uint(l_reg), __float_as_uint(l_reg), false, false); l_reg = __uint_as_float(rr[0]) + __uint_as_float(rr[1]); }
    if (hi == 0) li_l[r32] = l_reg; asm volatile("s_waitcnt lgkmcnt(0)" ::: "memory");
#pragma unroll
    for (int r = 0; r < 16; ++r) { const float rl = __builtin_amdgcn_rcpf(li_l[crow(r, hi)]);
#pragma unroll
        for (int d = 0; d < 4; ++d) o[d][r] *= rl; }
    __syncthreads();
#undef DMA_K
#undef DMA_V
#undef WAIT_BAR_N
#undef WAIT_BAR_0
#undef PIN
#undef KFR
#undef NEXT3
#undef STEP
}

typedef int i32x8 __attribute__((ext_vector_type(8)));
constexpr int F8_KRING = 0, F8_VRING = 4 * 8192, F8_SCR = 8 * 8192, F8_Q = 8 * 8192 + 2048;
constexpr float THR8 = 8.f;
__device__ __forceinline__ unsigned f8x4u(float a, float b, float c, float d) {
    int p = __builtin_amdgcn_cvt_pk_fp8_f32(a, b, 0, false); p = __builtin_amdgcn_cvt_pk_fp8_f32(c, d, p, true); return (unsigned)p; }
__device__ __forceinline__ void f8x8u(float a0, float a1, float a2, float a3, float b0, float b1, float b2, float b3, int& pa, int& pb) {
    asm volatile("v_cvt_pk_fp8_f32 %0, %2, %3\n\tv_cvt_pk_fp8_f32 %1, %6, %7\n\tv_cvt_pk_fp8_f32 %0, %4, %5 op_sel:[0,0,1]\n\tv_cvt_pk_fp8_f32 %1, %8, %9 op_sel:[0,0,1]\n\ts_nop 0"
                 : "=&v"(pa), "=&v"(pb) : "v"(a0), "v"(a1), "v"(a2), "v"(a3), "v"(b0), "v"(b1), "v"(b2), "v"(b3)); }
__device__ __forceinline__ float cl448(float x) { return __builtin_amdgcn_fmed3f(x, -448.f, 448.f); }
__device__ __forceinline__ unsigned f8x4(float a, float b, float c, float d) { return f8x4u(cl448(a), cl448(b), cl448(c), cl448(d)); }
template <int DQK> __device__ __forceinline__ int kimg_off(int key, int d) { const int g = (DQK == 128) ? ((key >> 1) & 7) : ((key >> 2) & 3); return key * DQK + ((((d >> 4) ^ g)) << 4) + (d & 15); }
__device__ __forceinline__ int vimg_off(int n, int j) { return n * 64 + ((((j >> 4) ^ ((n >> 2) & 3))) << 4) + (j & 15); }
__device__ __forceinline__ int kap(int h, int e) { return e < 16 ? crow(e, h) : 32 + crow(e - 16, h); }
template <int DQK>
__device__ __forceinline__ void attn_core_f8(const int tid, const bf16_t* Qb, int ldq, const unsigned char* Kimg, const unsigned char* Vimg, int seq, LAS unsigned char* ldsl, f32x16 (&o)[4],
                                             const float* qgain, const float* ropeT, int tpos0, float kmaxC) {
    constexpr int NQF = DQK / 16, NKS = DQK / 64, KTB = 64 * DQK, NKP = KTB / 1024;
    constexpr float SCALE = (DQK == 128) ? 0.088388347648318440f : 0.125f;
    constexpr float C = SCALE * LOG2E;
    typedef const LAS char* lds_cptr;
    const int wid = __builtin_amdgcn_readfirstlane(tid >> 6), lane = tid & 63, r32 = lane & 31, hi = lane >> 5;
    char* lds = (char*)(unsigned char*)ldsl; const unsigned ldsb = (unsigned)(uintptr_t)ldsl;
    float l_reg = 0.f;
#pragma unroll
    for (int d = 0; d < 4; ++d) o[d] = f32x16{};
    i32x8 qf[NKS]; float qn2;
    { float x[NQF][8];
      qn2 = prep_q_x<DQK>(x, Qb + (long)(wid * QBLK + r32) * ldq + hi * 8, qgain, ropeT, tpos0 >= 0 ? tpos0 + wid * QBLK + r32 : -1, hi);
#pragma unroll
      for (int ks = 0; ks < NKS; ++ks)
#pragma unroll
          for (int i = 0; i < 2; ++i) { const int da = 4 * ks + i, db = 4 * ks + 2 + i;
              unsigned a0 = f8x4(x[da][0] * C, x[da][1] * C, x[da][2] * C, x[da][3] * C), a1 = f8x4(x[da][4] * C, x[da][5] * C, x[da][6] * C, x[da][7] * C);
              unsigned b0 = f8x4(x[db][0] * C, x[db][1] * C, x[db][2] * C, x[db][3] * C), b1 = f8x4(x[db][4] * C, x[db][5] * C, x[db][6] * C, x[db][7] * C);
              auto r0 = __builtin_amdgcn_permlane32_swap(a0, b0, false, false); auto r1 = __builtin_amdgcn_permlane32_swap(a1, b1, false, false);
              qf[ks][4 * i + 0] = (int)r0[0]; qf[ks][4 * i + 1] = (int)r1[0]; qf[ks][4 * i + 2] = (int)r0[1]; qf[ks][4 * i + 3] = (int)r1[1]; } }
    const int gk = (DQK == 128) ? ((r32 >> 1) & 7) : ((r32 >> 2) & 3), gv = (r32 >> 2) & 3;
    int kc2[2], vco[2];
#pragma unroll
    for (int i = 0; i < 2; ++i) kc2[i] = (((2 * hi + i) ^ gk) << 4);
#define kco(i) (((i) >> 1) ? (kc2[(i) & 1] ^ 64) : kc2[(i) & 1])
#pragma unroll
    for (int i = 0; i < 2; ++i) vco[i] = (((2 * hi + i) ^ gv) << 4);
    const lds_cptr qp0 = (lds_cptr)ldsl + F8_Q + wid * 4096 + r32 * DQK;
#pragma unroll
    for (int ks = 0; ks < NKS; ++ks) { *(LAS u32x4*)(qp0 + kco(2 * ks)) = (u32x4){(unsigned)qf[ks][0], (unsigned)qf[ks][1], (unsigned)qf[ks][2], (unsigned)qf[ks][3]};
        *(LAS u32x4*)(qp0 + kco(2 * ks + 1)) = (u32x4){(unsigned)qf[ks][4], (unsigned)qf[ks][5], (unsigned)qf[ks][6], (unsigned)qf[ks][7]}; }
    asm volatile("s_waitcnt lgkmcnt(0)" ::: "memory");
    const lds_cptr kp0 = (lds_cptr)ldsl + F8_KRING + r32 * DQK;
    const lds_cptr vp0 = (lds_cptr)ldsl + F8_VRING + r32 * 64;
    const int NT = seq / KVBLK;
    const unsigned char* kimgw = Kimg + (wid % NKP) * 1024; const unsigned char* vimgw = Vimg + wid * 1024;
#define ksrc (kimgw + (unsigned)(lane * 16))
#define vsrc (vimgw + (unsigned)(lane * 16))
#define DMA8(t, kslot, vslot) do { const int _t = (t) < NT ? (t) : NT - 1; \
    glds16(ksrc + (size_t)_t * KTB, (unsigned)__builtin_amdgcn_readfirstlane((int)(ldsb + F8_KRING + (kslot) * 8192 + (wid % NKP) * 1024))); \
    glds16(vsrc + (size_t)_t * 8192, (unsigned)__builtin_amdgcn_readfirstlane((int)(ldsb + F8_VRING + (vslot) * 8192 + wid * 1024))); } while (0)
#define DMA8K(t, kslot) do { const int _t = (t) < NT ? (t) : NT - 1; glds16(ksrc + (size_t)_t * KTB, (unsigned)__builtin_amdgcn_readfirstlane((int)(ldsb + F8_KRING + (kslot) * 8192 + (wid % NKP) * 1024))); } while (0)
#define WB8(n) do { asm volatile("s_waitcnt vmcnt(" #n ") lgkmcnt(0)\n\ts_barrier" ::: "memory"); SBAR(); } while (0)
#define QKT8(C0, C1, kso) do { const lds_cptr kp_ = kp0 + (kso); \
    _Pragma("unroll") for (int ks = 0; ks < NKS; ++ks) { \
        const u32x4 a0 = *(const LAS u32x4*)(kp_ + kco(2 * ks)), a1 = *(const LAS u32x4*)(kp_ + kco(2 * ks + 1)); \
        const u32x4 b0 = *(const LAS u32x4*)(kp_ + 32 * DQK + kco(2 * ks)), b1 = *(const LAS u32x4*)(kp_ + 32 * DQK + kco(2 * ks + 1)); \
        const i32x8 ka = {(int)a0[0], (int)a0[1], (int)a0[2], (int)a0[3], (int)a1[0], (int)a1[1], (int)a1[2], (int)a1[3]}; \
        const i32x8 kb = {(int)b0[0], (int)b0[1], (int)b0[2], (int)b0[3], (int)b1[0], (int)b1[1], (int)b1[2], (int)b1[3]}; \
        const u32x4 q0 = *(const LAS u32x4*)(qp0 + kco(2 * ks)), q1 = *(const LAS u32x4*)(qp0 + kco(2 * ks + 1)); \
        const i32x8 qq = {(int)q0[0], (int)q0[1], (int)q0[2], (int)q0[3], (int)q1[0], (int)q1[1], (int)q1[2], (int)q1[3]}; \
        C0 = __builtin_amdgcn_mfma_scale_f32_32x32x64_f8f6f4(ka, qq, ks == 0 ? negm : C0, 0, 0, 0, 0, 0, 0); \
        C1 = __builtin_amdgcn_mfma_scale_f32_32x32x64_f8f6f4(kb, qq, ks == 0 ? negm : C1, 0, 0, 0, 0, 0, 0); SBAR(); } } while (0)
#define PV8(vso) do { const lds_cptr vp_ = vp0 + (vso); \
    _Pragma("unroll") for (int d = 0; d < 4; ++d) { const u32x4 v0 = *(const LAS u32x4*)(vp_ + d * 2048 + vco[0]), v1 = *(const LAS u32x4*)(vp_ + d * 2048 + vco[1]); \
        const i32x8 vf = {(int)v0[0], (int)v0[1], (int)v0[2], (int)v0[3], (int)v1[0], (int)v1[1], (int)v1[2], (int)v1[3]}; \
        o[d] = __builtin_amdgcn_mfma_scale_f32_32x32x64_f8f6f4(pw, vf, o[d], 0, 0, 0, 0, 0, 0); } } while (0)
#define PART8(P0, P1, AL) do { float pm = P0[0]; \
    _Pragma("unroll") for (int r = 1; r < 16; ++r) pm = fmaxf(pm, P0[r]); \
    _Pragma("unroll") for (int r = 0; r < 16; ++r) pm = fmaxf(pm, P1[r]); \
    { auto rr = __builtin_amdgcn_permlane32_swap(__float_as_uint(pm), __float_as_uint(pm), false, false); pm = fmaxf(__uint_as_float(rr[0]), __uint_as_float(rr[1])); } \
    AL = 1.f; \
    if (!__builtin_expect(__all(pm <= THR8), 1)) { const float dl = fmaxf(pm, 0.f); AL = __builtin_amdgcn_exp2f(-dl); \
        _Pragma("unroll") for (int r = 0; r < 16; ++r) { P0[r] -= dl; P1[r] -= dl; negm[r] -= dl; } } \
    _Pragma("unroll") for (int r = 0; r < 16; ++r) P0[r] = __builtin_amdgcn_exp2f(P0[r]); } while (0)
#define FIN8(P0, P1, AL) do { \
    _Pragma("unroll") for (int r = 0; r < 16; ++r) P1[r] = __builtin_amdgcn_exp2f(P1[r]); \
    float ps = 0.f; \
    _Pragma("unroll") for (int r = 0; r < 16; ++r) ps += P0[r]; \
    _Pragma("unroll") for (int r = 0; r < 16; ++r) ps += P1[r]; \
    l_reg = l_reg * AL + ps; \
    _Pragma("unroll") for (int v = 0; v < 4; ++v) { pw[v] = (int)f8x4u(P0[4 * v], P0[4 * v + 1], P0[4 * v + 2], P0[4 * v + 3]); pw[4 + v] = (int)f8x4u(P1[4 * v], P1[4 * v + 1], P1[4 * v + 2], P1[4 * v + 3]); } } while (0)
#define RESC8(a) do { if (__any((a) < 1.f)) { int t2 = tid; asm volatile("" : "+v"(t2)); const int h2 = (t2 >> 5) & 1, r2 = t2 & 31; float* al2 = (float*)(lds + F8_SCR) + (t2 >> 6) * 64 + 32;   \
    if (h2 == 0) al2[r2] = (a); asm volatile("s_waitcnt lgkmcnt(0)" ::: "memory"); \
    _Pragma("unroll") for (int d = 0; d < 4; ++d) _Pragma("unroll") for (int r = 0; r < 16; ++r) o[d][r] *= al2[crow(r, h2)]; } } while (0)
#define NEXT3(x) ((x) == 2 ? 0 : (x) + 1)
    f32x16 pA0, pA1, pB0, pB1, negm = f32x16{}; float alA = 1.f, alB = 1.f; i32x8 pw;
    DMA8(0, 0, 0); DMA8K(1, 1); DMA8K(2, 2);
    WB8(0);
    { const int tk = 3 < NT ? 3 : NT - 1, tv = 1;
      glds16(ksrc + (size_t)tk * KTB, (unsigned)__builtin_amdgcn_readfirstlane((int)(ldsb + F8_KRING + 3 * 8192 + (wid % NKP) * 1024)));
      glds16(vsrc + (size_t)tv * 8192, (unsigned)__builtin_amdgcn_readfirstlane((int)(ldsb + F8_VRING + 1 * 8192 + wid * 1024))); }
    QKT8(pA0, pA1, 0);
    { float pm = pA0[0];
#pragma unroll
      for (int r = 1; r < 16; ++r) pm = fmaxf(pm, pA0[r]);
#pragma unroll
      for (int r = 0; r < 16; ++r) pm = fmaxf(pm, pA1[r]);
      { auto rr = __builtin_amdgcn_permlane32_swap(__float_as_uint(pm), __float_as_uint(pm), false, false); pm = fmaxf(__uint_as_float(rr[0]), __uint_as_float(rr[1])); }
      pm = fmaxf(pm, sqrtf(qn2) * kmaxC * 1.1f - 100.f);
#pragma unroll
      for (int r = 0; r < 16; ++r) { pA0[r] -= pm; pA1[r] -= pm; negm[r] = -pm; }
#pragma unroll
      for (int r = 0; r < 16; ++r) pA0[r] = __builtin_amdgcn_exp2f(pA0[r]); }
#pragma unroll
    for (int r = 0; r < 16; ++r) pA1[r] = __builtin_amdgcn_exp2f(pA1[r]);
#define PIN(x) asm volatile("" : "+v"(x))
#define KF8(kp, g) ({ const u32x4 _a = *(const LAS u32x4*)((kp) + ((g) & 1) * (32 * DQK) + kco(2 * ((g) >> 1))), _b = *(const LAS u32x4*)((kp) + ((g) & 1) * (32 * DQK) + kco(2 * ((g) >> 1) + 1)); \
    (i32x8){(int)_a[0], (int)_a[1], (int)_a[2], (int)_a[3], (int)_b[0], (int)_b[1], (int)_b[2], (int)_b[3]}; })
#define QF8(ks) ({ const u32x4 _a = *(const LAS u32x4*)(qp0 + kco(2 * (ks))), _b = *(const LAS u32x4*)(qp0 + kco(2 * (ks) + 1)); \
    (i32x8){(int)_a[0], (int)_a[1], (int)_a[2], (int)_a[3], (int)_b[0], (int)_b[1], (int)_b[2], (int)_b[3]}; })
#define VF8(vp, d) ({ const u32x4 _a = *(const LAS u32x4*)((vp) + (d) * 2048 + vco[0]), _b = *(const LAS u32x4*)((vp) + (d) * 2048 + vco[1]); \
    (i32x8){(int)_a[0], (int)_a[1], (int)_a[2], (int)_a[3], (int)_b[0], (int)_b[1], (int)_b[2], (int)_b[3]}; })
    constexpr int NG = 2 * NKS, NPG = (NG == 4) ? 2 : 1, NPK = 8 / NPG;
    constexpr float LIM8 = 448.f;
    bool resc = false; float pdl = 0.f;
    i32x8 sel; { const int sv = ((lane & 15) < 2 && ((lane >> 4) & 1) == (lane & 15)) ? 0x38383838 : 0;
#pragma unroll
      for (int i = 0; i < 8; ++i) sel[i] = sv; }
    f32x4 lacc = {0.f, 0.f, 0.f, 0.f}, srs;
#define PACK8(P0, P1, w_) do { const int e_ = (4 * (w_)) & 15; int pa_, pb_; \
    if ((w_) < 4) f8x8u(P0[e_], P0[e_ + 1], P0[e_ + 2], P0[e_ + 3], P0[e_ + 4], P0[e_ + 5], P0[e_ + 6], P0[e_ + 7], pa_, pb_); \
    else          f8x8u(P1[e_], P1[e_ + 1], P1[e_ + 2], P1[e_ + 3], P1[e_ + 4], P1[e_ + 5], P1[e_ + 6], P1[e_ + 7], pa_, pb_); \
    pw[w_] = pa_; pw[(w_) + 1] = pb_; } while (0)
#define RSUM8() srs = __builtin_amdgcn_mfma_scale_f32_16x16x128_f8f6f4(pw, sel, (f32x4){0.f, 0.f, 0.f, 0.f}, 0, 0, 0, 0, 0, 0)
#define MOVE9(P0, P1) do { float sacc = 0.f; \
    _Pragma("unroll") for (int r = 0; r < 16; ++r) sacc += P0[r]; \
    _Pragma("unroll") for (int r = 0; r < 16; ++r) sacc += P1[r]; \
    float srow; { auto rr = __builtin_amdgcn_permlane32_swap(__float_as_uint(sacc), __float_as_uint(sacc), false, false); srow = __uint_as_float(rr[0]) + __uint_as_float(rr[1]); } \
    pdl = fmaxf(__builtin_ceilf(__builtin_amdgcn_logf(srow)) - 6.f, 0.f); const float f_ = __builtin_amdgcn_exp2f(-pdl); \
    _Pragma("unroll") for (int r = 0; r < 16; ++r) { P0[r] *= f_; P1[r] *= f_; negm[r] -= pdl; } \
    { int t2 = tid; asm volatile("" : "+v"(t2)); float* al2 = (float*)(lds + F8_SCR) + (t2 >> 6) * 64 + 32; if (((t2 >> 5) & 1) == 0) al2[t2 & 31] = f_; asm volatile("s_waitcnt lgkmcnt(0)" ::: "memory"); \
      const int q0 = 16 * (t2 & 1) + 4 * ((t2 >> 4) & 3); \
      _Pragma("unroll") for (int r = 0; r < 4; ++r) lacc[r] *= al2[q0 + r]; } \
    _Pragma("unroll") for (int w_ = 0; w_ < 8; w_ += 2) PACK8(P0, P1, w_); \
    RSUM8(); resc = true; } while (0)
#define MOVE9B(C0, C1) do { int t2 = tid; asm volatile("" : "+v"(t2)); const int h2 = (t2 >> 5) & 1; const float* al2 = (const float*)(lds + F8_SCR) + (t2 >> 6) * 64 + 32; asm volatile("s_waitcnt lgkmcnt(0)" ::: "memory"); \
    _Pragma("unroll") for (int r = 0; r < 16; ++r) { C0[r] -= pdl; C1[r] -= pdl; } \
    _Pragma("unroll") for (int d = 0; d < 4; ++d) _Pragma("unroll") for (int r = 0; r < 16; ++r) o[d][r] *= al2[crow(r, h2)]; resc = false; } while (0)
#define TEST9(P0, P1) do { const float mx_ = (srs[0] + srs[1]) + (srs[2] + srs[3]);     \
    if (__builtin_expect(__any(!(mx_ < LIM8)), 0)) MOVE9(P0, P1); \
    lacc += srs; } while (0)
#define DMAK_(tk_, kd_) do { const int tk = (tk_) < NT ? (tk_) : NT - 1; glds16(ksrc + (size_t)tk * KTB, (unsigned)__builtin_amdgcn_readfirstlane((int)(ldsb + F8_KRING + (kd_) * 8192 + (wid % NKP) * 1024))); } while (0)
#define DMAV_(tv_, vd_) do { const int tv = (tv_) < NT ? (tv_) : NT - 1; glds16(vsrc + (size_t)tv * 8192, (unsigned)__builtin_amdgcn_readfirstlane((int)(ldsb + F8_VRING + (vd_) * 8192 + wid * 1024))); } while (0)
#define STEP8(C0, C1, P0, P1, kso, vso, knext, tk_, kd_, tv_, vd_) do { SBAR(); \
    const lds_cptr kp_ = kp0 + (kso); const lds_cptr vp_ = vp0 + (vso); \
    i32x8 vf_[2]; \
      \
    C0 = __builtin_amdgcn_mfma_scale_f32_32x32x64_f8f6f4(kc0_, qc0_, negm, 0, 0, 0, 0, 0, 0); SBAR(); \
    if (NG == 4) { kc0_ = KF8(kp_, 2); } else { vf_[0] = VF8(vp_, 0); } \
    if (NG == 4) { PACK8(P0, P1, 0); PACK8(P0, P1, 2); } else { PACK8(P0, P1, 0); PACK8(P0, P1, 2); PACK8(P0, P1, 4); PACK8(P0, P1, 6); SBAR(); RSUM8(); } \
    SBAR(); \
      \
    C1 = __builtin_amdgcn_mfma_scale_f32_32x32x64_f8f6f4(kc1_, qc0_, negm, 0, 0, 0, 0, 0, 0); SBAR(); \
    if (NG == 4) { kc1_ = KF8(kp_, 3); PACK8(P0, P1, 4); PACK8(P0, P1, 6); SBAR(); RSUM8(); } \
    else { DMAK_(tk_, kd_); DMAV_(tv_, vd_); SBAR(); TEST9(P0, P1); } \
    SBAR(); \
    if (NG == 4) { \
          \
        C0 = __builtin_amdgcn_mfma_scale_f32_32x32x64_f8f6f4(kc0_, qc1_, C0, 0, 0, 0, 0, 0, 0); SBAR(); \
        DMAK_(tk_, kd_); vf_[0] = VF8(vp_, 0); SBAR(); \
          \
        C1 = __builtin_amdgcn_mfma_scale_f32_32x32x64_f8f6f4(kc1_, qc1_, C1, 0, 0, 0, 0, 0, 0); SBAR(); \
        DMAV_(tv_, vd_); SBAR(); TEST9(P0, P1); SBAR(); } \
    if (__builtin_expect(resc, 0)) MOVE9B(C0, C1); \
    SBAR(); \
    _Pragma("unroll") for (int d = 0; d < 4; ++d) { \
        if (d + 1 < 4) vf_[(d + 1) & 1] = VF8(vp_, d + 1); \
        if (d == 3) { const lds_cptr kn_ = kp0 + (knext); kc0_ = KF8(kn_, 0); kc1_ = KF8(kn_, 1); }     \
        SBAR(); \
        o[d] = __builtin_amdgcn_mfma_scale_f32_32x32x64_f8f6f4(pw, vf_[d & 1], o[d], 0, 0, 0, 0, 0, 0); \
        if (d < 2) { _Pragma("unroll") for (int e_ = 0; e_ < 8; ++e_) C0[8 * d + e_] = __builtin_amdgcn_exp2f(C0[8 * d + e_]); PIN(C0); } \
        else       { _Pragma("unroll") for (int e_ = 0; e_ < 8; ++e_) C1[8 * (d - 2) + e_] = __builtin_amdgcn_exp2f(C1[8 * (d - 2) + e_]); PIN(C1); } \
        SBAR(); } \
    } while (0)
    i32x8 kc0_, kc1_, qc0_, qc1_;
    { const lds_cptr kn_ = kp0 + 1 * 8192; kc0_ = KF8(kn_, 0); qc0_ = QF8(0); kc1_ = KF8(kn_, 1); if (NG == 4) qc1_ = QF8(1); else qc1_ = qc0_; }
    WB8(2);
#define STEPQ(C0, C1, P0, P1, t_, q_) STEP8(C0, C1, P0, P1, ((q_) & 3) * 8192, (((q_) + 3) & 3) * 8192, (((q_) + 1) & 3) * 8192, (t_) + 3, ((q_) + 3) & 3, (t_) + 1, ((q_) + 1) & 3)
    int t = 1;
    for (; t + 6 < NT; t += 4) {
        STEPQ(pB0, pB1, pA0, pA1, t, 1); WB8(2);
        STEPQ(pA0, pA1, pB0, pB1, t + 1, 2); WB8(2);
        STEPQ(pB0, pB1, pA0, pA1, t + 2, 3); WB8(2);
        STEPQ(pA0, pA1, pB0, pB1, t + 3, 0); WB8(2);
    }
    STEPQ(pB0, pB1, pA0, pA1, t, 1); WB8(2);
    STEPQ(pA0, pA1, pB0, pB1, t + 1, 2); WB8(2);
    STEP8(pB0, pB1, pA0, pA1, 3 * 8192, 2 * 8192, 0 * 8192, NT, 2, NT, 0); WB8(0);
    const int vs_ = 3;
    {
#pragma unroll
      for (int w_ = 0; w_ < 8; w_ += 2) PACK8(pB0, pB1, w_);
      RSUM8();
      TEST9(pB0, pB1);
      if (resc) MOVE9B(pA0, pA1);
      PV8(vs_ * 8192); }
    { int t2 = tid; asm volatile("" : "+v"(t2)); const int h2 = (t2 >> 5) & 1; float* li2 = (float*)(lds + F8_SCR) + (t2 >> 6) * 64;
      if ((t2 & 15) < 2) { const int q0 = 16 * (t2 & 15) + 4 * ((t2 >> 4) & 3);
#pragma unroll
          for (int r = 0; r < 4; ++r) li2[q0 + r] = lacc[r]; }
      asm volatile("s_waitcnt lgkmcnt(0)" ::: "memory");
#pragma unroll
      for (int r = 0; r < 16; ++r) { const float rl = __builtin_amdgcn_rcpf(li2[crow(r, h2)]);
#pragma unroll
          for (int d = 0; d < 4; ++d) o[d][r] *= rl; } }
    __syncthreads();
#undef DMA8
#undef PIN
#undef KF8
#undef QF8
#undef VF8
#undef STEP8
#undef MOVE9
#undef MOVE9B
#undef TEST9
#undef PACK8
#undef RSUM8
#undef DMAK_
#undef DMAV_
#undef STEPQ
#undef kco
#undef ksrc
#undef vsrc
#undef DMA8K
#undef WB8
#undef QKT8
#undef PV8
#undef PART8
#undef FIN8
#undef RESC8
#undef NEXT3
}
template <int NCB> __device__ __forceinline__ void store_o_lds(const int tid, const f32x16 (&o)[NCB], bf16_t* O, int ldo, char* lds) {
    const int wid = tid >> 6, lane = tid & 63, r32 = lane & 31, hi = lane >> 5;
    constexpr int RB = NCB * 64;
    char* st = lds + wid * 8192;
#pragma unroll
    for (int r = 0; r < 16; ++r) { const int orow = crow(r, hi);
#pragma unroll
        for (int d = 0; d < NCB; ++d) *(bf16_t*)(st + orow * RB + (d * 32 + r32) * 2) = (bf16_t)(cvtpk(o[d][r], 0.f) & 0xffffu); }
    asm volatile("s_waitcnt lgkmcnt(0)" ::: "memory");
    constexpr int CPR = RB / 16;
#pragma unroll
    for (int i = 0; i < (32 * CPR) / 64; ++i) { const int c = lane + 64 * i, row = c / CPR, cc = c % CPR;
        const u32x4 v = *(const u32x4*)(st + row * RB + cc * 16);
        *(u32x4*)((char*)(O + (long)(wid * QBLK + row) * ldo) + cc * 16) = v; }
    asm volatile("s_waitcnt lgkmcnt(0)" ::: "memory");
    __syncthreads();
}
}

struct Args { const float* in[25]; float* out; unsigned char* ws; int ph_lo, ph_hi; };
enum { I_X = 0, I_C, I_CTX, I_CCTX, I_WMOD, I_BMOD, I_LNG, I_LNB, I_WINE, I_WOUTE, I_SINK, I_LQ1, I_LK1, I_LQ2, I_LK2, I_SUBG, I_WINO, I_WOUTO, I_QNG, I_KNG, I_WR, I_BR, I_WG, I_WU, I_WDN };

struct Ctx {
    LAS unsigned char* lds; LAS int* lc; int tid, lane, wave, G, c, gw, NGW;
    const GAS float* const CAS* in; unsigned char* ws;
};

#define INP(i) ((const float*)F.in[i])
__device__ __forceinline__ int lane_id() { int l; asm volatile("v_mbcnt_lo_u32_b32 %0, -1, 0\n\tv_mbcnt_hi_u32_b32 %0, -1, %0" : "=v"(l)); return l; }
__device__ __forceinline__ Ctx make_ctx(int wave_s) {
    Ctx F;
    unsigned t = (unsigned)(wave_s * 64 + lane_id()); asm volatile("" : "+v"(t));
    const CAS char* ka = (const CAS char*)__builtin_amdgcn_kernarg_segment_ptr(); asm volatile("" : "+s"(ka));
    unsigned lb = 0u; asm volatile("" : "+s"(lb));
    F.lds = (LAS unsigned char*)(uintptr_t)lb; F.lc = (LAS int*)(F.lds + LDSCTL_OFF);
    F.tid = (int)t; F.lane = F.tid & 63; F.wave = __builtin_amdgcn_readfirstlane(F.tid >> 6);
    F.G = gridDim.x; F.c = blockIdx.x; F.gw = F.c * NWAVES + F.wave; F.NGW = F.G * NWAVES;
    F.in = (const GAS float* const CAS*)ka; F.ws = (unsigned char*)*(GAS unsigned char* const CAS*)(ka + 208);
    return F;
}
__device__ __forceinline__ void p0_transpose_item(const float* W, int K, int N, bf16_t* WT, int mode, LAS float* scr, int item, int lane) {
    const int nblk = N / 32, kb = item / nblk, nb = item % nblk, k0 = 64 * kb, n0 = 32 * nb;
#pragma unroll 8
    for (int i = 0; i < 32; ++i) { const int kk = 2 * i + (lane >> 5); scr[kk * 33 + (lane & 31)] = W[(size_t)(k0 + kk) * N + n0 + (lane & 31)]; }
    LDS_WAIT(); asm volatile("" ::: "memory");
    const int cc = lane & 7;
#pragma unroll
    for (int j = 0; j < 4; ++j) { const int n = (lane >> 3) + 8 * j; const LAS float* s = scr + (8 * cc) * 33 + n;
        u32x4 o; o.x = cvt_pk_bf16(s[0 * 33], s[1 * 33]); o.y = cvt_pk_bf16(s[2 * 33], s[3 * 33]); o.z = cvt_pk_bf16(s[4 * 33], s[5 * 33]); o.w = cvt_pk_bf16(s[6 * 33], s[7 * 33]);
        const int ng = n0 + n; const int nr = (mode == 0) ? ng : ((ng >> 2) * 8 + (ng & 3) + (mode == 2 ? 4 : 0));
        *(u32x4*)(WT + (size_t)nr * K + k0 + 8 * cc) = o; }
    LDS_WAIT(); asm volatile("" ::: "memory");
}
__device__ __forceinline__ void p0_prologue(const Ctx& F) {
    unsigned char* ws = F.ws;
    for (int blk = F.c; blk < 192; blk += F.G) {
        LAS float* cs = (LAS float*)F.lds;
        for (int i = F.tid; i < 2048; i += NTHREADS) { const float v = (i < 1024) ? INP(I_C)[i] : INP(I_CCTX)[i - 1024]; cs[i] = v / (1.f + __expf(-v)); }
        __syncthreads();
        const int l = blk / 48, cb = (blk % 48) * 128, q = F.tid >> 7, cc = F.tid & 127, col = cb + cc;
        const float* wp = INP(I_WMOD) + (size_t)l * DM * 6144 + (size_t)(q * 256) * 6144 + col;
        float a0 = 0.f, a1 = 0.f;
#pragma unroll 8
        for (int k = 0; k < 256; ++k) { const float w = wp[(size_t)k * 6144]; a0 = fmaf(cs[q * 256 + k], w, a0); a1 = fmaf(cs[1024 + q * 256 + k], w, a1); }
        LAS float* red = (LAS float*)F.lds + 2048;
        red[(0 * 4 + q) * 128 + cc] = a0; red[(1 * 4 + q) * 128 + cc] = a1;
        __syncthreads();
        if (F.tid < 256) { const int s = F.tid >> 7; const float b = INP(I_BMOD)[l * 6144 + col];
            const float v = red[(s * 4 + 0) * 128 + cc] + red[(s * 4 + 1) * 128 + cc] + red[(s * 4 + 2) * 128 + cc] + red[(s * 4 + 3) * 128 + cc] + b;
            ((float*)(ws + WS_MODV))[(l * 2 + s) * 6144 + col] = v; }
        __syncthreads();
    }
    if (F.c == F.G - 1) {
        float* t64 = (float*)(ws + WS_TAB64); float* t128 = (float*)(ws + WS_TAB128);
        const float l2t = 13.287712379549449f;
        for (int i = F.tid; i < 256 * 16; i += NTHREADS) { const int pos = i >> 4, f = i & 15; const float inv = exp2f(-(float)f * (1.f / 16.f) * l2t), a = (float)pos * inv; t64[2 * i] = cosf(a); t64[2 * i + 1] = sinf(a); }
        for (int i = F.tid; i < 256 * 32; i += NTHREADS) { const int pos = i >> 5, f = i & 31; const float inv = exp2f(-(float)f * (1.f / 32.f) * l2t), a = (float)pos * inv; t128[2 * i] = cosf(a); t128[2 * i + 1] = sinf(a); }
        if (F.tid < 2) { const int i = F.tid; float s1 = 0.f, s2 = 0.f;
            for (int k = 0; k < 64; ++k) { s1 += INP(I_LQ1)[i * 64 + k] * INP(I_LK1)[i * 64 + k]; s2 += INP(I_LQ2)[i * 64 + k] * INP(I_LK2)[i * 64 + k]; }
            const float lam_init = 0.8f - 0.6f * expf(-0.3f * (float)(2 * i));
            ((float*)(ws + WS_LAM))[i] = expf(s1) - expf(s2) + lam_init; }
    }
    LAS float* scr = (LAS float*)(F.lds + 32768 + F.wave * 8704);
    constexpr int I_INE = 16 * 72, I_INO = 16 * 48, I_OUT = 16 * 32, I_GU = 16 * 16, I_DN = 8 * 32;
    constexpr int N_A = 2 * I_INE, N_B = 2 * I_INO, N_C = 4 * I_OUT, N_D = 64 * I_GU, N_E = 64 * I_GU, N_F = 64 * I_DN;
    constexpr int NITEMS = N_A + N_B + N_C + N_D + N_E + N_F;
    for (int it = F.gw; it < NITEMS; it += F.NGW) {
        int r = it;
        if (r < N_A) { const int i = r / I_INE; p0_transpose_item(INP(I_WINE) + (size_t)i * DM * EVEN_IN, DM, EVEN_IN, (bf16_t*)(ws + WS_WINE) + (size_t)i * EVEN_IN * DM, 0, scr, r % I_INE, F.lane); continue; } r -= N_A;
        if (r < N_B) { const int i = r / I_INO; p0_transpose_item(INP(I_WINO) + (size_t)i * DM * ODD_IN, DM, ODD_IN, (bf16_t*)(ws + WS_WINO) + (size_t)i * ODD_IN * DM, 0, scr, r % I_INO, F.lane); continue; } r -= N_B;
        if (r < N_C) { const int l = r / I_OUT; const float* src = ((l & 1) ? INP(I_WOUTO) : INP(I_WOUTE)) + (size_t)(l >> 1) * DM * DM;
            p0_transpose_item(src, DM, DM, (bf16_t*)(ws + WS_WOUT) + (size_t)l * DM * DM, 0, scr, r % I_OUT, F.lane); continue; } r -= N_C;
        if (r < N_D) { const int m = r / I_GU; p0_transpose_item(INP(I_WG) + (size_t)m * DM * DEXP, DM, DEXP, (bf16_t*)(ws + WS_WGU) + (size_t)m * 1024 * DM, 1, scr, r % I_GU, F.lane); continue; } r -= N_D;
        if (r < N_E) { const int m = r / I_GU; p0_transpose_item(INP(I_WU) + (size_t)m * DM * DEXP, DM, DEXP, (bf16_t*)(ws + WS_WGU) + (size_t)m * 1024 * DM, 2, scr, r % I_GU, F.lane); continue; } r -= N_E;
        { const int m = r / I_DN; p0_transpose_item(INP(I_WDN) + (size_t)m * DEXP * DM, DEXP, DM, (bf16_t*)(ws + WS_WD) + (size_t)m * DM * DEXP, 0, scr, r % I_DN, F.lane); }
    }
}

__device__ __forceinline__ void load_tstart(const Ctx& F, int l) {
    if (F.tid == 0) { unsigned* cw = (unsigned*)(F.ws + WS_CTL) + CW_CNT + l * 16 * 64; int acc = 0;
        for (int e = 0; e < 16; ++e) { const int n = (int)__hip_atomic_load(cw + e * 64, RLX_AGENT); F.lc[LC_ECNT + e] = n; F.lc[LC_TSTART + e] = acc; acc += (n + 255) >> 8; }
        F.lc[LC_TSTART + 16] = acc; }
    __syncthreads();
}

__device__ __forceinline__ void phase_a(const Ctx& F, int l, float* out) {
    unsigned char* ws = F.ws;
    float* XB = (float*)(ws + WS_XB); const float* X1B = (const float*)(ws + WS_X1B); bf16_t* HB = (bf16_t*)(ws + WS_HB);
    const bf16_t* MO = (const bf16_t*)(ws + WS_QKV); const i32x4* ROUTE = (const i32x4*)(ws + WS_ROUTE); const float* MODV = (const float*)(ws + WS_MODV);
    if (l > 0) load_tstart(F, l - 1);
    const int row_lo = (l == 4) ? NCTX : 0;
    for (int row = row_lo + F.gw; row < MROWS; row += F.NGW) {
        const int isctx = row < NCTX ? 1 : 0;
        f32x4 v[4];
        if (l == 0) {
            const float* src = isctx ? INP(I_CTX) + (size_t)row * DM : INP(I_X) + (size_t)(row - NCTX) * DM;
#pragma unroll
            for (int j = 0; j < 4; ++j) v[j] = *(const f32x4*)(src + 4 * F.lane + 256 * j);
        } else {
            const float* mp = MODV + ((l - 1) * 2 + isctx) * 6144;
            const i32x4 rt = ROUTE[row];
            const int e0 = rt.x >> 15, e1 = rt.y >> 15; const float w0 = __int_as_float(rt.z), w1 = __int_as_float(rt.w);
            const bf16_t* m0 = MO + (size_t)(F.lc[LC_TSTART + e0] * 256 + (rt.x & 32767)) * DM; const bf16_t* m1 = MO + (size_t)(F.lc[LC_TSTART + e1] * 256 + (rt.y & 32767)) * DM;
            float s = 0.f;
#pragma unroll
            for (int j = 0; j < 4; ++j) { const int col = 4 * F.lane + 256 * j;
                const f32x4 x1 = *(const f32x4*)(X1B + (size_t)row * DM + col); const f32x4 g2 = *(const f32x4*)(mp + 5120 + col);
                const u32x2 a = *(const u32x2*)(m0 + col), b = *(const u32x2*)(m1 + col);
                f32x4 mo; mo.x = w0 * bf_lo(a.x) + w1 * bf_lo(b.x); mo.y = w0 * bf_hi(a.x) + w1 * bf_hi(b.x); mo.z = w0 * bf_lo(a.y) + w1 * bf_lo(b.y); mo.w = w0 * bf_hi(a.y) + w1 * bf_hi(b.y);
                v[j] = ALPHA * x1 + g2 * mo; s += (v[j].x + v[j].y) + (v[j].z + v[j].w); }
            const float mean = wave_sum(s) * (1.f / DM); float s2 = 0.f;
#pragma unroll
            for (int j = 0; j < 4; ++j) { v[j] = v[j] - mean; s2 += (v[j].x * v[j].x + v[j].y * v[j].y) + (v[j].z * v[j].z + v[j].w * v[j].w); }
            const float rstd = 1.f / sqrtf(wave_sum(s2) * (1.f / DM) + LN_EPS);
#pragma unroll
            for (int j = 0; j < 4; ++j) { const int col = 4 * F.lane + 256 * j;
                const f32x4 g = *(const f32x4*)(INP(I_LNG) + ((l - 1) * 2 + 1) * DM + col), b = *(const f32x4*)(INP(I_LNB) + ((l - 1) * 2 + 1) * DM + col);
                v[j] = v[j] * rstd * g + b; }
        }
        if (l == 4) {
#pragma unroll
            for (int j = 0; j < 4; ++j) *(f32x4*)(out + (size_t)(row - NCTX) * DM + 4 * F.lane + 256 * j) = v[j];
        } else {
            const float* mq = MODV + (l * 2 + isctx) * 6144;
#pragma unroll
            for (int j = 0; j < 4; ++j) { const int col = 4 * F.lane + 256 * j;
                *(f32x4*)(XB + (size_t)row * DM + col) = v[j];
                const f32x4 sh = *(const f32x4*)(mq + col), sc = *(const f32x4*)(mq + 1024 + col);
                const f32x4 h = v[j] * (1.f + sc) + sh;
                u32x2 w; w.x = cvt_pk_bf16(h.x, h.y); w.y = cvt_pk_bf16(h.z, h.w);
                *(u32x2*)(HB + (size_t)row * DM + col) = w; }
        }
    }
}

__device__ __forceinline__ void kmax_begin(const Ctx& F) { if (F.tid < 16) F.lc[LC_KMAX + F.tid] = 0; __syncthreads(); }
__device__ __forceinline__ void kmax_end(const Ctx& F, int l, int nheads) {
    __syncthreads();
    if (F.tid < nheads) { const unsigned v = (unsigned)F.lc[LC_KMAX + F.tid]; if (v) atomicMax((unsigned*)(F.ws + WS_CTL) + CW_KMAX + (l * 16 + F.tid) * 64, v); }
}
__device__ __forceinline__ void rope8(u32x4& a, u32x4& b, const float* T) {
    unsigned* pa = (unsigned*)&a; unsigned* pb = (unsigned*)&b;
#pragma unroll
    for (int j = 0; j < 4; ++j) { const f32x4 cs = *(const f32x4*)(T + 4 * j);
        const float x10 = bf_lo(pa[j]), x11 = bf_hi(pa[j]), x20 = bf_lo(pb[j]), x21 = bf_hi(pb[j]);
        pa[j] = cvt_pk_bf16(x10 * cs.x - x20 * cs.y, x11 * cs.z - x21 * cs.w);
        pb[j] = cvt_pk_bf16(x10 * cs.y + x20 * cs.x, x11 * cs.w + x21 * cs.z); }
}
__device__ __forceinline__ float ss8(const u32x4& a) {
    const unsigned* p = (const unsigned*)&a; float s = 0.f;
#pragma unroll
    for (int j = 0; j < 4; ++j) { const float lo = bf_lo(p[j]), hi = bf_hi(p[j]); s = fmaf(lo, lo, s); s = fmaf(hi, hi, s); }
    return s;
}
__device__ __forceinline__ u32x2 pk8(const u32x4& a) {
    u32x2 w; w.x = att::f8x4(bf_lo(a.x), bf_hi(a.x), bf_lo(a.y), bf_hi(a.y)); w.y = att::f8x4(bf_lo(a.z), bf_hi(a.z), bf_lo(a.w), bf_hi(a.w)); return w; }
__device__ __forceinline__ void vimg_build(const Ctx& F, const bf16_t* QKV, int ld, int col0, int nheads) {
    unsigned char* VF8 = F.ws + WS_VF8;
    for (int it = F.gw; it < nheads * NTILE; it += F.NGW) {
        const int h = it / NTILE, tile = it - h * NTILE;
        unsigned char* img = VF8 + (size_t)it * 8192;
#pragma unroll 1
        for (int pass = 0; pass < 2; ++pass) { const int n = pass * 64 + F.lane;
            const bf16_t* src = QKV + (size_t)(tile * 64) * ld + col0 + h * 128 + n;
            float v[64];
#pragma unroll
            for (int k = 0; k < 64; ++k) v[k] = __uint_as_float(((unsigned)src[(size_t)k * ld]) << 16);
#pragma unroll
            for (int c = 0; c < 4; ++c) { u32x4 w;
#pragma unroll
                for (int d = 0; d < 4; ++d) { const int j = 16 * c + 4 * d, hh = j >> 5, e = j & 31;
                    w[d] = att::f8x4(v[att::kap(hh, e)], v[att::kap(hh, e + 1)], v[att::kap(hh, e + 2)], v[att::kap(hh, e + 3)]); }
                *(u32x4*)(img + att::vimg_off(n, 16 * c)) = w; } }
    }
}
__device__ __forceinline__ void phase_c_even(const Ctx& F, int l) {
    bf16_t* QKV = (bf16_t*)(F.ws + WS_QKV); const float* T = (const float*)(F.ws + WS_TAB64); unsigned char* KF8 = F.ws + WS_KF8;
    kmax_begin(F);
    const int sub = F.lane >> 2, q = F.lane & 3;
    const int e1 = (q >> 1) * 32 + (q & 1) * 8;
    const int nitems = SEQ * 10;
    for (int it = F.gw * 16 + sub; it < nitems; it += F.NGW * 16) {
        const int t = it / 10, hd = it - t * 10;
        const int col = hd < 2 ? 512 + 64 * hd : 1280 + 64 * (hd - 2);
        const int pos = (q >> 1) ? (t & 63) : (t >> 6);
        bf16_t* p = QKV + (size_t)(NCTX + t) * EVEN_IN + col + e1;
        u32x4 a = *(const u32x4*)p, b = *(const u32x4*)(p + 16);
        float ss = ss8(a) + ss8(b);
        rope8(a, b, T + (pos * 16 + (q & 1) * 8) * 2);
        *(u32x4*)p = a; *(u32x4*)(p + 16) = b;
        if (hd >= 2) {
            const int row = NCTX + t; unsigned char* img = KF8 + ((size_t)(hd - 2) * NTILE + (row >> 6)) * 4096;
            *(u32x2*)(img + att::kimg_off<64>(row & 63, e1)) = pk8(a); *(u32x2*)(img + att::kimg_off<64>(row & 63, e1 + 16)) = pk8(b); }
        ss += __shfl_xor(ss, 1); ss += __shfl_xor(ss, 2);
        if (q == 0 && hd >= 2) __hip_atomic_fetch_max((LAS unsigned*)(F.lc + LC_KMAX) + (hd - 2), __float_as_uint(ss), __ATOMIC_RELAXED, __HIP_MEMORY_SCOPE_WORKGROUP);
    }
    for (int it = F.gw * 16 + sub; it < NCTX * 8; it += F.NGW * 16) {
        const int row = it >> 3, hd = it & 7;
        const bf16_t* p = QKV + (size_t)row * EVEN_IN + 1280 + 64 * hd + 16 * q;
        const u32x4 a = *(const u32x4*)p, b = *(const u32x4*)(p + 8);
        float ss = ss8(a) + ss8(b);
        { unsigned char* img = KF8 + ((size_t)hd * NTILE + (row >> 6)) * 4096; const u32x2 w0 = pk8(a), w1 = pk8(b);
          *(u32x4*)(img + att::kimg_off<64>(row & 63, 16 * q)) = (u32x4){w0.x, w0.y, w1.x, w1.y}; }
        ss += __shfl_xor(ss, 1); ss += __shfl_xor(ss, 2);
        if (q == 0) __hip_atomic_fetch_max((LAS unsigned*)(F.lc + LC_KMAX) + hd, __float_as_uint(ss), __ATOMIC_RELAXED, __HIP_MEMORY_SCOPE_WORKGROUP);
    }
    vimg_build(F, QKV, EVEN_IN, 1792, 4);
    kmax_end(F, l, 8);
}
__device__ __forceinline__ void phase_c_odd(const Ctx& F, int li, int l) {
    bf16_t* QKV = (bf16_t*)(F.ws + WS_QKV); const float* T = (const float*)(F.ws + WS_TAB128); unsigned char* KF8 = F.ws + WS_KF8;
    const float* g = INP(I_KNG) + li * 128;
    kmax_begin(F);
    const int sub = F.lane >> 3, q = F.lane & 7;
    const int e1 = (q >> 2) * 64 + (q & 3) * 8;
    const int nitems = MROWS * 2;
    for (int it = F.gw * 8 + sub; it < nitems; it += F.NGW * 8) {
        const int row = it >> 1, hd = it & 1;
        bf16_t* p = QKV + (size_t)row * ODD_IN + 1024 + hd * 128 + e1;
        u32x4 a = *(const u32x4*)p, b = *(const u32x4*)(p + 32);
        float ss = ss8(a) + ss8(b);
        ss += __shfl_xor(ss, 1); ss += __shfl_xor(ss, 2); ss += __shfl_xor(ss, 4);
        const float rs = 1.f / sqrtf(ss * (1.f / 128.f) + QK_EPS);
        { unsigned* pa = (unsigned*)&a; unsigned* pb = (unsigned*)&b;
#pragma unroll
          for (int j = 0; j < 4; ++j) { const f32x2 ga = *(const f32x2*)(g + e1 + 2 * j), gb = *(const f32x2*)(g + e1 + 32 + 2 * j);
              pa[j] = cvt_pk_bf16(bf_lo(pa[j]) * rs * ga.x, bf_hi(pa[j]) * rs * ga.y); pb[j] = cvt_pk_bf16(bf_lo(pb[j]) * rs * gb.x, bf_hi(pb[j]) * rs * gb.y); } }
        float s2 = ss8(a) + ss8(b);
        s2 += __shfl_xor(s2, 1); s2 += __shfl_xor(s2, 2); s2 += __shfl_xor(s2, 4);
        if (q == 0) __hip_atomic_fetch_max((LAS unsigned*)(F.lc + LC_KMAX) + hd, __float_as_uint(s2), __ATOMIC_RELAXED, __HIP_MEMORY_SCOPE_WORKGROUP);
        if (row >= NCTX) { const int t = row - NCTX, pos = (q >> 2) ? (t & 63) : (t >> 6); rope8(a, b, T + (pos * 32 + (q & 3) * 8) * 2); }
        *(u32x4*)p = a; *(u32x4*)(p + 32) = b;
        { unsigned char* img = KF8 + ((size_t)hd * NTILE + (row >> 6)) * 8192;
          *(u32x2*)(img + att::kimg_off<128>(row & 63, e1)) = pk8(a); *(u32x2*)(img + att::kimg_off<128>(row & 63, e1 + 32)) = pk8(b); }
    }
    vimg_build(F, QKV, ODD_IN, 1280, 2);
    kmax_end(F, l, 2);
}

#define ATT_COMMON const bf16_t* QKV = (const bf16_t*)(F.ws + WS_QKV); bf16_t* OB = (bf16_t*)(F.ws + WS_OB); float* SCR = (float*)(F.ws + WS_YB); \
    char* lds = (char*)(unsigned char*)F.lds; (void)SCR; (void)OB;
#define EPI_TID() int te = F.wave * 64 + lane_id(); asm volatile("" : "+v"(te)); const int lane = te & 63, wid = te >> 6, r32 = lane & 31; (void)r32; (void)wid; (void)lane
__device__ __forceinline__ void phase_d_b0(const Ctx& F, int l) {
    ATT_COMMON
    for (int u = (F.c + F.G - 8) % F.G; u < 260; u += F.G) {
        const bool isctx = u >= 256; const int h = isctx ? u - 256 : (u >> 6); const int row0 = isctx ? 0 : NCTX + (u & 63) * 256; const int seq = isctx ? NCTX : MROWS;
        f32x16 o[4];
        const float kmaxC = sqrtf(__uint_as_float(__hip_atomic_load((unsigned*)(F.ws + WS_CTL) + CW_KMAX + (l * 16 + 2 * h) * 64, RLX_AGENT))) * (0.125f * LOG2E * 1.02f);
#if ATT_F8
        att::attn_core_f8<64>(F.wave * 64 + lane_id(), QKV + (size_t)row0 * EVEN_IN + 768 + (2 * h) * 64, EVEN_IN, F.ws + WS_KF8 + (size_t)(2 * h) * NTILE * 4096, F.ws + WS_VF8 + (size_t)h * NTILE * 8192, seq, F.lds, o, nullptr, (const float*)(F.ws + WS_TAB64), isctx ? -1 : (u & 63) * 256, kmaxC);
#else
        att::attn_core_il<64>(F.tid, QKV + (size_t)row0 * EVEN_IN + 768 + (2 * h) * 64, EVEN_IN, QKV + 1280 + (2 * h) * 64, QKV + 1792 + h * 128, EVEN_IN, seq, kmaxC, F.lds, o, nullptr, (const float*)(F.ws + WS_TAB64), isctx ? -1 : (u & 63) * 256);
#endif
        EPI_TID();
        float* scr = SCR + (size_t)u * 32768 + (size_t)wid * 4096 + lane;
#pragma unroll
        for (int r = 0; r < 16; ++r)
#pragma unroll
            for (int d = 0; d < 4; ++d) scr[(r * 4 + d) * 64] = o[d][r];
    }
}
__device__ __forceinline__ void phase_d_b1(const Ctx& F, int li, int l) { const int lam_layer = l;
    ATT_COMMON
    for (int u = (F.c + F.G - 8) % F.G; u < 260; u += F.G) {
        const bool isctx = u >= 256; const int h = isctx ? u - 256 : (u >> 6); const int row0 = isctx ? 0 : NCTX + (u & 63) * 256; const int seq = isctx ? NCTX : MROWS;
        f32x16 o[4];
        const float kmaxC = sqrtf(__uint_as_float(__hip_atomic_load((unsigned*)(F.ws + WS_CTL) + CW_KMAX + (l * 16 + 2 * h + 1) * 64, RLX_AGENT))) * (0.125f * LOG2E * 1.02f);
#if ATT_F8
        att::attn_core_f8<64>(F.wave * 64 + lane_id(), QKV + (size_t)row0 * EVEN_IN + 768 + (2 * h + 1) * 64, EVEN_IN, F.ws + WS_KF8 + (size_t)(2 * h + 1) * NTILE * 4096, F.ws + WS_VF8 + (size_t)h * NTILE * 8192, seq, F.lds, o, nullptr, (const float*)(F.ws + WS_TAB64), isctx ? -1 : (u & 63) * 256, kmaxC);
#else
        att::attn_core_il<64>(F.tid, QKV + (size_t)row0 * EVEN_IN + 768 + (2 * h + 1) * 64, EVEN_IN, QKV + 1280 + (2 * h + 1) * 64, QKV + 1792 + h * 128, EVEN_IN, seq, kmaxC, F.lds, o, nullptr, (const float*)(F.ws + WS_TAB64), isctx ? -1 : (u & 63) * 256);
#endif
        EPI_TID();
        const float* scr = SCR + (size_t)u * 32768 + (size_t)wid * 4096 + lane;
        const float lam = __hip_atomic_load((float*)(F.ws + WS_LAM) + li, RLX_AGENT);
        const float lam_init = 0.8f - 0.6f * expf(-0.3f * (float)lam_layer);
        const float* sg = INP(I_SUBG) + li * 128;
#pragma unroll
        for (int r = 0; r < 16; ++r) { float s = 0.f;
#pragma unroll
            for (int d = 0; d < 4; ++d) { const float v = scr[(r * 4 + d) * 64] - lam * o[d][r]; o[d][r] = v; s += v * v; }
#pragma unroll
            for (int mm = 1; mm < 32; mm <<= 1) s += __shfl_xor(s, mm);
            s = (1.f - lam_init) / sqrtf(s * (1.f / 128.f) + SUBLN_EPS);
#pragma unroll
            for (int d = 0; d < 4; ++d) o[d][r] *= s * sg[d * 32 + r32]; }
        att::store_o_lds<4>(te, o, OB + (size_t)row0 * DM + 512 + h * 128, DM, lds);
    }
}
__device__ __forceinline__ void phase_d_a(const Ctx& F, int li) {
    ATT_COMMON
    for (int u = F.c; u < 520; u += F.G) {
        const bool isctx = u >= 512; const int hq = isctx ? u - 512 : (u >> 6); const int q0lat = isctx ? 0 : (u & 63) * 256; const int row0 = isctx ? 0 : NCTX + q0lat; const int seq = isctx ? NCTX : NCTX + 512;
        const int kvh = hq >> 2; const float sink = INP(I_SINK)[li * 8 + hq];
        f32x16 o[2];
        att::attn_core<64, 64, true, 2>(F.wave * 64 + lane_id(), QKV + (size_t)row0 * EVEN_IN + hq * 64, EVEN_IN, QKV + 512 + kvh * 64, QKV + 640 + kvh * 64, EVEN_IN, seq, q0lat, sink * 8.f, 1.f, lds, o, (const float*)(F.ws + WS_TAB64), isctx ? -1 : q0lat);
        EPI_TID();
        att::store_o_lds<2>(te, o, OB + (size_t)row0 * DM + hq * 64, DM, lds);
    }
}
__device__ __forceinline__ void phase_d_odd(const Ctx& F, int l) {
    const bf16_t* QKV = (const bf16_t*)(F.ws + WS_QKV); bf16_t* OB = (bf16_t*)(F.ws + WS_OB);
    char* lds = (char*)(unsigned char*)F.lds;
    const int nun = (l == DEPTH - 1) ? 512 : 520;
    for (int u = F.c; u < nun; u += F.G) {
        const bool isctx = u >= 512; const int hq = isctx ? u - 512 : (u >> 6); const int row0 = isctx ? 0 : NCTX + (u & 63) * 256; const int seq = isctx ? NCTX : MROWS;
        const int kvh = hq >> 2;
        f32x16 o[4];
        const float kmaxC = sqrtf(__uint_as_float(__hip_atomic_load((unsigned*)(F.ws + WS_CTL) + CW_KMAX + (l * 16 + kvh) * 64, RLX_AGENT))) * (0.088388347648318440f * LOG2E * 1.02f);
#if ATT_F8
        att::attn_core_f8<128>(F.wave * 64 + lane_id(), QKV + (size_t)row0 * ODD_IN + hq * 128, ODD_IN, F.ws + WS_KF8 + (size_t)kvh * NTILE * 8192, F.ws + WS_VF8 + (size_t)kvh * NTILE * 8192, seq, F.lds, o, INP(I_QNG) + (l >> 1) * 128, (const float*)(F.ws + WS_TAB128), isctx ? -1 : (u & 63) * 256, kmaxC);
#else
        att::attn_core_il<128>(F.tid, QKV + (size_t)row0 * ODD_IN + hq * 128, ODD_IN, QKV + 1024 + kvh * 128, QKV + 1280 + kvh * 128, ODD_IN, seq, kmaxC, F.lds, o, INP(I_QNG) + (l >> 1) * 128, (const float*)(F.ws + WS_TAB128), isctx ? -1 : (u & 63) * 256);
#endif
        EPI_TID();
        att::store_o_lds<4>(te, o, OB + (size_t)row0 * DM + hq * 128, DM, lds);
    }
}


__device__ __forceinline__ void ctx_outproj_mini(const Ctx& F, const bf16_t* O, const bf16_t* Wt, bf16_t* Y) {
    for (int blk = F.c; blk < 256; blk += F.G) {
        const int rb = blk >> 4, cb = blk & 15, fr = F.lane & 15, fq = F.lane >> 4, kb = F.wave * 128;
        f32x4 acc[4];
#pragma unroll
        for (int n = 0; n < 4; ++n) acc[n] = (f32x4){0.f, 0.f, 0.f, 0.f};
        const bf16_t* ap = O + (size_t)(rb * 16 + fr) * DM + kb + 8 * fq;
        const bf16_t* bp = Wt + (size_t)(cb * 64 + fr) * DM + kb + 8 * fq;
#pragma unroll
        for (int k = 0; k < 4; ++k) { const bf16x8 a = *(const bf16x8*)(ap + 32 * k);
#pragma unroll
            for (int n = 0; n < 4; ++n) { const bf16x8 b = *(const bf16x8*)(bp + (size_t)(16 * n) * DM + 32 * k); acc[n] = __builtin_amdgcn_mfma_f32_16x16x32_bf16(b, a, acc[n], 0, 0, 0); } }
        LAS float* red = (LAS float*)F.lds + F.wave * 1024;
#pragma unroll
        for (int n = 0; n < 4; ++n) *(LAS f32x4*)(red + fr * 64 + 16 * n + 4 * fq) = acc[n];
        __syncthreads();
        { const int e = F.tid * 2; float s0 = 0.f, s1 = 0.f;
#pragma unroll
          for (int w = 0; w < 8; ++w) { const f32x2 v = *(const LAS f32x2*)((LAS float*)F.lds + w * 1024 + e); s0 += v.x; s1 += v.y; }
          const int row = e >> 6, col = e & 63;
          *(unsigned*)(Y + (size_t)(rb * 16 + row) * DM + cb * 64 + col) = cvt_pk_bf16(s0, s1); }
        __syncthreads();
    }
}
__device__ __forceinline__ void phase_f(const Ctx& F, int l, int row_lo, bool dry = false) {
    unsigned char* ws = F.ws;
    const float* XB = (const float*)(ws + WS_XB); const bf16_t* YB = (const bf16_t*)(ws + WS_YB); float* X1B = (float*)(ws + WS_X1B); bf16_t* HB = (bf16_t*)(ws + WS_HB);
    const float* MODV = (const float*)(ws + WS_MODV); i32x4* ROUTE = (i32x4*)(ws + WS_ROUTE); int* IDX = (int*)(ws + WS_IDX);
    LAS float* wr_l = (LAS float*)F.lds;
    for (int i = F.tid; i < 16384; i += NTHREADS) wr_l[(i & 15) * 1024 + (i >> 4)] = INP(I_WR)[i];
    if (F.tid < 16) F.lc[LC_LCNT + F.tid] = 0;
    __syncthreads();
    float br[16];
#pragma unroll
    for (int e = 0; e < 16; ++e) br[e] = INP(I_BR)[e];
    int nr = 0;
    for (int row = row_lo + F.gw; row < MROWS; row += F.NGW, ++nr) {
        const int isctx = row < NCTX ? 1 : 0; const float* mp = MODV + (l * 2 + isctx) * 6144;
        f32x4 v[4]; float s = 0.f;
#pragma unroll
        for (int j = 0; j < 4; ++j) { const int col = 4 * F.lane + 256 * j;
            const f32x4 x = *(const f32x4*)(XB + (size_t)row * DM + col), g1 = *(const f32x4*)(mp + 2048 + col); const u32x2 yw = *(const u32x2*)(YB + (size_t)row * DM + col);
            const f32x4 y = {bf_lo(yw.x), bf_hi(yw.x), bf_lo(yw.y), bf_hi(yw.y)};
            v[j] = ALPHA * x + g1 * y; s += (v[j].x + v[j].y) + (v[j].z + v[j].w); }
        const float mean = wave_sum(s) * (1.f / DM); float s2 = 0.f;
#pragma unroll
        for (int j = 0; j < 4; ++j) { v[j] = v[j] - mean; s2 += (v[j].x * v[j].x + v[j].y * v[j].y) + (v[j].z * v[j].z + v[j].w * v[j].w); }
        const float rstd = 1.f / sqrtf(wave_sum(s2) * (1.f / DM) + LN_EPS);
#pragma unroll
        for (int j = 0; j < 4; ++j) { const int col = 4 * F.lane + 256 * j;
            const f32x4 g = *(const f32x4*)(INP(I_LNG) + (l * 2) * DM + col), b = *(const f32x4*)(INP(I_LNB) + (l * 2) * DM + col);
            v[j] = v[j] * rstd * g + b;
            *(f32x4*)(X1B + (size_t)row * DM + col) = v[j];
            const f32x4 sh = *(const f32x4*)(mp + 3072 + col), sc = *(const f32x4*)(mp + 4096 + col);
            v[j] = v[j] * (1.f + sc) + sh;
            u32x2 w; w.x = cvt_pk_bf16(v[j].x, v[j].y); w.y = cvt_pk_bf16(v[j].z, v[j].w);
            *(u32x2*)(HB + (size_t)row * DM + col) = w; }
        float sc[16], sel[16];
#pragma unroll
        for (int e = 0; e < 16; ++e) { float a = 0.f;
#pragma unroll
            for (int j = 0; j < 4; ++j) { const f32x4 w = *(const LAS f32x4*)(wr_l + e * 1024 + 4 * F.lane + 256 * j); a += (v[j].x * w.x + v[j].y * w.y) + (v[j].z * w.z + v[j].w * w.w); }
            a = wave_sum(a); sc[e] = 1.f / (1.f + __expf(-a)); sel[e] = sc[e] + br[e]; }
        int best = 0; float bestv = -3.0e38f; int ci0[4], ci1[4]; float cw0[4], cw1[4];
#pragma unroll
        for (int g = 0; g < 4; ++g) {
            const float a = sel[4 * g], b = sel[4 * g + 1], c2 = sel[4 * g + 2], d = sel[4 * g + 3];
            int i0 = 0; float m0 = a; if (b > m0) { m0 = b; i0 = 1; } if (c2 > m0) { m0 = c2; i0 = 2; } if (d > m0) { m0 = d; i0 = 3; }
            int i1 = -1; float m1 = -3.0e38f;
            if (i0 != 0 && a > m1) { m1 = a; i1 = 0; } if (i0 != 1 && b > m1) { m1 = b; i1 = 1; } if (i0 != 2 && c2 > m1) { m1 = c2; i1 = 2; } if (i0 != 3 && d > m1) { m1 = d; i1 = 3; }
            const float gs = m0 + m1; if (gs > bestv) { bestv = gs; best = g; }
            ci0[g] = 4 * g + i0; ci1[g] = 4 * g + i1;
            const float s0 = sc[4 * g], s1 = sc[4 * g + 1], s2_ = sc[4 * g + 2], s3 = sc[4 * g + 3];
            cw0[g] = i0 == 0 ? s0 : (i0 == 1 ? s1 : (i0 == 2 ? s2_ : s3)); cw1[g] = i1 == 0 ? s0 : (i1 == 1 ? s1 : (i1 == 2 ? s2_ : s3)); }
        const int e0 = best == 0 ? ci0[0] : (best == 1 ? ci0[1] : (best == 2 ? ci0[2] : ci0[3])), e1 = best == 0 ? ci1[0] : (best == 1 ? ci1[1] : (best == 2 ? ci1[2] : ci1[3]));
        float w0 = best == 0 ? cw0[0] : (best == 1 ? cw0[1] : (best == 2 ? cw0[2] : cw0[3])), w1 = best == 0 ? cw1[0] : (best == 1 ? cw1[1] : (best == 2 ? cw1[2] : cw1[3]));
        const float wn = 1.f / (w0 + w1); w0 *= wn; w1 *= wn;
        if (F.lane == 0 && !dry) {
            const int lp0 = __hip_atomic_fetch_add(F.lc + LC_LCNT + e0, 1, __ATOMIC_RELAXED, __HIP_MEMORY_SCOPE_WORKGROUP);
            const int lp1 = __hip_atomic_fetch_add(F.lc + LC_LCNT + e1, 1, __ATOMIC_RELAXED, __HIP_MEMORY_SCOPE_WORKGROUP);
            LAS int* wt = F.lc + LC_WTAB + (F.wave * 16 + nr) * 8;
            wt[0] = row; wt[1] = e0; wt[2] = lp0; wt[3] = e1; wt[4] = lp1; wt[5] = __float_as_int(w0); wt[6] = __float_as_int(w1); }
    }
    __syncthreads();
    if (dry) return;
    if (F.tid < 16) { const int n = F.lc[LC_LCNT + F.tid];
        const unsigned base = n ? xb_add((unsigned*)(ws + WS_CTL) + CW_CNT + (l * 16 + F.tid) * 64, (unsigned)n) : 0u;
        F.lc[LC_GBASE + F.tid] = (int)base; }
    __syncthreads();
    if (F.lane < nr) {
        const LAS int* wt = F.lc + LC_WTAB + (F.wave * 16 + F.lane) * 8;
        const int row = wt[0], e0 = wt[1], e1 = wt[3]; const int p0 = F.lc[LC_GBASE + e0] + wt[2], p1 = F.lc[LC_GBASE + e1] + wt[4];
        IDX[e0 * MROWS + p0] = row; IDX[e1 * MROWS + p1] = row;
        i32x4 rt; rt.x = (e0 << 15) | p0; rt.y = (e1 << 15) | p1; rt.z = wt[5]; rt.w = wt[6];
        ROUTE[row] = rt; }
}

__global__ void __launch_bounds__(NTHREADS, 2) mk_fwd(Args args) {
    extern __shared__ __attribute__((aligned(16))) unsigned char lds_raw[];
    LAS int* lc0 = (LAS int*)((LAS unsigned char*)lds_raw + LDSCTL_OFF);
    const int wave_s = __builtin_amdgcn_readfirstlane((int)threadIdx.x >> 6);
    for (int u = wave_s * 64 + lane_id(); u < (LDS_BYTES - LDSCTL_OFF) / 4; u += NTHREADS) lc0[u] = 0;
    __syncthreads();
#define IS_T0 (wave_s == 0 && lane_id() == 0)
    unsigned* barw = (unsigned*)(args.ws + WS_CTL) + CW_BAR;
#if MK_MULTI
    XcdBarrier bar; bar.bar = barw; bar.x = 0; bar.st = nullptr;
#define GRID_BAR() do { } while (0)
#else
    XcdBarrier bar = xcd_barrier_post(barw, (volatile LAS unsigned*)(lc0 + LC_BAR), IS_T0);
#define GRID_BAR() xcd_barrier(bar, IS_T0)
#endif
    const int lo = args.ph_lo, hi = args.ph_hi;
#ifndef PHMASK
#define PHMASK 0xFFFF
#endif
#define EN(b) ((PHMASK >> (b)) & 1)
#ifndef REP_MASK
#define REP_MASK 0
#endif
#define REP_CAT2(a, b) a##b
#define REP_CAT(a, b) REP_CAT2(a, b)
#define REP(b) for (int REP_CAT(_rep, __LINE__) = 0; REP_CAT(_rep, __LINE__) < 1 + ((REP_MASK >> (b)) & 1); ++REP_CAT(_rep, __LINE__))
#define IN(k) (lo <= (k) && (k) < hi)
#define SEAM(k) do { if (IN(k) && IN((k) + 1)) GRID_BAR(); } while (0)

    if (IN(0) && EN(0)) REP(0) { const Ctx F = make_ctx(wave_s); p0_prologue(F); } SEAM(0);

    for (int l = 0; l < DEPTH; ++l) {
        const int pb = 1 + 8 * l, li = l >> 1; const bool odd = (l & 1) != 0;
        const int pm_lo = (l == DEPTH - 1) ? 1 : 0;
        if (IN(pb + 0) && EN(1)) REP(1) { const Ctx F = make_ctx(wave_s); phase_a(F, l, nullptr); } SEAM(pb + 0);
        if (IN(pb + 1) && EN(2)) REP(2) {
            const Ctx F = make_ctx(wave_s); unsigned char* ws = F.ws; const int NIN = odd ? ODD_IN : EVEN_IN;
            pg8::DenseSched S; S.init((const bf16_t*)(ws + WS_HB), odd ? (const bf16_t*)(ws + WS_WINO) + (size_t)li * ODD_IN * DM : (const bf16_t*)(ws + WS_WINE) + (size_t)li * EVEN_IN * DM, DM, 0, MROWS / 256, NIN, F.G, F.c);
            pg8::EpiBf16 E{(bf16_t*)(ws + WS_QKV), NIN};
            pg8::gemm_phase<pg8::EpiBf16, pg8::DenseSched>(F.tid, F.lds, DM, S, E);
        } SEAM(pb + 1);
        if (IN(pb + 2) && EN(3)) { const Ctx F = make_ctx(wave_s); if (odd) phase_c_odd(F, li, l); else phase_c_even(F, l); } SEAM(pb + 2);
        if (IN(pb + 3) && EN(4)) REP(4) {
#ifndef ATTSEL
#define ATTSEL 15
#endif
            if (odd) { if (ATTSEL & 8) REP(11) { const Ctx F = make_ctx(wave_s); phase_d_odd(F, l); } }
            else { REP(9) { if (ATTSEL & 1) { const Ctx F = make_ctx(wave_s); phase_d_b0(F, l); } if (ATTSEL & 2) { const Ctx F = make_ctx(wave_s); phase_d_b1(F, li, l); } } if (ATTSEL & 4) REP(10) { const Ctx F = make_ctx(wave_s); phase_d_a(F, li); } }
        } SEAM(pb + 3);
        if (IN(pb + 4) && EN(5)) REP(5) {
            const Ctx F = make_ctx(wave_s); unsigned char* ws = F.ws;
            pg8::DenseSched S; S.init((const bf16_t*)(ws + WS_OB), (const bf16_t*)(ws + WS_WOUT) + (size_t)l * DM * DM, DM, 1, MROWS / 256 - 1, DM, F.G, F.c);
            pg8::EpiBf16 E{(bf16_t*)(ws + WS_YB), DM};
            pg8::gemm_phase<pg8::EpiBf16, pg8::DenseSched>(F.tid, F.lds, DM, S, E);
            if (pm_lo == 0) ctx_outproj_mini(F, (const bf16_t*)(ws + WS_OB), (const bf16_t*)(ws + WS_WOUT) + (size_t)l * DM * DM, (bf16_t*)(ws + WS_YB));
        } SEAM(pb + 4);
#ifdef PF_PROBE
        if (IN(pb + 5) && EN(6)) { const Ctx F = make_ctx(wave_s); phase_f(F, l, pm_lo * 256, true); __syncthreads(); }
#endif
        if (IN(pb + 5) && EN(6)) { const Ctx F = make_ctx(wave_s); phase_f(F, l, pm_lo * 256); } SEAM(pb + 5);
#define MOE_GU_SCHED(S) pg8::MoeSched<true> S; S.Ab = (const bf16_t*)(ws + WS_HB); S.Wb = (const bf16_t*)(ws + WS_WGU) + (size_t)l * NEXP * 1024 * DM; S.idx = (const int*)(ws + WS_IDX); \
            S.tstart = F.lc + LC_TSTART; S.ecnt = F.lc + LC_ECNT; S.K = DM
#define MOE_DN_SCHED(S) pg8::MoeSched<false> S; S.Ab = (const bf16_t*)(ws + WS_YB); S.Wb = (const bf16_t*)(ws + WS_WD) + (size_t)l * NEXP * DM * DEXP; S.idx = nullptr; \
            S.tstart = F.lc + LC_TSTART; S.ecnt = F.lc + LC_ECNT; S.K = DEXP
        int moe_nu = 0, moe_r = 0; bool moe_split = false;
        if ((IN(pb + 6) && EN(7)) || (IN(pb + 7) && EN(8))) { const Ctx F = make_ctx(wave_s); load_tstart(F, l); moe_nu = __builtin_amdgcn_readfirstlane(F.lc[LC_TSTART + 16]) * 4;
            moe_r = moe_nu - 2 * F.G; moe_split = (MK_MULTI == 0) && (REP_MASK == 0) && moe_r > 0 && 3 * moe_r <= F.G; }
        if (IN(pb + 6) && EN(7)) REP(7) {
            const Ctx F = make_ctx(wave_s); unsigned char* ws = F.ws;
            MOE_GU_SCHED(S); S.base = F.c; S.stride = F.G; S.hi = moe_split ? 2 * F.G : moe_nu;
            pg8::EpiGateUp E{(bf16_t*)(ws + WS_YB)};
            pg8::gemm_phase<pg8::EpiGateUp, pg8::MoeSched<true>>(F.tid, F.lds, DM, S, E);
        } SEAM(pb + 6);
        if (IN(pb + 7) && EN(8)) REP(8) {
            if (!moe_split) {
                const Ctx F = make_ctx(wave_s); unsigned char* ws = F.ws;
                MOE_DN_SCHED(S); S.base = F.c; S.stride = F.G; S.hi = moe_nu;
                pg8::EpiBf16 E{(bf16_t*)(ws + WS_QKV), DM};
                pg8::gemm_phase<pg8::EpiBf16, pg8::MoeSched<false>>(F.tid, F.lds, DEXP, S, E);
            } else {
                { const Ctx F = make_ctx(wave_s); unsigned char* ws = F.ws;
                  MOE_GU_SCHED(S); S.base = 2 * F.G + F.c; S.stride = F.G; S.hi = moe_nu;
                  pg8::EpiGateUp E{(bf16_t*)(ws + WS_YB)};
                  pg8::gemm_phase<pg8::EpiGateUp, pg8::MoeSched<true>>(F.tid, F.lds, DM, S, E); }
                { const Ctx F = make_ctx(wave_s); unsigned char* ws = F.ws;
                  MOE_DN_SCHED(S); S.base = F.c >= moe_r ? 2 * (F.c - moe_r) : 0; S.stride = 1; S.hi = F.c >= moe_r ? S.base + 2 : 0;
                  pg8::EpiBf16 E{(bf16_t*)(ws + WS_QKV), DM};
                  pg8::gemm_phase<pg8::EpiBf16, pg8::MoeSched<false>>(F.tid, F.lds, DEXP, S, E); }
                GRID_BAR();
                { const Ctx F = make_ctx(wave_s); unsigned char* ws = F.ws;
                  MOE_DN_SCHED(S); S.base = 2 * (F.G - moe_r) + F.c; S.stride = F.G; S.hi = moe_nu;
                  pg8::EpiBf16 E{(bf16_t*)(ws + WS_QKV), DM};
                  pg8::gemm_phase<pg8::EpiBf16, pg8::MoeSched<false>>(F.tid, F.lds, DEXP, S, E); }
            }
        } SEAM(pb + 7);
    }
    if (IN(33) && EN(1)) { const Ctx F = make_ctx(wave_s); float* outp = (float*)*(GAS float* const CAS*)((const CAS char*)F.in + 200); phase_a(F, 4, outp); }
#undef IN
#undef SEAM
}

constexpr int NPHASE = 34;
extern "C" void kernel_launch(void* const* d_in, const int* in_sizes, int n_in, void* d_out, int out_size, void* d_ws, size_t ws_size, hipStream_t stream) {
    static int grid = 0;
    if (grid == 0) {
        if (n_in != 25 || out_size != SEQ * DM || ws_size < WS_END) { fprintf(stderr, "kernel_launch: shape mismatch n_in %d out %d ws %zu (need %zu)\n", n_in, out_size, ws_size, (size_t)WS_END); grid = -1; return; }
        int dev = 0, cus = 0, per_cu = 0;
        if (hipGetDevice(&dev) != hipSuccess || hipDeviceGetAttribute(&cus, hipDeviceAttributeMultiprocessorCount, dev) != hipSuccess) { grid = -1; return; }
        if (hipFuncSetAttribute((const void*)mk_fwd, hipFuncAttributeMaxDynamicSharedMemorySize, LDS_BYTES) != hipSuccess) { fprintf(stderr, "kernel_launch: hipFuncSetAttribute failed\n"); grid = -1; return; }
        if (hipOccupancyMaxActiveBlocksPerMultiprocessor(&per_cu, (const void*)mk_fwd, NTHREADS, LDS_BYTES) != hipSuccess || per_cu < 1) { fprintf(stderr, "kernel_launch: occupancy query says %d\n", per_cu); }
        (void)hipGetLastError();
        grid = cus;
    }
    if (grid < 0) return;
    if (hipMemsetAsync((char*)d_ws + WS_CTL, 0, CTL_ZERO_BYTES, stream) != hipSuccess) return;
    Args a{};
    for (int i = 0; i < 25; ++i) a.in[i] = (const float*)d_in[i];
    a.out = (float*)d_out; a.ws = (unsigned char*)d_ws;
#if MK_MULTI
    for (int p = 0; p < NPHASE; ++p) { a.ph_lo = p; a.ph_hi = p + 1; hipLaunchKernelGGL(mk_fwd, dim3(grid), dim3(NTHREADS), LDS_BYTES, stream, a); }
#else
    a.ph_lo = 0; a.ph_hi = NPHASE;
    hipLaunchKernelGGL(mk_fwd, dim3(grid), dim3(NTHREADS), LDS_BYTES, stream, a);
#endif
    const hipError_t le = hipPeekAtLastError();
    if (le != hipSuccess) fprintf(stderr, "kernel_launch: launch failed: %s\n", hipGetErrorName(le));
}
```

```cpp
#include <hip/hip_runtime.h>
#include <cstdio>
#include <cstdint>

#ifndef ATT_F8
#define ATT_F8 1
#endif
#ifndef MK_MULTI
#define MK_MULTI 0
#endif

#define LAS __attribute__((address_space(3)))
#define GAS __attribute__((address_space(1)))
#define CAS __attribute__((address_space(4)))
typedef unsigned short bf16_t;
typedef short bf16x8 __attribute__((ext_vector_type(8)));
typedef short s16x4 __attribute__((ext_vector_type(4)));
typedef float f32x2 __attribute__((ext_vector_type(2)));
typedef float f32x4 __attribute__((ext_vector_type(4)));
typedef float f32x16 __attribute__((ext_vector_type(16)));
typedef unsigned u32x2 __attribute__((ext_vector_type(2)));
typedef unsigned u32x4 __attribute__((ext_vector_type(4)));
typedef int i32x4 __attribute__((ext_vector_type(4)));

constexpr int DM = 1024, SEQ = 16384, NCTX = 256, MROWS = SEQ + NCTX, DEPTH = 4;
constexpr int EVEN_IN = 2304, ODD_IN = 1536;
constexpr int NEXP = 16, DEXP = 512;
constexpr float ALPHA = 1.681792830507429f;
constexpr float LN_EPS = 1e-5f, QK_EPS = 1e-6f, SUBLN_EPS = 1e-5f;
constexpr int NWAVES = 8, NTHREADS = 512;
constexpr int MAXSLOT = 37376;
constexpr float LOG2E = 1.4426950408889634f;

constexpr size_t al256(size_t x) { return (x + 255) / 256 * 256; }
constexpr size_t WS_CTL = 0, CTL_ZERO_BYTES = 1u << 20;
constexpr int CW_BAR = 4096;
constexpr int CW_KMAX = 24576;
constexpr int CW_ATK = 32768;
constexpr int CW_CNT = 16384;
constexpr size_t WS_MODV = CTL_ZERO_BYTES;
constexpr size_t WS_TAB64 = WS_MODV + al256((size_t)4 * 2 * 6144 * 4);
constexpr size_t WS_TAB128 = WS_TAB64 + al256((size_t)256 * 16 * 2 * 4);
constexpr size_t WS_LAM = WS_TAB128 + al256((size_t)256 * 32 * 2 * 4);
constexpr size_t WS_ROUTE = WS_LAM + 256;
constexpr size_t WS_IDX = WS_ROUTE + al256((size_t)MROWS * 16);
constexpr size_t WS_WINE = al256(WS_IDX + (size_t)NEXP * MROWS * 4);
constexpr size_t WS_WINO = WS_WINE + (size_t)2 * EVEN_IN * DM * 2;
constexpr size_t WS_WOUT = WS_WINO + (size_t)2 * ODD_IN * DM * 2;
constexpr size_t WS_WGU = WS_WOUT + (size_t)4 * DM * DM * 2;
constexpr size_t WS_WD = WS_WGU + (size_t)4 * NEXP * 1024 * DM * 2;
constexpr size_t WS_XB = WS_WD + (size_t)4 * NEXP * DM * DEXP * 2;
constexpr size_t WS_X1B = WS_XB + (size_t)MROWS * DM * 4;
constexpr size_t WS_HB = WS_X1B + (size_t)MROWS * DM * 4;
constexpr size_t WS_QKV = WS_HB + (size_t)MROWS * DM * 2;
constexpr size_t WS_OB = WS_QKV + (size_t)MROWS * EVEN_IN * 2;
constexpr size_t WS_YB = WS_OB + (size_t)MROWS * DM * 2;
constexpr int NTILE = MROWS / 64;
constexpr size_t WS_KF8 = WS_YB + (size_t)MROWS * DM * 4;
constexpr size_t WS_VF8 = WS_KF8 + (size_t)8 * NTILE * 4096;
constexpr size_t WS_END = WS_VF8 + (size_t)4 * NTILE * 8192;
static_assert((size_t)MAXSLOT * DM * 2 <= (size_t)MROWS * EVEN_IN * 2, "moe out fits qkv region");
static_assert((size_t)MAXSLOT * DEXP * 2 <= (size_t)MROWS * DM * 4, "A2 fits y region");

constexpr int RING_BYTES = 131072;
constexpr int LDSCTL_OFF = RING_BYTES;
constexpr int LC_BAR = 0;
constexpr int LC_TSTART = 16;
constexpr int LC_ECNT = 40;
constexpr int LC_LCNT = 56;
constexpr int LC_GBASE = 72;
constexpr int LC_WTAB = 96;
constexpr int LC_KMAX = 1120;
constexpr int LC_TK = 1140;
constexpr int LDS_BYTES = 147456;
static_assert(LDSCTL_OFF + (LC_KMAX + 16) * 4 <= 139264 && 139264 + 8192 <= LDS_BYTES, "LDS map");

__device__ __forceinline__ unsigned cvt_pk_bf16(float lo, float hi) { unsigned r; asm volatile("v_cvt_pk_bf16_f32 %0, %1, %2" : "=v"(r) : "v"(lo), "v"(hi)); return r; }
__device__ __forceinline__ float bf_lo(unsigned w) { return __uint_as_float(w << 16); }
__device__ __forceinline__ float bf_hi(unsigned w) { return __uint_as_float(w & 0xffff0000u); }
template <int CTRL> __device__ __forceinline__ float dpp_mov(float v) { return __builtin_bit_cast(float, __builtin_amdgcn_update_dpp(0, __builtin_bit_cast(int, v), CTRL, 0xF, 0xF, true)); }
__device__ __forceinline__ float xor1_add(float v) { return v + dpp_mov<0xB1>(v); }
__device__ __forceinline__ float xor2_add(float v) { return v + dpp_mov<0x4E>(v); }
__device__ __forceinline__ float half8_add(float v) { return v + dpp_mov<0x141>(v); }
__device__ __forceinline__ float row16_add(float v) { return v + dpp_mov<0x140>(v); }
__device__ __forceinline__ float rows32_add(float v) { auto r = __builtin_amdgcn_permlane16_swap(__float_as_uint(v), __float_as_uint(v), false, false); return __uint_as_float(r[0]) + __uint_as_float(r[1]); }
__device__ __forceinline__ float rows64_add(float v) { auto r = __builtin_amdgcn_permlane32_swap(__float_as_uint(v), __float_as_uint(v), false, false); return __uint_as_float(r[0]) + __uint_as_float(r[1]); }
__device__ __forceinline__ float wave_sum(float v) { return rows64_add(rows32_add(row16_add(half8_add(xor2_add(xor1_add(v)))))); }
#define LDS_WAIT() asm volatile("s_waitcnt lgkmcnt(0)" ::: "memory")
#define VM_WAIT() asm volatile("s_waitcnt vmcnt(0)" ::: "memory")
#define RLX_AGENT __ATOMIC_RELAXED, __HIP_MEMORY_SCOPE_AGENT

#define XB_TMO      128
#define XB_XCNT(j)  (256  + 64 * (j))
#define XB_XSUB(j)  (1280 + 64 * (j))
#define XB_XGEN(j)  (2304 + 64 * (j))
#define XB_TOP      3328
#define XB_TOPGEN   3392
#define XCD_BAR_WORDS 3456
#define XB_SPIN_CAP (1u << 18)
__device__ __forceinline__ unsigned xb_ld(unsigned* p)              { return __hip_atomic_load(p, __ATOMIC_RELAXED, __HIP_MEMORY_SCOPE_AGENT); }
__device__ __forceinline__ unsigned xb_add(unsigned* p, unsigned v) { return __hip_atomic_fetch_add(p, v, __ATOMIC_RELAXED, __HIP_MEMORY_SCOPE_AGENT); }
__device__ __forceinline__ unsigned xb_xcc_id() { return (unsigned)__builtin_amdgcn_s_getreg((3 << 11) | 20) & 0xFu; }
#define XB_SPIN(cond, bar) do { unsigned _sp = 0; while (cond) { __builtin_amdgcn_s_sleep(1); \
    if ((++_sp & 255u) == 0u) { if (xb_ld(&(bar)[XB_TMO])) break; if (_sp > XB_SPIN_CAP) { atomicAdd(&(bar)[XB_TMO], 1u); break; } } } } while (0)
struct XcdBarrier { unsigned* bar; unsigned x; volatile LAS unsigned* st; };
__device__ __forceinline__ XcdBarrier xcd_barrier_post(unsigned* bar, volatile LAS unsigned* st, bool is_t0) {
    XcdBarrier b; b.bar = bar; b.x = xb_xcc_id(); b.st = st;
    if (is_t0) (void)xb_add(&bar[XB_XCNT(b.x)], 1u);
    return b;
}
__device__ __forceinline__ void xcd_barrier_complete(unsigned* bar, unsigned x, unsigned& nloc, unsigned& nx) {
    const unsigned G = gridDim.x * gridDim.y * gridDim.z;
    unsigned sum, cnt, mine, sp = 0u;
    for (;;) {
        sum = 0u; cnt = 0u; mine = 0u;
#pragma unroll
        for (unsigned j = 0; j < 16; ++j) { const unsigned c = xb_ld(&bar[XB_XCNT(j)]); sum += c; cnt += (c > 0u) ? 1u : 0u; mine = (j == x) ? c : mine; }
        if (sum == G) break;
        __builtin_amdgcn_s_sleep(1);
        if ((++sp & 255u) == 0u) { if (xb_ld(&bar[XB_TMO])) break; if (sp > XB_SPIN_CAP) { atomicAdd(&bar[XB_TMO], 1u); break; } }
    }
    nloc = mine > 0u ? mine : 1u; nx = cnt > 0u ? cnt : 1u;
}
__device__ __forceinline__ void xcd_barrier(const XcdBarrier& b, bool is_t0) {
    asm volatile("s_waitcnt vmcnt(0)" ::: "memory");
    __syncthreads();
    if (is_t0) {
        unsigned* bar = b.bar;
        __builtin_amdgcn_s_waitcnt(0);
        unsigned nloc = b.st[0], nx = b.st[1];
        if (nloc == 0u) { xcd_barrier_complete(bar, b.x, nloc, nx); b.st[0] = nloc; b.st[1] = nx; }
        const unsigned old = xb_add(&bar[XB_XSUB(b.x)], 1u);
        const unsigned gen = old / nloc;
        if (old + 1u == (gen + 1u) * nloc) {
            __builtin_amdgcn_fence(__ATOMIC_RELEASE, "agent");
            asm volatile("s_waitcnt vmcnt(0)" ::: "memory");
            const unsigned og = xb_add(&bar[XB_TOP], 1u);
            const unsigned tg = og / nx;
            if (og + 1u == (tg + 1u) * nx) xb_add(&bar[XB_TOPGEN], 1u);
            else XB_SPIN(xb_ld(&bar[XB_TOPGEN]) == tg, bar);
            __builtin_amdgcn_fence(__ATOMIC_ACQUIRE, "agent");
            xb_add(&bar[XB_XGEN(b.x)], 1u);
            asm volatile("s_waitcnt vmcnt(0)" ::: "memory");
        } else {
            XB_SPIN(xb_ld(&bar[XB_XGEN(b.x)]) == gen, bar);
            __builtin_amdgcn_fence(__ATOMIC_ACQUIRE, "agent");
            asm volatile("s_waitcnt vmcnt(0)" ::: "memory");
        }
    }
    __syncthreads();
}

namespace pg8 {
constexpr int BM = 256, BK = 64, HALF = 128, HTB = HALF * BK * 2, NXCD = 8, WGM = 8;
constexpr int NV_OFF = 139264;
__host__ __device__ __forceinline__ int lds_byte(int r, int c) { const int st = (r >> 4) * 2 + (c >> 5), rr = r & 15, cc = c & 31, ob = rr * 64 + cc * 2; return st * 1024 + (ob ^ (((ob >> 9) & 1) << 5)); }
__host__ __device__ __forceinline__ void stage_rc(int b, int& R, int& C) { const int st = b / 1024, sb = b % 1024, swz = sb ^ (((sb >> 9) & 1) << 5); R = (st >> 1) * 16 + swz / 64; C = (st & 1) * 32 + (swz % 64) / 2; }
__host__ __device__ __forceinline__ int perm32(int rho) { const int n = rho >> 4, i = rho & 15; return 8 * (i >> 2) + 4 * n + (i & 3); }

struct Unit { int pm, pn, e, lrow; };

struct DenseSched {
    static constexpr bool GATHER = false;
    const bf16_t* A; const bf16_t* Bt; int K, nM, nN, nwg, G, c, pm_lo;
    __device__ void init(const bf16_t* A_, const bf16_t* Bt_, int K_, int pm_lo_, int nM_, int N, int G_, int c_) { A = A_; Bt = Bt_; K = K_; pm_lo = pm_lo_; nM = nM_; nN = N / BM; nwg = nM * nN; G = G_; c = c_; }
    __device__ __forceinline__ bool next(int i, Unit& u) const {
        const long L = (long)i * G + c; if (L >= nwg) return false;
        int wgid = (int)L; { const int q = nwg / NXCD, r = nwg % NXCD, xcd = wgid % NXCD, off = wgid / NXCD; wgid = (xcd < r ? xcd * (q + 1) : r * (q + 1) + (xcd - r) * q) + off; }
        const int nig = WGM * nN, gid = wgid / nig, fm = gid * WGM, gsz = (nM - fm) < WGM ? (nM - fm) : WGM;
        u.pm = pm_lo + fm + ((wgid % nig) % gsz); u.pn = (wgid % nig) / gsz; u.e = 0; u.lrow = 0; return true;
    }
    __device__ __forceinline__ const char* a_base(const Unit& u) const { return (const char*)A + (size_t)u.pm * BM * K * 2; }
    __device__ __forceinline__ const char* b_base(const Unit& u) const { return (const char*)Bt + (size_t)u.pn * BM * K * 2; }
    __device__ __forceinline__ void voffs(const Unit&, const int (&R)[2], const int (&C)[2], unsigned (&v0)[2], unsigned (&v1)[2]) const {
#pragma unroll
        for (int i = 0; i < 2; ++i) { v0[i] = (unsigned)(R[i] * K + C[i]) * 2u; v1[i] = v0[i] + (unsigned)(HALF * K) * 2u; }
    }
};
template <bool GATHER_> struct MoeSched {
    static constexpr bool GATHER = GATHER_;
    const bf16_t* Ab; const bf16_t* Wb; const int* idx; const LAS int* tstart; const LAS int* ecnt; int K, base, stride, hi;
    __device__ __forceinline__ bool next(int i, Unit& u) const {
        const int L = base + i * stride; if (L >= hi) return false;
        const int tile = L >> 2; u.pn = L & 3; u.pm = tile;
        int e = 0;
#pragma unroll
        for (int k = 1; k < 16; ++k) e += (tile >= tstart[k]) ? 1 : 0;
        e = __builtin_amdgcn_readfirstlane(e);
        u.e = e; u.lrow = __builtin_amdgcn_readfirstlane((tile - tstart[e]) * 256); return true;
    }
    __device__ __forceinline__ const char* a_base(const Unit& u) const { return GATHER ? (const char*)Ab : (const char*)Ab + (size_t)u.pm * BM * K * 2; }
    __device__ __forceinline__ const char* b_base(const Unit& u) const { return (const char*)Wb + ((size_t)u.e * 1024 + (size_t)u.pn * BM) * K * 2; }
    __device__ __forceinline__ void voffs(const Unit& u, const int (&R)[2], const int (&C)[2], unsigned (&v0)[2], unsigned (&v1)[2]) const {
        if constexpr (GATHER) {
            const int n = ecnt[u.e];
#pragma unroll
            for (int i = 0; i < 2; ++i) {
                const int p0 = u.lrow + R[i], p1 = p0 + HALF;
                const int t0 = p0 < n ? idx[u.e * MROWS + p0] : 0, t1 = p1 < n ? idx[u.e * MROWS + p1] : 0;
                v0[i] = (unsigned)(t0 * K + C[i]) * 2u; v1[i] = (unsigned)(t1 * K + C[i]) * 2u; }
        } else {
#pragma unroll
            for (int i = 0; i < 2; ++i) { v0[i] = (unsigned)(R[i] * K + C[i]) * 2u; v1[i] = v0[i] + (unsigned)(HALF * K) * 2u; }
        }
    }
};

struct EpiF32 {
    static constexpr bool PERM = false;
    float* C; int ldc;
    __device__ __forceinline__ void operator()(const f32x4 (&acc)[2][2][4][2], const Unit& u, int wr, int wc, int fr, int fq) const {
        const int row0 = u.pm * BM + wr * 64 + fr, col0 = u.pn * BM + wc * 32 + 4 * fq;
#pragma unroll
        for (int ai = 0; ai < 2; ++ai)
#pragma unroll
            for (int m = 0; m < 4; ++m) { float* rowp = C + (size_t)(row0 + ai * HALF + m * 16) * ldc + col0;
#pragma unroll
                for (int bj = 0; bj < 2; ++bj)
#pragma unroll
                    for (int n = 0; n < 2; ++n) *(f32x4*)(rowp + bj * HALF + n * 16) = acc[ai][bj][m][n]; }
    }
};
struct EpiBf16 {
    static constexpr bool PERM = true;
    bf16_t* O; int ldc;
    __device__ __forceinline__ void operator()(const f32x4 (&acc)[2][2][4][2], const Unit& u, int wr, int wc, int fr, int fq) const {
        const int row0 = u.pm * BM + wr * 64 + fr, col0 = u.pn * BM + wc * 32 + 8 * fq;
#pragma unroll
        for (int ai = 0; ai < 2; ++ai)
#pragma unroll
            for (int m = 0; m < 4; ++m) { bf16_t* rowp = O + (size_t)(row0 + ai * HALF + m * 16) * ldc + col0;
#pragma unroll
                for (int bj = 0; bj < 2; ++bj) { const f32x4 v0 = acc[ai][bj][m][0], v1 = acc[ai][bj][m][1];
                    u32x4 w; w.x = cvt_pk_bf16(v0[0], v0[1]); w.y = cvt_pk_bf16(v0[2], v0[3]); w.z = cvt_pk_bf16(v1[0], v1[1]); w.w = cvt_pk_bf16(v1[2], v1[3]);
                    *(u32x4*)(rowp + bj * HALF) = w; } }
    }
};
struct EpiGateUp {
    static constexpr bool PERM = true;
    bf16_t* O;
    __device__ __forceinline__ void operator()(const f32x4 (&acc)[2][2][4][2], const Unit& u, int wr, int wc, int fr, int fq) const {
        const int row0 = u.pm * BM + wr * 64 + fr, col0 = u.pn * BM + wc * 32 + 8 * fq;
#pragma unroll
        for (int ai = 0; ai < 2; ++ai)
#pragma unroll
            for (int m = 0; m < 4; ++m) { bf16_t* rowp = O + (size_t)(row0 + ai * HALF + m * 16) * DEXP;
#pragma unroll
                for (int bj = 0; bj < 2; ++bj) { const f32x4 g = acc[ai][bj][m][0], uu = acc[ai][bj][m][1]; float a[4];
#pragma unroll
                    for (int k = 0; k < 4; ++k) { const float s = __builtin_amdgcn_rcpf(1.f + __builtin_amdgcn_exp2f(-g[k] * LOG2E)); a[k] = g[k] * s * uu[k]; }
                    u32x2 w; w.x = cvt_pk_bf16(a[0], a[1]); w.y = cvt_pk_bf16(a[2], a[3]);
                    *(u32x2*)(rowp + ((col0 + bj * HALF) >> 1)) = w; } }
    }
};

template <class Epi, class Sched>
__device__ __forceinline__ void gemm_phase(const int tid, LAS unsigned char* lds, const int K, const Sched& S, const Epi& E) {
    const int wid = __builtin_amdgcn_readfirstlane(tid >> 6), lane = tid & 63, wr = wid >> 2, wc = wid & 3, fr = lane & 15, fq = lane >> 4;
    const int nt = K / BK;
    int Ra[2], Ca[2]; unsigned voffB[2];
#pragma unroll
    for (int i = 0; i < 2; ++i) { int R, C; stage_rc(tid * 16 + i * 8192, R, C); Ra[i] = R; Ca[i] = C; const int Rb = Epi::PERM ? ((R & ~31) + perm32(R & 31)) : R;
        voffB[i] = (unsigned)(Rb * K + C) * 2u; }
    const size_t kstep = (size_t)(BK * 2);
    const size_t hstep = (size_t)HALF * K * 2;
    const unsigned ldsw = (unsigned)wid * 1024u;
    const int aoff = lds_byte(wr * 64 + fr, fq * 8), boff = lds_byte(wc * 32 + fr, fq * 8);
#define PG8_SA(b, h) (((b) * 2 + (h)) * HTB)
#define PG8_SB(b, h) ((4 + (b) * 2 + (h)) * HTB)
#define PG8_STAGE(bufoff, gbase, voff) do { _Pragma("unroll") for (int _i = 0; _i < 2; ++_i) \
        __builtin_amdgcn_global_load_lds((const unsigned*)((const char*)(gbase) + (voff)[_i]), (LAS unsigned*)(lds + (bufoff) + ldsw + _i * 8192), 16, 0, 0); } while (0)
#define PG8_LDA(dst, b, h) do { _Pragma("unroll") for (int m = 0; m < 4; ++m) _Pragma("unroll") for (int k = 0; k < 2; ++k) dst[m][k] = *(const LAS bf16x8*)(lds + PG8_SA(b, h) + aoff + m * 2048 + k * 1024); } while (0)
#define PG8_LDB(dst, b, h) do { _Pragma("unroll") for (int n = 0; n < 2; ++n) _Pragma("unroll") for (int k = 0; k < 2; ++k) dst[n][k] = *(const LAS bf16x8*)(lds + PG8_SB(b, h) + boff + n * 2048 + k * 1024); } while (0)
#define PG8_MMA(ai, bj, At, Bt) do { __builtin_amdgcn_s_setprio(1); _Pragma("unroll") for (int m = 0; m < 4; ++m) _Pragma("unroll") for (int n = 0; n < 2; ++n) _Pragma("unroll") for (int k = 0; k < 2; ++k) \
        acc[ai][bj][m][n] = __builtin_amdgcn_mfma_f32_16x16x32_bf16(Bt[n][k], At[m][k], acc[ai][bj][m][n], 0, 0, 0); __builtin_amdgcn_s_setprio(0); } while (0)
#define PG8_WAIT_V(n) asm volatile("s_waitcnt vmcnt(" #n ")" ::: "memory")
#define PG8_WAIT_L(n) asm volatile("s_waitcnt lgkmcnt(" #n ")" ::: "memory")
#define PG8_BAR __builtin_amdgcn_s_barrier()
#define PG8_SCHED __builtin_amdgcn_sched_barrier(0)
    Unit cur, nxt; int ui = 0;
    if (!S.next(0, cur)) return;
    f32x4 acc[2][2][4][2];
#pragma unroll
    for (int a = 0; a < 2; ++a)
#pragma unroll
        for (int b = 0; b < 2; ++b)
#pragma unroll
            for (int m = 0; m < 4; ++m)
#pragma unroll
                for (int n = 0; n < 2; ++n) acc[a][b][m][n] = (f32x4){0.f, 0.f, 0.f, 0.f};
    bf16x8 At[4][2], B0[2][2], B1[2][2];
    const char* cA = S.a_base(cur); const char* cB = S.b_base(cur);
    unsigned cv0[2], cv1[2], sv0[2], sv1[2];
    S.voffs(cur, Ra, Ca, cv0, cv1);
#define PG8_STAGE_A(bufoff, gbase, half, sel) do { if constexpr (Sched::GATHER) { if (half) { if (sel) PG8_STAGE(bufoff, gbase, sv1); else PG8_STAGE(bufoff, gbase, cv1); } else { if (sel) PG8_STAGE(bufoff, gbase, sv0); else PG8_STAGE(bufoff, gbase, cv0); } } \
        else PG8_STAGE(bufoff, (gbase) + (half) * hstep, cv0); } while (0)
    PG8_STAGE(PG8_SB(0, 0), cB, voffB); PG8_STAGE(PG8_SB(0, 1), cB + hstep, voffB); PG8_STAGE_A(PG8_SA(0, 0), cA, 0, 0); PG8_STAGE_A(PG8_SA(0, 1), cA, 1, 0);
    if (wr == 1) PG8_BAR;
    PG8_WAIT_V(2); PG8_BAR;
    PG8_STAGE(PG8_SB(1, 0), cB + kstep, voffB); PG8_STAGE_A(PG8_SA(1, 0), cA + kstep, 0, 0); PG8_STAGE(PG8_SB(1, 1), cB + hstep + kstep, voffB);
    PG8_WAIT_V(6); PG8_BAR;
    for (;;) {
        const bool has_next = S.next(ui + 1, nxt);
        const char* nA = cA; const char* nB = cB;
        if (has_next) { nA = S.a_base(nxt); nB = S.b_base(nxt); }
        if constexpr (Sched::GATHER) {
            u32x4 q = {cv0[0], cv0[1], cv1[0], cv1[1]};
            if (has_next) { unsigned t0[2], t1[2]; S.voffs(nxt, Ra, Ca, t0, t1); q = (u32x4){t0[0], t0[1], t1[0], t1[1]}; }
            *(LAS u32x4*)(lds + NV_OFF + tid * 16) = q;
        }
        for (int t = 0; t < nt; t += 2) {
            const bool last = (t == nt - 2);
            const char* a1 = cA + (size_t)(t + 1) * kstep;
            const char* a2 = last ? nA : cA + (size_t)(t + 2) * kstep; const char* b2 = last ? nB : cB + (size_t)(t + 2) * kstep;
            const char* a3 = a2 + kstep; const char* b3 = b2 + kstep;
            if constexpr (Sched::GATHER) {
                sv0[0] = cv0[0]; sv0[1] = cv0[1]; sv1[0] = cv1[0]; sv1[1] = cv1[1];
                if (last) { const u32x4 q = *(const LAS u32x4*)(lds + NV_OFF + tid * 16); sv0[0] = q.x; sv0[1] = q.y; sv1[0] = q.z; sv1[1] = q.w; }
            }
            PG8_LDB(B0, 0, 0); PG8_LDB(B1, 0, 1); PG8_SCHED; PG8_LDA(At, 0, 0); PG8_STAGE_A(PG8_SA(1, 1), a1, 1, 0);
            PG8_WAIT_V(8); PG8_WAIT_L(0); PG8_BAR; PG8_MMA(0, 0, At, B0); PG8_MMA(0, 1, At, B1); PG8_BAR; PG8_SCHED;
            PG8_LDA(At, 0, 1); PG8_STAGE(PG8_SB(0, 0), b2, voffB); PG8_STAGE(PG8_SB(0, 1), b2 + hstep, voffB); PG8_STAGE_A(PG8_SA(0, 0), a2, 0, 1);
            PG8_WAIT_V(8); PG8_WAIT_L(0); PG8_BAR; PG8_MMA(1, 0, At, B0); PG8_MMA(1, 1, At, B1); PG8_BAR; PG8_SCHED;
            PG8_LDB(B0, 1, 0); PG8_LDB(B1, 1, 1); PG8_SCHED; PG8_LDA(At, 1, 0); PG8_STAGE_A(PG8_SA(0, 1), a2, 1, 1);
            PG8_WAIT_V(8); PG8_WAIT_L(0); PG8_BAR; PG8_MMA(0, 0, At, B0); PG8_MMA(0, 1, At, B1); PG8_BAR; PG8_SCHED;
            PG8_LDA(At, 1, 1); PG8_STAGE(PG8_SB(1, 0), b3, voffB); PG8_STAGE(PG8_SB(1, 1), b3 + hstep, voffB); PG8_STAGE_A(PG8_SA(1, 0), a3, 0, 1);
            PG8_WAIT_V(8); PG8_WAIT_L(0); PG8_BAR; PG8_MMA(1, 0, At, B0); PG8_MMA(1, 1, At, B1); PG8_BAR; PG8_SCHED;
        }
        if (wr == 0) PG8_BAR;
        E(acc, cur, wr, wc, fr, fq);
        if (!has_next) break;
#pragma unroll
        for (int a = 0; a < 2; ++a)
#pragma unroll
            for (int b = 0; b < 2; ++b)
#pragma unroll
                for (int m = 0; m < 4; ++m)
#pragma unroll
                    for (int n = 0; n < 2; ++n) acc[a][b][m][n] = (f32x4){0.f, 0.f, 0.f, 0.f};
        cur = nxt; cA = nA; cB = nB; ++ui;
        if constexpr (Sched::GATHER) { cv0[0] = sv0[0]; cv0[1] = sv0[1]; cv1[0] = sv1[0]; cv1[1] = sv1[1]; }
        if (wr == 1) PG8_BAR;
    }
    PG8_WAIT_V(0);
    PG8_BAR;
#undef PG8_SA
#undef PG8_SB
#undef PG8_STAGE
#undef PG8_STAGE_A
#undef PG8_LDA
#undef PG8_LDB
#undef PG8_MMA
#undef PG8_WAIT_V
#undef PG8_WAIT_L
#undef PG8_BAR
#undef PG8_SCHED
}
}

namespace att {
constexpr int NW = 8, QBLK = 32, KVBLK = 64;
constexpr int SHM_V = 16384, SHM_K = 16384;
constexpr int SHM_ATTN = 2 * SHM_V + 2 * SHM_K + NW * 64 * 4;
constexpr float THR = 8.f;
#define SBAR() __builtin_amdgcn_sched_barrier(0)
__device__ __forceinline__ int crow(int r, int hi) { return (r & 3) + 8 * (r >> 2) + 4 * hi; }
__device__ __forceinline__ unsigned cvtpk(float lo, float hi) { unsigned r; asm volatile("v_cvt_pk_bf16_f32 %0, %1, %2" : "=v"(r) : "v"(lo), "v"(hi)); return r; }
template <int DQK> __device__ __forceinline__ int kswz(int row, int colB) {
    if constexpr (DQK == 128) return row * 256 + (colB ^ ((row & 7) << 4));
    else return row * 128 + (colB ^ (((row >> 1) & 7) << 4));
}
template <int DQK> __device__ __forceinline__ void partialSM(f32x16& p0, f32x16& p1, float& m_reg, float& mn, float& alpha) {
    constexpr float SCALE = (DQK == 128) ? 0.088388347648318440f : 0.125f;
    constexpr float C = SCALE * LOG2E;
    float pmax = p0[0];
#pragma unroll
    for (int r = 1; r < 16; ++r) pmax = fmaxf(pmax, p0[r]);
#pragma unroll
    for (int r = 0; r < 16; ++r) pmax = fmaxf(pmax, p1[r]);
    { auto rr = __builtin_amdgcn_permlane32_swap(__float_as_uint(pmax), __float_as_uint(pmax), false, false);
      pmax = fmaxf(__uint_as_float(rr[0]), __uint_as_float(rr[1])); }
    if (__builtin_expect(__all(pmax - m_reg <= THR / SCALE), 1)) { mn = m_reg; alpha = 1.f; }
    else { mn = fmaxf(m_reg, pmax); alpha = __builtin_amdgcn_exp2f((m_reg - mn) * C); m_reg = mn; }
    const float mnC = -mn * C;
#pragma unroll
    for (int r = 0; r < 16; ++r) p0[r] = fmaf(p0[r], C, mnC);
#pragma unroll
    for (int r = 0; r < 16; ++r) p1[r] = fmaf(p1[r], C, mnC);
#pragma unroll
    for (int r = 0; r < 16; ++r) p0[r] = __builtin_amdgcn_exp2f(p0[r]);
}
__device__ __forceinline__ void finishSM(f32x16& p0, f32x16& p1, float alpha, float& l_reg, bf16x8& pa0, bf16x8& pa1, bf16x8& pa2, bf16x8& pa3) {
#pragma unroll
    for (int r = 0; r < 16; ++r) p1[r] = __builtin_amdgcn_exp2f(p1[r]);
    float ps = 0;
#pragma unroll
    for (int r = 0; r < 16; ++r) ps += p0[r];
#pragma unroll
    for (int r = 0; r < 16; ++r) ps += p1[r];
    { auto rr = __builtin_amdgcn_permlane32_swap(__float_as_uint(ps), __float_as_uint(ps), false, false);
      ps = __uint_as_float(rr[0]) + __uint_as_float(rr[1]); }
    l_reg = l_reg * alpha + ps;
#define PK4(P, BASE, OUT) do { unsigned a0 = cvtpk(P[BASE + 0], P[BASE + 1]), a1 = cvtpk(P[BASE + 2], P[BASE + 3]);   \
    unsigned b0 = cvtpk(P[BASE + 4], P[BASE + 5]), b1 = cvtpk(P[BASE + 6], P[BASE + 7]);                              \
    auto r0 = __builtin_amdgcn_permlane32_swap(a0, b0, false, false); auto r1 = __builtin_amdgcn_permlane32_swap(a1, b1, false, false); \
    u32x4 w = {r0[0], r1[0], r0[1], r1[1]}; OUT = *reinterpret_cast<bf16x8*>(&w); } while (0)
    PK4(p0, 0, pa0); PK4(p0, 8, pa1); PK4(p1, 0, pa2); PK4(p1, 8, pa3);
#undef PK4
}
template <int DQK> __device__ __forceinline__ void qkt(f32x16& p0, f32x16& p1, const char* Ks, const bf16x8* qr, int r32, int hi) {
    p0 = f32x16{}; p1 = f32x16{};
#pragma unroll
    for (int d0 = 0; d0 < DQK / 16; ++d0) { const int cb = (d0 * 16 + hi * 8) * 2;
        bf16x8 b0 = *reinterpret_cast<const bf16x8*>(Ks + kswz<DQK>(r32, cb));
        bf16x8 b1 = *reinterpret_cast<const bf16x8*>(Ks + kswz<DQK>(32 + r32, cb));
        p0 = __builtin_amdgcn_mfma_f32_32x32x16_bf16(b0, qr[d0], p0, 0, 0, 0);
        p1 = __builtin_amdgcn_mfma_f32_32x32x16_bf16(b1, qr[d0], p1, 0, 0, 0); }
}
__device__ __forceinline__ void wmask(f32x16& p0, f32x16& p1, int k0, int q0lat, int qrel, int hi) {
    const int dbase = k0 - 384 - qrel, pbase = q0lat + k0 - 384;
#pragma unroll
    for (int r = 0; r < 16; ++r) {
        const int kk = crow(r, hi);
        { const int d = dbase + kk, kp = pbase + kk; const bool ok = (d >= -128) && (d <= 128) && (kp >= 0) && (kp < SEQ); p0[r] = ok ? p0[r] : -1e30f; }
        { const int d = dbase + kk + 32, kp = pbase + kk + 32; const bool ok = (d >= -128) && (d <= 128) && (kp >= 0) && (kp < SEQ); p1[r] = ok ? p1[r] : -1e30f; }
    }
}
template <int NCB> __device__ __forceinline__ int v_st(int k, int c) { const int kk = (k & ~0xC) | ((k & 4) << 1) | ((k & 8) >> 1); return ((kk >> 3) * NCB + (c >> 5)) * 512 + ((kk & 7) * 32 + (c & 31)) * 2; }
__device__ __forceinline__ int v_rd_base(int lane) { return ((lane & 3) << 3) | (((lane >> 2) & 3) << 6) | (((lane >> 4) & 1) << 5) | (((lane >> 5) & 1) << 8); }
template <int NCB> constexpr int v_rd_off(int d0, int ks, int half) { return d0 * 512 + ks * (1024 * NCB) + half * (512 * NCB); }
template <int OFF> __device__ __forceinline__ s16x4 tr_read(int vb) {
    s16x4 r; asm volatile("ds_read_b64_tr_b16 %0, %1 offset:%2" : "=&v"(r) : "v"(vb), "i"(OFF) : "memory"); return r;
}
template <int NCB, int D0> __device__ __forceinline__ void pv_one(f32x16& od, int vb, bf16x8 pa0, bf16x8 pa1, bf16x8 pa2, bf16x8 pa3) {
    const s16x4 l0 = tr_read<v_rd_off<NCB>(D0, 0, 0)>(vb), h0 = tr_read<v_rd_off<NCB>(D0, 0, 1)>(vb), l1 = tr_read<v_rd_off<NCB>(D0, 1, 0)>(vb), h1 = tr_read<v_rd_off<NCB>(D0, 1, 1)>(vb);
    const s16x4 l2 = tr_read<v_rd_off<NCB>(D0, 2, 0)>(vb), h2 = tr_read<v_rd_off<NCB>(D0, 2, 1)>(vb), l3 = tr_read<v_rd_off<NCB>(D0, 3, 0)>(vb), h3 = tr_read<v_rd_off<NCB>(D0, 3, 1)>(vb);
    asm volatile("s_waitcnt lgkmcnt(0)" ::: "memory"); SBAR();
#define PK(L, H) (bf16x8){L[0], L[1], L[2], L[3], H[0], H[1], H[2], H[3]}
    od = __builtin_amdgcn_mfma_f32_32x32x16_bf16(pa0, PK(l0, h0), od, 0, 0, 0);
    od = __builtin_amdgcn_mfma_f32_32x32x16_bf16(pa1, PK(l1, h1), od, 0, 0, 0);
    od = __builtin_amdgcn_mfma_f32_32x32x16_bf16(pa2, PK(l2, h2), od, 0, 0, 0);
    od = __builtin_amdgcn_mfma_f32_32x32x16_bf16(pa3, PK(l3, h3), od, 0, 0, 0);
#undef PK
}
template <int NCB> __device__ __forceinline__ void pv_d0(f32x16* o, int vb, bf16x8 pa0, bf16x8 pa1, bf16x8 pa2, bf16x8 pa3) {
    pv_one<NCB, 0>(o[0], vb, pa0, pa1, pa2, pa3); pv_one<NCB, 1>(o[1], vb, pa0, pa1, pa2, pa3);
    if constexpr (NCB == 4) { pv_one<NCB, 2>(o[2], vb, pa0, pa1, pa2, pa3); pv_one<NCB, 3>(o[3], vb, pa0, pa1, pa2, pa3); }
}


template <int DQK>
__device__ __forceinline__ float prep_q_x(float (&x)[DQK / 16][8], const bf16_t* Qw, const float* g, const float* T, int tpos, int hi) {
    constexpr int NQF = DQK / 16, QUART = DQK / 4, NB2 = NQF / 4;
    float ss = 0.f;
#pragma unroll
    for (int b = 0; b < NQF; ++b) { const bf16x8 v = *reinterpret_cast<const bf16x8*>(Qw + b * 16);
#pragma unroll
        for (int j = 0; j < 8; ++j) { x[b][j] = __uint_as_float(((unsigned)(unsigned short)v[j]) << 16); ss = fmaf(x[b][j], x[b][j], ss); } }
    if (g) {
        { auto rr = __builtin_amdgcn_permlane32_swap(__float_as_uint(ss), __float_as_uint(ss), false, false); ss = __uint_as_float(rr[0]) + __uint_as_float(rr[1]); }
        const float rs = 1.f / sqrtf(ss * (1.f / DQK) + QK_EPS); ss = 0.f;
#pragma unroll
        for (int b = 0; b < NQF; ++b) { const f32x4 g0 = *(const f32x4*)(g + b * 16 + hi * 8), g1 = *(const f32x4*)(g + b * 16 + hi * 8 + 4);
#pragma unroll
            for (int j = 0; j < 8; ++j) { x[b][j] *= rs * (j < 4 ? g0[j & 3] : g1[j & 3]); ss = fmaf(x[b][j], x[b][j], ss); } }
    }
    if (tpos >= 0) {
#pragma unroll
        for (int ty = 0; ty < 2; ++ty) { const int pos = ty ? (tpos & 63) : (tpos >> 6);
#pragma unroll
            for (int bb = 0; bb < NB2; ++bb) { const int b1 = ty * 2 * NB2 + bb, b2 = b1 + NB2; const float* tp = T + (pos * QUART + bb * 16 + hi * 8) * 2;
#pragma unroll
                for (int jj = 0; jj < 4; ++jj) { const f32x4 cs = *(const f32x4*)(tp + 4 * jj);
                    { const float x1 = x[b1][2 * jj], x2 = x[b2][2 * jj]; x[b1][2 * jj] = x1 * cs.x - x2 * cs.y; x[b2][2 * jj] = x1 * cs.y + x2 * cs.x; }
                    { const float x1 = x[b1][2 * jj + 1], x2 = x[b2][2 * jj + 1]; x[b1][2 * jj + 1] = x1 * cs.z - x2 * cs.w; x[b2][2 * jj + 1] = x1 * cs.w + x2 * cs.z; } } } }
    }
    { auto rr = __builtin_amdgcn_permlane32_swap(__float_as_uint(ss), __float_as_uint(ss), false, false); ss = __uint_as_float(rr[0]) + __uint_as_float(rr[1]); }
    return ss;
}
template <int DQK>
__device__ __forceinline__ float prep_q(bf16x8 (&qr)[DQK / 16], const bf16_t* Qw, const float* g, const float* T, int tpos, int hi, float pre) {
    constexpr int NQF = DQK / 16;
    float x[NQF][8];
    const float ss = prep_q_x<DQK>(x, Qw, g, T, tpos, hi);
#pragma unroll
    for (int b = 0; b < NQF; ++b) { u32x4 w;
#pragma unroll
        for (int j = 0; j < 4; ++j) w[j] = cvtpk(x[b][2 * j] * pre, x[b][2 * j + 1] * pre);
        qr[b] = *reinterpret_cast<bf16x8*>(&w); }
    return ss;
}
template <int DQK, int DV, bool WINDOW, int SDEPTH>
__device__ __forceinline__ void attn_core(const int tid, const bf16_t* Qb, int ldq, const bf16_t* Kb, const bf16_t* Vb, int ldk, int seq, int q0lat, float m_init, float l_init, char* lds, f32x16 (&o)[DV / 32], const float* ropeT, int tpos0) {
    constexpr int NCB = DV / 32, NQF = DQK / 16, NKL = DQK / 64, NVL = DV / 64;
    constexpr float SCALE = (DQK == 128) ? 0.088388347648318440f : 0.125f;
    constexpr float C = SCALE * LOG2E;
    const int wid = tid >> 6, lane = tid & 63, r32 = lane & 31, hi = lane >> 5;
    char* V_lds = lds; char* K_lds = lds + 2 * SHM_V;
    float* ws = (float*)(lds + 2 * SHM_V + 2 * SHM_K) + wid * 64; float* li_l = ws; float* al_l = ws + 32;
    float m_reg = m_init, l_reg = l_init; bf16x8 qr[NQF];
#pragma unroll
    for (int d = 0; d < NCB; ++d) o[d] = f32x16{};
    const bf16_t* Qw = Qb + (long)(wid * QBLK + r32) * ldq + hi * 8;
    (void)prep_q<DQK>(qr, Qw, nullptr, ropeT, tpos0 >= 0 ? tpos0 + wid * QBLK + r32 : -1, hi, 1.f);
    int krow[NKL], vrow[NVL], kst[NKL], vst[NVL]; int kcol, vcol;
    if constexpr (DQK == 128) { kcol = (tid & 15) * 8; krow[0] = tid >> 4; krow[1] = 32 + (tid >> 4); } else { kcol = (tid & 7) * 8; krow[0] = tid >> 3; }
    if constexpr (DV == 128) { vcol = (tid & 15) * 8; vrow[0] = tid >> 4; vrow[1] = 32 + (tid >> 4); } else { vcol = (tid & 7) * 8; vrow[0] = tid >> 3; }
#pragma unroll
    for (int i = 0; i < NKL; ++i) kst[i] = kswz<DQK>(krow[i], kcol * 2);
#pragma unroll
    for (int i = 0; i < NVL; ++i) vst[i] = v_st<NCB>(vrow[i], vcol);
    const int vb0 = (int)(uintptr_t)V_lds + v_rd_base(lane);
    struct { bf16x8 v[NVL]; bf16x8 k[NKL]; } sr_[SDEPTH];
    unsigned voffv[NVL], voffk[NKL];
#pragma unroll
    for (int i = 0; i < NVL; ++i) voffv[i] = (unsigned)(vrow[i] * ldk + vcol) * 2u;
#pragma unroll
    for (int i = 0; i < NKL; ++i) voffk[i] = (unsigned)(krow[i] * ldk + kcol) * 2u;
#define TROW(k0) (WINDOW ? (((k0) < 256) ? (k0) : (((q0lat + (k0) - 128) > (MROWS - 64)) ? (MROWS - 64) : (q0lat + (k0) - 128))) : (k0))
#define SLOAD(i, k0) do { const size_t _tb = (size_t)TROW(k0) * (size_t)ldk * 2; const char* _vb = (const char*)Vb + _tb; const char* _kb = (const char*)Kb + _tb; \
    _Pragma("unroll") for (int _j = 0; _j < NVL; ++_j) sr_[i].v[_j] = *reinterpret_cast<const bf16x8*>(_vb + voffv[_j]); \
    _Pragma("unroll") for (int _j = 0; _j < NKL; ++_j) sr_[i].k[_j] = *reinterpret_cast<const bf16x8*>(_kb + voffk[_j]); } while (0)
#define SWRITE(b, i) do { _Pragma("unroll") for (int _j = 0; _j < NVL; ++_j) *(bf16x8*)(V_lds + (b) * SHM_V + vst[_j]) = sr_[i].v[_j]; \
    _Pragma("unroll") for (int _j = 0; _j < NKL; ++_j) *(bf16x8*)(K_lds + (b) * SHM_K + kst[_j]) = sr_[i].k[_j]; } while (0)
#define SWAIT() do { if constexpr (SDEPTH == 1) asm volatile("s_waitcnt vmcnt(0)" ::: "memory"); else if constexpr (NKL + NVL == 4) asm volatile("s_waitcnt vmcnt(4)" ::: "memory"); else if constexpr (NKL + NVL == 3) asm volatile("s_waitcnt vmcnt(3)" ::: "memory"); else asm volatile("s_waitcnt vmcnt(2)" ::: "memory"); } while (0)
#define RESC(a) do { if (__any((a) < 1.f)) { if (hi == 0) al_l[r32] = (a); asm volatile("s_waitcnt lgkmcnt(0)" ::: "memory"); \
    _Pragma("unroll") for (int d = 0; d < NCB; ++d) _Pragma("unroll") for (int r = 0; r < 16; ++r) o[d][r] *= al_l[crow(r, hi)]; } } while (0)
#define WMASK(p0, p1, jt) do { if constexpr (WINDOW) { if ((jt) * KVBLK >= 256) wmask(p0, p1, (jt) * KVBLK, q0lat, wid * QBLK + r32, hi); } } while (0)
    f32x16 pA0, pA1, pB0, pB1; float mnA, mnB, alA, alB; bf16x8 pa0, pa1, pa2, pa3; const int NT = seq / KVBLK;
    constexpr int SE = 0, SO = SDEPTH - 1;
    SLOAD(SE, 0); asm volatile("s_waitcnt vmcnt(0)" ::: "memory"); SWRITE(0, SE); __syncthreads();
    qkt<DQK>(pA0, pA1, K_lds, qr, r32, hi); WMASK(pA0, pA1, 0); partialSM<DQK>(pA0, pA1, m_reg, mnA, alA);
    SLOAD(SO, KVBLK); if constexpr (SDEPTH == 2) { if (2 < NT) SLOAD(SE, 2 * KVBLK); }
    SWAIT(); SWRITE(1, SO); __syncthreads();
    for (int j = 1; j + 1 < NT; j += 2) {
        SBAR(); qkt<DQK>(pB0, pB1, K_lds + SHM_K, qr, r32, hi); WMASK(pB0, pB1, j);
        finishSM(pA0, pA1, alA, l_reg, pa0, pa1, pa2, pa3); SBAR();
        SLOAD(SO, (j + SDEPTH) * KVBLK); SBAR();
        pv_d0<NCB>(o, vb0, pa0, pa1, pa2, pa3); partialSM<DQK>(pB0, pB1, m_reg, mnB, alB);
        __syncthreads(); SWAIT(); SWRITE(0, SE);
        RESC(alB); __syncthreads();
        SBAR(); qkt<DQK>(pA0, pA1, K_lds, qr, r32, hi); WMASK(pA0, pA1, j + 1);
        finishSM(pB0, pB1, alB, l_reg, pa0, pa1, pa2, pa3); SBAR();
        if (SDEPTH == 1 || j + 3 < NT) SLOAD(SE, (j + 1 + SDEPTH) * KVBLK); SBAR();
        pv_d0<NCB>(o, vb0 + SHM_V, pa0, pa1, pa2, pa3); partialSM<DQK>(pA0, pA1, m_reg, mnA, alA);
        __syncthreads(); SWAIT(); SWRITE(1, SO);
        RESC(alA); __syncthreads();
    }
    SBAR(); qkt<DQK>(pB0, pB1, K_lds + SHM_K, qr, r32, hi); WMASK(pB0, pB1, NT - 1);
    finishSM(pA0, pA1, alA, l_reg, pa0, pa1, pa2, pa3); SBAR();
    pv_d0<NCB>(o, vb0, pa0, pa1, pa2, pa3); partialSM<DQK>(pB0, pB1, m_reg, mnB, alB);
    __syncthreads(); RESC(alB);
    finishSM(pB0, pB1, alB, l_reg, pa0, pa1, pa2, pa3); SBAR();
    pv_d0<NCB>(o, vb0 + SHM_V, pa0, pa1, pa2, pa3);
    if (hi == 0) li_l[r32] = l_reg; asm volatile("s_waitcnt lgkmcnt(0)" ::: "memory");
#pragma unroll
    for (int r = 0; r < 16; ++r) { const float rl = __builtin_amdgcn_rcpf(li_l[crow(r, hi)]);
#pragma unroll
        for (int d = 0; d < NCB; ++d) o[d][r] *= rl; }
    __syncthreads();
#undef TROW
#undef SLOAD
#undef SWRITE
#undef SWAIT
#undef RESC
#undef WMASK
}
template <int NCB> __device__ __forceinline__ void store_o_bf16(const int tid, const f32x16 (&o)[NCB], bf16_t* O, int ldo) {
    const int wid = tid >> 6, lane = tid & 63, r32 = lane & 31, hi = lane >> 5;
    bf16_t* Ow = O + (long)(wid * QBLK) * ldo + r32;
#pragma unroll
    for (int r = 0; r < 16; ++r) { const int orow = crow(r, hi);
#pragma unroll
        for (int d = 0; d < NCB; ++d) Ow[(long)orow * ldo + d * 32] = (bf16_t)(cvtpk(o[d][r], 0.f) & 0xffffu); }
}

typedef float f32x2_t __attribute__((ext_vector_type(2)));
typedef __bf16 bf16x2_t __attribute__((ext_vector_type(2)));
typedef short v4i16_t __attribute__((ext_vector_type(4)));
__device__ __forceinline__ unsigned cvtpk_s(float lo, float hi) { f32x2_t v = {lo, hi}; bf16x2_t b = __builtin_convertvector(v, bf16x2_t); return __builtin_bit_cast(unsigned, b); }
__device__ __forceinline__ s16x4 vtr(int addr) { return __builtin_bit_cast(s16x4, __builtin_amdgcn_ds_read_tr16_b64_v4i16((LAS v4i16_t*)(uintptr_t)(unsigned)addr)); }
__device__ __forceinline__ float bfv(short x) { return __uint_as_float(((unsigned)(unsigned short)x) << 16); }
template <int DQK> __device__ __forceinline__ void qkt_init(f32x16& p0, f32x16& p1, float init, const char* Ks, const bf16x8* qr, int r32, int hi) {
#pragma unroll
    for (int r = 0; r < 16; ++r) { p0[r] = init; p1[r] = init; }
#pragma unroll
    for (int d0 = 0; d0 < DQK / 16; ++d0) { const int cb = (d0 * 16 + hi * 8) * 2;
        bf16x8 b0 = *reinterpret_cast<const bf16x8*>(Ks + kswz<DQK>(r32, cb));
        bf16x8 b1 = *reinterpret_cast<const bf16x8*>(Ks + kswz<DQK>(32 + r32, cb));
        p0 = __builtin_amdgcn_mfma_f32_32x32x16_bf16(b0, qr[d0], p0, 0, 0, 0);
        p1 = __builtin_amdgcn_mfma_f32_32x32x16_bf16(b1, qr[d0], p1, 0, 0, 0); }
}
__device__ __forceinline__ void exp_half(f32x16& p) {
#pragma unroll
    for (int r = 0; r < 16; ++r) p[r] = __builtin_amdgcn_exp2f(p[r]);
}
__device__ __forceinline__ void finish_fixed(f32x16& p0, f32x16& p1, float& l_reg, bf16x8& pa0, bf16x8& pa1, bf16x8& pa2, bf16x8& pa3) {
    exp_half(p1);
    float ps = 0;
#pragma unroll
    for (int r = 0; r < 16; ++r) ps += p0[r];
#pragma unroll
    for (int r = 0; r < 16; ++r) ps += p1[r];
    l_reg += ps;
#define PK4(P, BASE, OUT) do { unsigned a0 = cvtpk(P[BASE + 0], P[BASE + 1]), a1 = cvtpk(P[BASE + 2], P[BASE + 3]);   \
    unsigned b0 = cvtpk(P[BASE + 4], P[BASE + 5]), b1 = cvtpk(P[BASE + 6], P[BASE + 7]);                              \
    auto r0 = __builtin_amdgcn_permlane32_swap(a0, b0, false, false); auto r1 = __builtin_amdgcn_permlane32_swap(a1, b1, false, false); \
    u32x4 w = {r0[0], r1[0], r0[1], r1[1]}; OUT = *reinterpret_cast<bf16x8*>(&w); } while (0)
    PK4(p0, 0, pa0); PK4(p0, 8, pa1); PK4(p1, 0, pa2); PK4(p1, 8, pa3);
#undef PK4
}
template <int DQK, int DV, int SDEPTH>
__device__ __forceinline__ void attn_core_fixed(const int tid, const bf16_t* Qb, int ldq, const bf16_t* Kb, const bf16_t* Vb, int ldk, int seq, float kmaxC, char* lds, f32x16 (&o)[DV / 32]) {
    constexpr int NCB = DV / 32, NQF = DQK / 16, NKL = DQK / 64, NVL = DV / 64;
    constexpr float SCALE = (DQK == 128) ? 0.088388347648318440f : 0.125f;
    constexpr float C = SCALE * LOG2E;
    const int wid = tid >> 6, lane = tid & 63, r32 = lane & 31, hi = lane >> 5;
    char* V_lds = lds; char* K_lds = lds + 2 * SHM_V;
    float* li_l = (float*)(lds + 2 * SHM_V + 2 * SHM_K) + wid * 64;
    float l_reg = 0.f; bf16x8 qr[NQF];
#pragma unroll
    for (int d = 0; d < NCB; ++d) o[d] = f32x16{};
    const bf16_t* Qw = Qb + (long)(wid * QBLK + r32) * ldq + hi * 8;
#pragma unroll
    for (int d0 = 0; d0 < NQF; ++d0) qr[d0] = *reinterpret_cast<const bf16x8*>(Qw + d0 * 16);
    float ssq = 0.f;
#pragma unroll
    for (int d0 = 0; d0 < NQF; ++d0) { u32x4 w;
#pragma unroll
        for (int j = 0; j < 4; ++j) { const float a = bfv(qr[d0][2 * j]), b = bfv(qr[d0][2 * j + 1]); ssq = fmaf(a, a, ssq); ssq = fmaf(b, b, ssq); w[j] = cvtpk(a * C, b * C); }
        qr[d0] = *reinterpret_cast<bf16x8*>(&w); }
    { auto rr = __builtin_amdgcn_permlane32_swap(__float_as_uint(ssq), __float_as_uint(ssq), false, false); ssq = __uint_as_float(rr[0]) + __uint_as_float(rr[1]); }
    const float ninit = -fmaxf(0.f, sqrtf(ssq) * kmaxC - 60.f);
    int krow[NKL], vrow[NVL], kst[NKL], vst[NVL]; int kcol, vcol;
    if constexpr (DQK == 128) { kcol = (tid & 15) * 8; krow[0] = tid >> 4; krow[1] = 32 + (tid >> 4); } else { kcol = (tid & 7) * 8; krow[0] = tid >> 3; }
    if constexpr (DV == 128) { vcol = (tid & 15) * 8; vrow[0] = tid >> 4; vrow[1] = 32 + (tid >> 4); } else { vcol = (tid & 7) * 8; vrow[0] = tid >> 3; }
#pragma unroll
    for (int i = 0; i < NKL; ++i) kst[i] = kswz<DQK>(krow[i], kcol * 2);
#pragma unroll
    for (int i = 0; i < NVL; ++i) vst[i] = v_st<NCB>(vrow[i], vcol);
    const int vb0 = (int)(uintptr_t)V_lds + v_rd_base(lane);
    struct { bf16x8 v[NVL]; bf16x8 k[NKL]; } sr_[SDEPTH];
    unsigned voffv[NVL], voffk[NKL];
#pragma unroll
    for (int i = 0; i < NVL; ++i) voffv[i] = (unsigned)(vrow[i] * ldk + vcol) * 2u;
#pragma unroll
    for (int i = 0; i < NKL; ++i) voffk[i] = (unsigned)(krow[i] * ldk + kcol) * 2u;
#define SLOAD(i, k0) do { const size_t _tb = (size_t)(k0) * (size_t)ldk * 2; const char* _vb = (const char*)Vb + _tb; const char* _kb = (const char*)Kb + _tb; \
    _Pragma("unroll") for (int _j = 0; _j < NVL; ++_j) sr_[i].v[_j] = *reinterpret_cast<const bf16x8*>(_vb + voffv[_j]); \
    _Pragma("unroll") for (int _j = 0; _j < NKL; ++_j) sr_[i].k[_j] = *reinterpret_cast<const bf16x8*>(_kb + voffk[_j]); } while (0)
#define SWRITE(b, i) do { _Pragma("unroll") for (int _j = 0; _j < NVL; ++_j) *(bf16x8*)(V_lds + (b) * SHM_V + vst[_j]) = sr_[i].v[_j]; \
    _Pragma("unroll") for (int _j = 0; _j < NKL; ++_j) *(bf16x8*)(K_lds + (b) * SHM_K + kst[_j]) = sr_[i].k[_j]; } while (0)
#define SWAIT() do { if constexpr (SDEPTH == 1) asm volatile("s_waitcnt vmcnt(0)" ::: "memory"); else if constexpr (NKL + NVL == 4) asm volatile("s_waitcnt vmcnt(4)" ::: "memory"); else if constexpr (NKL + NVL == 3) asm volatile("s_waitcnt vmcnt(3)" ::: "memory"); else asm volatile("s_waitcnt vmcnt(2)" ::: "memory"); } while (0)
    f32x16 pA0, pA1, pB0, pB1; bf16x8 pa0, pa1, pa2, pa3; const int NT = seq / KVBLK;
    constexpr int SE = 0, SO = SDEPTH - 1;
    SLOAD(SE, 0); asm volatile("s_waitcnt vmcnt(0)" ::: "memory"); SWRITE(0, SE); __syncthreads();
    qkt_init<DQK>(pA0, pA1, ninit, K_lds, qr, r32, hi); exp_half(pA0);
    SLOAD(SO, KVBLK); if constexpr (SDEPTH == 2) { if (2 < NT) SLOAD(SE, 2 * KVBLK); }
    SWAIT(); SWRITE(1, SO); __syncthreads();
    for (int j = 1; j + 1 < NT; j += 2) {
        SBAR(); qkt_init<DQK>(pB0, pB1, ninit, K_lds + SHM_K, qr, r32, hi);
        finish_fixed(pA0, pA1, l_reg, pa0, pa1, pa2, pa3); SBAR();
        SLOAD(SO, (j + SDEPTH) * KVBLK); SBAR();
        pv_d0<NCB>(o, vb0, pa0, pa1, pa2, pa3); SBAR(); exp_half(pB0); SBAR();
        __syncthreads(); SWAIT(); SWRITE(0, SE);
        __syncthreads();
        SBAR(); qkt_init<DQK>(pA0, pA1, ninit, K_lds, qr, r32, hi);
        finish_fixed(pB0, pB1, l_reg, pa0, pa1, pa2, pa3); SBAR();
        if (SDEPTH == 1 || j + 3 < NT) SLOAD(SE, (j + 1 + SDEPTH) * KVBLK); SBAR();
        pv_d0<NCB>(o, vb0 + SHM_V, pa0, pa1, pa2, pa3); SBAR(); exp_half(pA0); SBAR();
        __syncthreads(); SWAIT(); SWRITE(1, SO);
        __syncthreads();
    }
    SBAR(); qkt_init<DQK>(pB0, pB1, ninit, K_lds + SHM_K, qr, r32, hi);
    finish_fixed(pA0, pA1, l_reg, pa0, pa1, pa2, pa3); SBAR();
    pv_d0<NCB>(o, vb0, pa0, pa1, pa2, pa3); exp_half(pB0);
    __syncthreads();
    finish_fixed(pB0, pB1, l_reg, pa0, pa1, pa2, pa3); SBAR();
    pv_d0<NCB>(o, vb0 + SHM_V, pa0, pa1, pa2, pa3);
    { auto rr = __builtin_amdgcn_permlane32_swap(__float_as_uint(l_reg), __float_as_uint(l_reg), false, false); l_reg = __uint_as_float(rr[0]) + __uint_as_float(rr[1]); }
    if (hi == 0) li_l[r32] = l_reg; asm volatile("s_waitcnt lgkmcnt(0)" ::: "memory");
#pragma unroll
    for (int r = 0; r < 16; ++r) { const float rl = __builtin_amdgcn_rcpf(li_l[crow(r, hi)]);
#pragma unroll
        for (int d = 0; d < NCB; ++d) o[d][r] *= rl; }
    __syncthreads();
#undef SLOAD
#undef SWRITE
#undef SWAIT
}

constexpr int DMA_KRING = 0, DMA_VRING = 3 * SHM_K, DMA_SCR = 3 * SHM_K + 3 * SHM_V;
template <int DQK, int DV>
__device__ __forceinline__ void attn_core_dma(const int tid, const bf16_t* Qb, int ldq, const bf16_t* Kb, const bf16_t* Vb, int ldk, int seq, float kmaxC, LAS unsigned char* ldsl, f32x16 (&o)[DV / 32]) {
    static_assert(DV == 128, "V image is [64][128]");
    constexpr int NCB = DV / 32, NQF = DQK / 16, NKL = DQK / 64, NVL = DV / 64;
    constexpr float SCALE = (DQK == 128) ? 0.088388347648318440f : 0.125f;
    constexpr float C = SCALE * LOG2E;
    const int wid = __builtin_amdgcn_readfirstlane(tid >> 6), lane = tid & 63, r32 = lane & 31, hi = lane >> 5;
    char* lds = (char*)(unsigned char*)ldsl;
    char* K_lds = lds + DMA_KRING; char* V_lds = lds + DMA_VRING;
    float* li_l = (float*)(lds + DMA_SCR) + wid * 64;
    float l_reg = 0.f; bf16x8 qr[NQF];
#pragma unroll
    for (int d = 0; d < NCB; ++d) o[d] = f32x16{};
    const bf16_t* Qw = Qb + (long)(wid * QBLK + r32) * ldq + hi * 8;
#pragma unroll
    for (int d0 = 0; d0 < NQF; ++d0) qr[d0] = *reinterpret_cast<const bf16x8*>(Qw + d0 * 16);
    float ssq = 0.f;
#pragma unroll
    for (int d0 = 0; d0 < NQF; ++d0) { u32x4 w;
#pragma unroll
        for (int j = 0; j < 4; ++j) { const float a = bfv(qr[d0][2 * j]), b = bfv(qr[d0][2 * j + 1]); ssq = fmaf(a, a, ssq); ssq = fmaf(b, b, ssq); w[j] = cvtpk(a * C, b * C); }
        qr[d0] = *reinterpret_cast<bf16x8*>(&w); }
    { auto rr = __builtin_amdgcn_permlane32_swap(__float_as_uint(ssq), __float_as_uint(ssq), false, false); ssq = __uint_as_float(rr[0]) + __uint_as_float(rr[1]); }
    const float ninit = -fmaxf(0.f, sqrtf(ssq) * kmaxC - 60.f);
    unsigned srck[NKL], srcv[NVL];
#pragma unroll
    for (int i = 0; i < NKL; ++i) { const int b = (wid * NKL + i) * 1024 + lane * 16;
        if constexpr (DQK == 128) { const int row = b >> 8, colB = (b & 255) ^ ((row & 7) << 4); srck[i] = (unsigned)(row * ldk * 2 + colB); }
        else { const int row = b >> 7, colB = (b & 127) ^ (((row >> 1) & 7) << 4); srck[i] = (unsigned)(row * ldk * 2 + colB); } }
#pragma unroll
    for (int i = 0; i < NVL; ++i) { const int b = (wid * NVL + i) * 1024 + lane * 16; const int sub = b >> 9, kk = (sub >> 2) * 8 + ((b & 511) >> 6);
        const int k = (kk & ~0xC) | ((kk & 4) << 1) | ((kk & 8) >> 1), c = (sub & 3) * 32 + ((b & 63) >> 1); srcv[i] = (unsigned)(k * ldk * 2 + c * 2); }
    const int vb0 = (int)(uintptr_t)V_lds + v_rd_base(lane);
    const int NT = seq / KVBLK;
#define DMA_K(t, slot) do { const int _t = (t) < NT ? (t) : NT - 1; const char* _kb = (const char*)Kb + (size_t)_t * KVBLK * (size_t)ldk * 2; \
    _Pragma("unroll") for (int _i = 0; _i < NKL; ++_i) __builtin_amdgcn_global_load_lds((const unsigned*)(_kb + srck[_i]), (LAS unsigned*)(ldsl + DMA_KRING + (slot) * SHM_K + (wid * NKL + _i) * 1024), 16, 0, 0); } while (0)
#define DMA_V(t, slot) do { const int _t = (t) < NT ? (t) : NT - 1; const char* _vb = (const char*)Vb + (size_t)_t * KVBLK * (size_t)ldk * 2; \
    _Pragma("unroll") for (int _i = 0; _i < NVL; ++_i) __builtin_amdgcn_global_load_lds((const unsigned*)(_vb + srcv[_i]), (LAS unsigned*)(ldsl + DMA_VRING + (slot) * SHM_V + (wid * NVL + _i) * 1024), 16, 0, 0); } while (0)
#define DMA_WAIT_BAR() do { if constexpr (NKL + NVL == 4) asm volatile("s_waitcnt vmcnt(4)" ::: "memory"); else asm volatile("s_waitcnt vmcnt(3)" ::: "memory"); \
    __builtin_amdgcn_s_barrier(); SBAR(); } while (0)
#define NEXT3(x) ((x) == 2 ? 0 : (x) + 1)
    f32x16 pA0, pA1, pB0, pB1; bf16x8 pa0, pa1, pa2, pa3;
    DMA_K(0, 0); DMA_K(1, 1); DMA_V(0, 0);
    asm volatile("s_waitcnt vmcnt(0)" ::: "memory"); __builtin_amdgcn_s_barrier(); SBAR();
    DMA_K(2, 2); DMA_V(1, 1);
    qkt_init<DQK>(pA0, pA1, ninit, K_lds, qr, r32, hi); exp_half(pA0);
    DMA_WAIT_BAR();
    int ks = 1, vs = 0;
    for (int j = 1; j + 1 < NT; j += 2) {
        { const int kd = ks == 0 ? 2 : ks - 1, vd = vs == 0 ? 2 : vs - 1; DMA_K(j + 2, kd); DMA_V(j + 1, vd); }
        SBAR(); qkt_init<DQK>(pB0, pB1, ninit, K_lds + ks * SHM_K, qr, r32, hi);
        finish_fixed(pA0, pA1, l_reg, pa0, pa1, pa2, pa3); SBAR();
        pv_d0<NCB>(o, vb0 + vs * SHM_V, pa0, pa1, pa2, pa3); SBAR(); exp_half(pB0); SBAR();
        DMA_WAIT_BAR();
        ks = NEXT3(ks); vs = NEXT3(vs);
        { const int kd = ks == 0 ? 2 : ks - 1, vd = vs == 0 ? 2 : vs - 1; DMA_K(j + 3, kd); DMA_V(j + 2, vd); }
        SBAR(); qkt_init<DQK>(pA0, pA1, ninit, K_lds + ks * SHM_K, qr, r32, hi);
        finish_fixed(pB0, pB1, l_reg, pa0, pa1, pa2, pa3); SBAR();
        pv_d0<NCB>(o, vb0 + vs * SHM_V, pa0, pa1, pa2, pa3); SBAR(); exp_half(pA0); SBAR();
        DMA_WAIT_BAR();
        ks = NEXT3(ks); vs = NEXT3(vs);
    }
    SBAR(); qkt_init<DQK>(pB0, pB1, ninit, K_lds + ks * SHM_K, qr, r32, hi);
    finish_fixed(pA0, pA1, l_reg, pa0, pa1, pa2, pa3); SBAR();
    pv_d0<NCB>(o, vb0 + vs * SHM_V, pa0, pa1, pa2, pa3); SBAR(); exp_half(pB0); SBAR();
    asm volatile("s_waitcnt vmcnt(0)" ::: "memory"); __builtin_amdgcn_s_barrier(); SBAR();
    vs = NEXT3(vs);
    finish_fixed(pB0, pB1, l_reg, pa0, pa1, pa2, pa3); SBAR();
    pv_d0<NCB>(o, vb0 + vs * SHM_V, pa0, pa1, pa2, pa3);
    { auto rr = __builtin_amdgcn_permlane32_swap(__float_as_uint(l_reg), __float_as_uint(l_reg), false, false); l_reg = __uint_as_float(rr[0]) + __uint_as_float(rr[1]); }
    if (hi == 0) li_l[r32] = l_reg; asm volatile("s_waitcnt lgkmcnt(0)" ::: "memory");
#pragma unroll
    for (int r = 0; r < 16; ++r) { const float rl = __builtin_amdgcn_rcpf(li_l[crow(r, hi)]);
#pragma unroll
        for (int d = 0; d < NCB; ++d) o[d][r] *= rl; }
    __syncthreads();
#undef DMA_K
#undef DMA_V
#undef DMA_WAIT_BAR
#undef NEXT3
}

__device__ __forceinline__ void glds16(const void* gsrc, unsigned lds_dst) { unsigned keep;
    asm volatile("s_mov_b32 %0, m0\n\ts_mov_b32 m0, %2\n\ts_nop 0\n\tglobal_load_lds_dwordx4 %1, off\n\ts_mov_b32 m0, %0" : "=&s"(keep) : "v"(gsrc), "s"(lds_dst) : "memory"); }
template <int DQK>
__device__ __forceinline__ void attn_core_il(const int tid, const bf16_t* Qb, int ldq, const bf16_t* Kb, const bf16_t* Vb, int ldk, int seq, float kmaxC, LAS unsigned char* ldsl, f32x16 (&o)[4], const float* qgain, const float* ropeT, int tpos0) {
    constexpr int NQF = DQK / 16, NKL = DQK / 64, NVL = 2, NGA = 2 * NQF, NADD = 32 / NGA, NPK = 16 / NGA, NCG = DQK / 32;
    constexpr float SCALE = (DQK == 128) ? 0.088388347648318440f : 0.125f;
    constexpr float C = SCALE * LOG2E;
    typedef const LAS char* lds_cptr;
    const int wid = __builtin_amdgcn_readfirstlane(tid >> 6), lane = tid & 63, r32 = lane & 31, hi = lane >> 5;
    char* lds = (char*)(unsigned char*)ldsl; const unsigned ldsb = (unsigned)(uintptr_t)ldsl;
    float* li_l = (float*)(lds + DMA_SCR) + wid * 64;
    float l_reg = 0.f; bf16x8 qr[NQF];
#pragma unroll
    for (int d = 0; d < 4; ++d) o[d] = f32x16{};
    const bf16_t* Qw = Qb + (long)(wid * QBLK + r32) * ldq + hi * 8;
    const float ssq = prep_q<DQK>(qr, Qw, qgain, ropeT, tpos0 >= 0 ? tpos0 + wid * QBLK + r32 : -1, hi, C);
    f32x16 negm;
    { const float ninit = -fmaxf(0.f, sqrtf(ssq) * kmaxC - 60.f);
#pragma unroll
      for (int r = 0; r < 16; ++r) negm[r] = ninit; }
    asm volatile("" : "+v"(negm));
    unsigned srck[2 * NKL], srcv[2 * NVL];
#pragma unroll
    for (int i = 0; i < 2 * NKL; ++i) { const int p = (wid & 3) + 4 * i, rg = p / NCG, cg = p % NCG; srck[i] = (unsigned)((rg * 16 + (lane & 15)) * ldk + (cg * 4 + (lane >> 4)) * 8) * 2u; }
#pragma unroll
    for (int i = 0; i < 2 * NVL; ++i) { const int p = (wid & 3) + 4 * i; srcv[i] = (unsigned)((16 * (p & 3) + (lane >> 2)) * ldk + (p >> 2) * 32 + (lane & 3) * 8) * 2u; }
    const lds_cptr kp0 = (lds_cptr)ldsl + DMA_KRING + (r32 >> 4) * (NCG * 1024) + hi * 256 + (r32 & 15) * 16;
    const lds_cptr vp0 = (lds_cptr)ldsl + DMA_VRING + ((lane >> 4) & 1) * 32 + (lane & 3) * 8 + (4 * hi + ((lane & 15) >> 2)) * 64;
    const int NT = seq / KVBLK;
#define DMA_K(t, slot) do { const int _t = (t) < NT ? (t) : NT - 1; const char* _kb = (const char*)Kb + (size_t)_t * KVBLK * (size_t)ldk * 2; \
    if (wid < 4) { _Pragma("unroll") for (int _i = 0; _i < 2 * NKL; ++_i) glds16(_kb + srck[_i], (unsigned)__builtin_amdgcn_readfirstlane((int)(ldsb + DMA_KRING + (slot) * SHM_K + (wid + 4 * _i) * 1024))); } } while (0)
#define DMA_V(t, slot) do { const int _t = (t) < NT ? (t) : NT - 1; const char* _vb = (const char*)Vb + (size_t)_t * KVBLK * (size_t)ldk * 2; \
    if (wid < 4) { _Pragma("unroll") for (int _i = 0; _i < 2 * NVL; ++_i) glds16(_vb + srcv[_i], (unsigned)__builtin_amdgcn_readfirstlane((int)(ldsb + DMA_VRING + (slot) * SHM_V + (wid + 4 * _i) * 1024))); } } while (0)
#define WAIT_BAR_N() do { if constexpr (NKL + NVL == 4) asm volatile("s_waitcnt vmcnt(8) lgkmcnt(0)\n\ts_barrier" ::: "memory"); else asm volatile("s_waitcnt vmcnt(6) lgkmcnt(0)\n\ts_barrier" ::: "memory"); SBAR(); } while (0)
#define WAIT_BAR_0() do { asm volatile("s_waitcnt vmcnt(0) lgkmcnt(0)\n\ts_barrier" ::: "memory"); SBAR(); } while (0)
#define PIN(x) asm volatile("" : "+v"(x))
#define KFR(kp, g) (*(const LAS bf16x8*)((kp) + ((g) & 1) * (2 * NCG * 1024) + ((g) >> 2) * 1024 + (((g) >> 1) & 1) * 512))
#define NEXT3(x) ((x) == 2 ? 0 : (x) + 1)
    f32x16 pA0, pA1, pB0, pB1; u32x4 pw0, pw1, pw2, pw3;
#define STEP(C0, C1, P0, P1, kso, vso) do { SBAR(); \
    const lds_cptr kp_ = kp0 + (kso); const lds_cptr vp_ = vp0 + (vso); \
    bf16x8 kf_[3]; s16x4 vl_[3], vh_[3]; float sacc = 0.f; \
    kf_[0] = KFR(kp_, 0); kf_[1] = KFR(kp_, 1); SBAR(); \
    _Pragma("unroll") for (int g = 0; g < NGA; ++g) { \
        if (g + 2 < NGA) kf_[(g + 2) % 3] = KFR(kp_, g + 2); \
        if (g == NGA - 2) { vl_[0] = vtr((int)(uintptr_t)(vp_)); vh_[0] = vtr((int)(uintptr_t)(vp_ + 512)); } \
        if (g == NGA - 1) { vl_[1] = vtr((int)(uintptr_t)(vp_ + 4096)); vh_[1] = vtr((int)(uintptr_t)(vp_ + 4096 + 512)); } \
        SBAR(); \
        if ((g & 1) == 0) C0 = __builtin_amdgcn_mfma_f32_32x32x16_bf16(kf_[g % 3], qr[g >> 1], (g < 2) ? negm : C0, 0, 0, 0); \
        else              C1 = __builtin_amdgcn_mfma_f32_32x32x16_bf16(kf_[g % 3], qr[g >> 1], (g < 2) ? negm : C1, 0, 0, 0); \
        _Pragma("unroll") for (int a_ = 0; a_ < NADD; ++a_) { const int v_ = g * NADD + a_; sacc += (v_ < 16) ? P0[v_ & 15] : P1[v_ & 15]; } \
        PIN(sacc); \
        _Pragma("unroll") for (int k_ = 0; k_ < NPK; ++k_) { const int w_ = g * NPK + k_; const int e_ = (2 * w_) & 15; const unsigned pk_ = (w_ < 8) ? cvtpk_s(P0[e_], P0[e_ + 1]) : cvtpk_s(P1[e_], P1[e_ + 1]); \
            if ((w_ >> 2) == 0) pw0[w_ & 3] = pk_; else if ((w_ >> 2) == 1) pw1[w_ & 3] = pk_; else if ((w_ >> 2) == 2) pw2[w_ & 3] = pk_; else pw3[w_ & 3] = pk_; } \
        PIN(pw0); PIN(pw1); PIN(pw2); PIN(pw3); SBAR(); } \
    l_reg += sacc; \
    _Pragma("unroll") for (int g = 0; g < 16; ++g) { \
        if (g + 2 < 16) { const int g2 = g + 2; vl_[g2 % 3] = vtr((int)(uintptr_t)(vp_ + (g2 & 3) * 4096 + (g2 >> 2) * 1024)); vh_[g2 % 3] = vtr((int)(uintptr_t)(vp_ + (g2 & 3) * 4096 + (g2 >> 2) * 1024 + 512)); } \
        SBAR(); \
        { const s16x4 l_ = vl_[g % 3], h_ = vh_[g % 3]; const bf16x8 vf_ = (bf16x8){l_[0], l_[1], l_[2], l_[3], h_[0], h_[1], h_[2], h_[3]}; \
          const bf16x8 pa_ = __builtin_bit_cast(bf16x8, (g >> 2) == 0 ? pw0 : ((g >> 2) == 1 ? pw1 : ((g >> 2) == 2 ? pw2 : pw3))); \
          o[g & 3] = __builtin_amdgcn_mfma_f32_32x32x16_bf16(pa_, vf_, o[g & 3], 0, 0, 0); } \
        if (g < 8) { C0[2 * g] = __builtin_amdgcn_exp2f(C0[2 * g]); C0[2 * g + 1] = __builtin_amdgcn_exp2f(C0[2 * g + 1]); PIN(C0); } \
        else { C1[2 * g - 16] = __builtin_amdgcn_exp2f(C1[2 * g - 16]); C1[2 * g - 15] = __builtin_amdgcn_exp2f(C1[2 * g - 15]); PIN(C1); } \
        SBAR(); } \
    } while (0)
    DMA_K(0, 0); DMA_K(1, 1); DMA_V(0, 0);
    WAIT_BAR_0();
    DMA_K(2, 2); DMA_V(1, 1);
    { const lds_cptr kp_ = kp0;
#pragma unroll
      for (int g = 0; g < NGA; ++g) { const bf16x8 kf = KFR(kp_, g);
          if ((g & 1) == 0) pA0 = __builtin_amdgcn_mfma_f32_32x32x16_bf16(kf, qr[g >> 1], (g < 2) ? negm : pA0, 0, 0, 0);
          else              pA1 = __builtin_amdgcn_mfma_f32_32x32x16_bf16(kf, qr[g >> 1], (g < 2) ? negm : pA1, 0, 0, 0); } }
    exp_half(pA0); exp_half(pA1);
    WAIT_BAR_N();
    int ks = 1, vs = 0;
    for (int t = 1; t + 1 < NT; t += 2) {
        { const int kd = ks == 0 ? 2 : ks - 1, vd = vs == 0 ? 2 : vs - 1; DMA_K(t + 2, kd); DMA_V(t + 1, vd); }
        STEP(pB0, pB1, pA0, pA1, ks * SHM_K, vs * SHM_V); WAIT_BAR_N(); ks = NEXT3(ks); vs = NEXT3(vs);
        { const int kd = ks == 0 ? 2 : ks - 1, vd = vs == 0 ? 2 : vs - 1; DMA_K(t + 3, kd); DMA_V(t + 2, vd); }
        STEP(pA0, pA1, pB0, pB1, ks * SHM_K, vs * SHM_V); WAIT_BAR_N(); ks = NEXT3(ks); vs = NEXT3(vs);
    }
    STEP(pB0, pB1, pA0, pA1, ks * SHM_K, vs * SHM_V); WAIT_BAR_0(); vs = NEXT3(vs);
    { float sacc = 0.f;
#pragma unroll
      for (int r = 0; r < 16; ++r) sacc += pB0[r];
#pragma unroll
      for (int r = 0; r < 16; ++r) sacc += pB1[r];
      l_reg += sacc;
      pw0 = (u32x4){cvtpk_s(pB0[0], pB0[1]), cvtpk_s(pB0[2], pB0[3]), cvtpk_s(pB0[4], pB0[5]), cvtpk_s(pB0[6], pB0[7])};
      pw1 = (u32x4){cvtpk_s(pB0[8], pB0[9]), cvtpk_s(pB0[10], pB0[11]), cvtpk_s(pB0[12], pB0[13]), cvtpk_s(pB0[14], pB0[15])};
      pw2 = (u32x4){cvtpk_s(pB1[0], pB1[1]), cvtpk_s(pB1[2], pB1[3]), cvtpk_s(pB1[4], pB1[5]), cvtpk_s(pB1[6], pB1[7])};
      pw3 = (u32x4){cvtpk_s(pB1[8], pB1[9]), cvtpk_s(pB1[10], pB1[11]), cvtpk_s(pB1[12], pB1[13]), cvtpk_s(pB1[14], pB1[15])};
      const lds_cptr vp_ = vp0 + vs * SHM_V;
#pragma unroll
      for (int g = 0; g < 16; ++g) { const s16x4 l_ = vtr((int)(uintptr_t)(vp_ + (g & 3) * 4096 + (g >> 2) * 1024)), h_ = vtr((int)(uintptr_t)(vp_ + (g & 3) * 4096 + (g >> 2) * 1024 + 512));
          const bf16x8 vf_ = (bf16x8){l_[0], l_[1], l_[2], l_[3], h_[0], h_[1], h_[2], h_[3]};
          const bf16x8 pa_ = __builtin_bit_cast(bf16x8, (g >> 2) == 0 ? pw0 : ((g >> 2) == 1 ? pw1 : ((g >> 2) == 2 ? pw2 : pw3)));
          o[g & 3] = __builtin_amdgcn_mfma_f32_32x32x16_bf16(pa_, vf_, o[g & 3], 0, 0, 0); } }
    { auto rr = __builtin_amdgcn_permlane32_swap(__float_as_uint(l_reg), __float_as_uint(l_reg), false, false); l_reg = __uint_as_float(rr[0]) + __uint_as_float(rr[1]); }
    if (hi == 0) li_l[r32] = l_reg; asm volatile("s_waitcnt lgkmcnt(0)" ::: "memory");
#pragma unroll
    for (int r = 0; r < 16; ++r) { const float rl = __builtin_amdgcn_rcpf(li_l[crow(r, hi)]);
#pragma unroll
        for (int d = 0; d < 4; ++d) o[d][r] *= rl; }
    __syncthreads();
#undef DMA_K
#undef DMA_V
#undef WAIT_BAR_N
#undef WAIT_BAR_0
#undef PIN
#undef KFR
#undef NEXT3
#undef STEP
}

typedef int i32x8 __attribute__((ext_vector_type(8)));
constexpr int F8_KRING = 0, F8_VRING = 4 * 8192, F8_SCR = 8 * 8192, F8_Q = 8 * 8192 + 2048;
constexpr float THR8 = 8.f;
__device__ __forceinline__ unsigned f8x4u(float a, float b, float c, float d) {
    int p = __builtin_amdgcn_cvt_pk_fp8_f32(a, b, 0, false); p = __builtin_amdgcn_cvt_pk_fp8_f32(c, d, p, true); return (unsigned)p; }
__device__ __forceinline__ void f8x8u(float a0, float a1, float a2, float a3, float b0, float b1, float b2, float b3, int& pa, int& pb) {
    asm volatile("v_cvt_pk_fp8_f32 %0, %2, %3\n\tv_cvt_pk_fp8_f32 %1, %6, %7\n\tv_cvt_pk_fp8_f32 %0, %4, %5 op_sel:[0,0,1]\n\tv_cvt_pk_fp8_f32 %1, %8, %9 op_sel:[0,0,1]\n\ts_nop 0"
                 : "=&v"(pa), "=&v"(pb) : "v"(a0), "v"(a1), "v"(a2), "v"(a3), "v"(b0), "v"(b1), "v"(b2), "v"(b3)); }
__device__ __forceinline__ float cl448(float x) { return __builtin_amdgcn_fmed3f(x, -448.f, 448.f); }
__device__ __forceinline__ unsigned f8x4(float a, float b, float c, float d) { return f8x4u(cl448(a), cl448(b), cl448(c), cl448(d)); }
template <int DQK> __device__ __forceinline__ int kimg_off(int key, int d) { const int g = (DQK == 128) ? ((key >> 1) & 7) : ((key >> 2) & 3); return key * DQK + ((((d >> 4) ^ g)) << 4) + (d & 15); }
__device__ __forceinline__ int vimg_off(int n, int j) { return n * 64 + ((((j >> 4) ^ ((n >> 2) & 3))) << 4) + (j & 15); }
__device__ __forceinline__ int kap(int h, int e) { return e < 16 ? crow(e, h) : 32 + crow(e - 16, h); }
template <int DQK>
__device__ __forceinline__ void attn_core_f8(const int tid, const bf16_t* Qb, int ldq, const unsigned char* Kimg, const unsigned char* Vimg, int seq, LAS unsigned char* ldsl, f32x16 (&o)[4],
                                             const float* qgain, const float* ropeT, int tpos0, float kmaxC) {
    constexpr int NQF = DQK / 16, NKS = DQK / 64, KTB = 64 * DQK, NKP = KTB / 1024;
    constexpr float SCALE = (DQK == 128) ? 0.088388347648318440f : 0.125f;
    constexpr float C = SCALE * LOG2E;
    typedef const LAS char* lds_cptr;
    const int wid = __builtin_amdgcn_readfirstlane(tid >> 6), lane = tid & 63, r32 = lane & 31, hi = lane >> 5;
    char* lds = (char*)(unsigned char*)ldsl; const unsigned ldsb = (unsigned)(uintptr_t)ldsl;
    float l_reg = 0.f;
#pragma unroll
    for (int d = 0; d < 4; ++d) o[d] = f32x16{};
    i32x8 qf[NKS]; float qn2;
    { float x[NQF][8];
      qn2 = prep_q_x<DQK>(x, Qb + (long)(wid * QBLK + r32) * ldq + hi * 8, qgain, ropeT, tpos0 >= 0 ? tpos0 + wid * QBLK + r32 : -1, hi);
#pragma unroll
      for (int ks = 0; ks < NKS; ++ks)
#pragma unroll
          for (int i = 0; i < 2; ++i) { const int da = 4 * ks + i, db = 4 * ks + 2 + i;
              unsigned a0 = f8x4(x[da][0] * C, x[da][1] * C, x[da][2] * C, x[da][3] * C), a1 = f8x4(x[da][4] * C, x[da][5] * C, x[da][6] * C, x[da][7] * C);
              unsigned b0 = f8x4(x[db][0] * C, x[db][1] * C, x[db][2] * C, x[db][3] * C), b1 = f8x4(x[db][4] * C, x[db][5] * C, x[db][6] * C, x[db][7] * C);
              auto r0 = __builtin_amdgcn_permlane32_swap(a0, b0, false, false); auto r1 = __builtin_amdgcn_permlane32_swap(a1, b1, false, false);
              qf[ks][4 * i + 0] = (int)r0[0]; qf[ks][4 * i + 1] = (int)r1[0]; qf[ks][4 * i + 2] = (int)r0[1]; qf[ks][4 * i + 3] = (int)r1[1]; } }
    const int gk = (DQK == 128) ? ((r32 >> 1) & 7) : ((r32 >> 2) & 3), gv = (r32 >> 2) & 3;
    int kc2[2], vco[2];
#pragma unroll
    for (int i = 0; i < 2; ++i) kc2[i] = (((2 * hi + i) ^ gk) << 4);
#define kco(i) (((i) >> 1) ? (kc2[(i) & 1] ^ 64) : kc2[(i) & 1])
#pragma unroll
    for (int i = 0; i < 2; ++i) vco[i] = (((2 * hi + i) ^ gv) << 4);
    const lds_cptr qp0 = (lds_cptr)ldsl + F8_Q + wid * 4096 + r32 * DQK;
#pragma unroll
    for (int ks = 0; ks < NKS; ++ks) { *(LAS u32x4*)(qp0 + kco(2 * ks)) = (u32x4){(unsigned)qf[ks][0], (unsigned)qf[ks][1], (unsigned)qf[ks][2], (unsigned)qf[ks][3]};
        *(LAS u32x4*)(qp0 + kco(2 * ks + 1)) = (u32x4){(unsigned)qf[ks][4], (unsigned)qf[ks][5], (unsigned)qf[ks][6], (unsigned)qf[ks][7]}; }
    asm volatile("s_waitcnt lgkmcnt(0)" ::: "memory");
    const lds_cptr kp0 = (lds_cptr)ldsl + F8_KRING + r32 * DQK;
    const lds_cptr vp0 = (lds_cptr)ldsl + F8_VRING + r32 * 64;
    const int NT = seq / KVBLK;
    const unsigned char* kimgw = Kimg + (wid % NKP) * 1024; const unsigned char* vimgw = Vimg + wid * 1024;
#define ksrc (kimgw + (unsigned)(lane * 16))
#define vsrc (vimgw + (unsigned)(lane * 16))
#define DMA8(t, kslot, vslot) do { const int _t = (t) < NT ? (t) : NT - 1; \
    glds16(ksrc + (size_t)_t * KTB, (unsigned)__builtin_amdgcn_readfirstlane((int)(ldsb + F8_KRING + (kslot) * 8192 + (wid % NKP) * 1024))); \
    glds16(vsrc + (size_t)_t * 8192, (unsigned)__builtin_amdgcn_readfirstlane((int)(ldsb + F8_VRING + (vslot) * 8192 + wid * 1024))); } while (0)
#define DMA8K(t, kslot) do { const int _t = (t) < NT ? (t) : NT - 1; glds16(ksrc + (size_t)_t * KTB, (unsigned)__builtin_amdgcn_readfirstlane((int)(ldsb + F8_KRING + (kslot) * 8192 + (wid % NKP) * 1024))); } while (0)
#define WB8(n) do { asm volatile("s_waitcnt vmcnt(" #n ") lgkmcnt(0)\n\ts_barrier" ::: "memory"); SBAR(); } while (0)
#define QKT8(C0, C1, kso) do { const lds_cptr kp_ = kp0 + (kso); \
    _Pragma("unroll") for (int ks = 0; ks < NKS; ++ks) { \
        const u32x4 a0 = *(const LAS u32x4*)(kp_ + kco(2 * ks)), a1 = *(const LAS u32x4*)(kp_ + kco(2 * ks + 1)); \
        const u32x4 b0 = *(const LAS u32x4*)(kp_ + 32 * DQK + kco(2 * ks)), b1 = *(const LAS u32x4*)(kp_ + 32 * DQK + kco(2 * ks + 1)); \
        const i32x8 ka = {(int)a0[0], (int)a0[1], (int)a0[2], (int)a0[3], (int)a1[0], (int)a1[1], (int)a1[2], (int)a1[3]}; \
        const i32x8 kb = {(int)b0[0], (int)b0[1], (int)b0[2], (int)b0[3], (int)b1[0], (int)b1[1], (int)b1[2], (int)b1[3]}; \
        const u32x4 q0 = *(const LAS u32x4*)(qp0 + kco(2 * ks)), q1 = *(const LAS u32x4*)(qp0 + kco(2 * ks + 1)); \
        const i32x8 qq = {(int)q0[0], (int)q0[1], (int)q0[2], (int)q0[3], (int)q1[0], (int)q1[1], (int)q1[2], (int)q1[3]}; \
        C0 = __builtin_amdgcn_mfma_scale_f32_32x32x64_f8f6f4(ka, qq, ks == 0 ? negm : C0, 0, 0, 0, 0, 0, 0); \
        C1 = __builtin_amdgcn_mfma_scale_f32_32x32x64_f8f6f4(kb, qq, ks == 0 ? negm : C1, 0, 0, 0, 0, 0, 0); SBAR(); } } while (0)
#define PV8(vso) do { const lds_cptr vp_ = vp0 + (vso); \
    _Pragma("unroll") for (int d = 0; d < 4; ++d) { const u32x4 v0 = *(const LAS u32x4*)(vp_ + d * 2048 + vco[0]), v1 = *(const LAS u32x4*)(vp_ + d * 2048 + vco[1]); \
        const i32x8 vf = {(int)v0[0], (int)v0[1], (int)v0[2], (int)v0[3], (int)v1[0], (int)v1[1], (int)v1[2], (int)v1[3]}; \
        o[d] = __builtin_amdgcn_mfma_scale_f32_32x32x64_f8f6f4(pw, vf, o[d], 0, 0, 0, 0, 0, 0); } } while (0)
#define PART8(P0, P1, AL) do { float pm = P0[0]; \
    _Pragma("unroll") for (int r = 1; r < 16; ++r) pm = fmaxf(pm, P0[r]); \
    _Pragma("unroll") for (int r = 0; r < 16; ++r) pm = fmaxf(pm, P1[r]); \
    { auto rr = __builtin_amdgcn_permlane32_swap(__float_as_uint(pm), __float_as_uint(pm), false, false); pm = fmaxf(__uint_as_float(rr[0]), __uint_as_float(rr[1])); } \
    AL = 1.f; \
    if (!__builtin_expect(__all(pm <= THR8), 1)) { const float dl = fmaxf(pm, 0.f); AL = __builtin_amdgcn_exp2f(-dl); \
        _Pragma("unroll") for (int r = 0; r < 16; ++r) { P0[r] -= dl; P1[r] -= dl; negm[r] -= dl; } } \
    _Pragma("unroll") for (int r = 0; r < 16; ++r) P0[r] = __builtin_amdgcn_exp2f(P0[r]); } while (0)
#define FIN8(P0, P1, AL) do { \
    _Pragma("unroll") for (int r = 0; r < 16; ++r) P1[r] = __builtin_amdgcn_exp2f(P1[r]); \
    float ps = 0.f; \
    _Pragma("unroll") for (int r = 0; r < 16; ++r) ps += P0[r]; \
    _Pragma("unroll") for (int r = 0; r < 16; ++r) ps += P1[r]; \
    l_reg = l_reg * AL + ps; \
    _Pragma("unroll") for (int v = 0; v < 4; ++v) { pw[v] = (int)f8x4u(P0[4 * v], P0[4 * v + 1], P0[4 * v + 2], P0[4 * v + 3]); pw[4 + v] = (int)f8x4u(P1[4 * v], P1[4 * v + 1], P1[4 * v + 2], P1[4 * v + 3]); } } while (0)
#define RESC8(a) do { if (__any((a) < 1.f)) { int t2 = tid; asm volatile("" : "+v"(t2)); const int h2 = (t2 >> 5) & 1, r2 = t2 & 31; float* al2 = (float*)(lds + F8_SCR) + (t2 >> 6) * 64 + 32;   \
    if (h2 == 0) al2[r2] = (a); asm volatile("s_waitcnt lgkmcnt(0)" ::: "memory"); \
    _Pragma("unroll") for (int d = 0; d < 4; ++d) _Pragma("unroll") for (int r = 0; r < 16; ++r) o[d][r] *= al2[crow(r, h2)]; } } while (0)
#define NEXT3(x) ((x) == 2 ? 0 : (x) + 1)
    f32x16 pA0, pA1, pB0, pB1, negm = f32x16{}; float alA = 1.f, alB = 1.f; i32x8 pw;
    DMA8(0, 0, 0); DMA8K(1, 1); DMA8K(2, 2);
    WB8(0);
    { const int tk = 3 < NT ? 3 : NT - 1, tv = 1;
      glds16(ksrc + (size_t)tk * KTB, (unsigned)__builtin_amdgcn_readfirstlane((int)(ldsb + F8_KRING + 3 * 8192 + (wid % NKP) * 1024)));
      glds16(vsrc + (size_t)tv * 8192, (unsigned)__builtin_amdgcn_readfirstlane((int)(ldsb + F8_VRING + 1 * 8192 + wid * 1024))); }
    QKT8(pA0, pA1, 0);
    { float pm = pA0[0];
#pragma unroll
      for (int r = 1; r < 16; ++r) pm = fmaxf(pm, pA0[r]);
#pragma unroll
      for (int r = 0; r < 16; ++r) pm = fmaxf(pm, pA1[r]);
      { auto rr = __builtin_amdgcn_permlane32_swap(__float_as_uint(pm), __float_as_uint(pm), false, false); pm = fmaxf(__uint_as_float(rr[0]), __uint_as_float(rr[1])); }
      pm = fmaxf(pm, sqrtf(qn2) * kmaxC * 1.1f - 100.f);
#pragma unroll
      for (int r = 0; r < 16; ++r) { pA0[r] -= pm; pA1[r] -= pm; negm[r] = -pm; }
#pragma unroll
      for (int r = 0; r < 16; ++r) pA0[r] = __builtin_amdgcn_exp2f(pA0[r]); }
#pragma unroll
    for (int r = 0; r < 16; ++r) pA1[r] = __builtin_amdgcn_exp2f(pA1[r]);
#define PIN(x) asm volatile("" : "+v"(x))
#define KF8(kp, g) ({ const u32x4 _a = *(const LAS u32x4*)((kp) + ((g) & 1) * (32 * DQK) + kco(2 * ((g) >> 1))), _b = *(const LAS u32x4*)((kp) + ((g) & 1) * (32 * DQK) + kco(2 * ((g) >> 1) + 1)); \
    (i32x8){(int)_a[0], (int)_a[1], (int)_a[2], (int)_a[3], (int)_b[0], (int)_b[1], (int)_b[2], (int)_b[3]}; })
#define QF8(ks) ({ const u32x4 _a = *(const LAS u32x4*)(qp0 + kco(2 * (ks))), _b = *(const LAS u32x4*)(qp0 + kco(2 * (ks) + 1)); \
    (i32x8){(int)_a[0], (int)_a[1], (int)_a[2], (int)_a[3], (int)_b[0], (int)_b[1], (int)_b[2], (int)_b[3]}; })
#define VF8(vp, d) ({ const u32x4 _a = *(const LAS u32x4*)((vp) + (d) * 2048 + vco[0]), _b = *(const LAS u32x4*)((vp) + (d) * 2048 + vco[1]); \
    (i32x8){(int)_a[0], (int)_a[1], (int)_a[2], (int)_a[3], (int)_b[0], (int)_b[1], (int)_b[2], (int)_b[3]}; })
    constexpr int NG = 2 * NKS, NPG = (NG == 4) ? 2 : 1, NPK = 8 / NPG;
    constexpr float LIM8 = 448.f;
    bool resc = false; float pdl = 0.f;
    i32x8 sel; { const int sv = ((lane & 15) < 2 && ((lane >> 4) & 1) == (lane & 15)) ? 0x38383838 : 0;
#pragma unroll
      for (int i = 0; i < 8; ++i) sel[i] = sv; }
    f32x4 lacc = {0.f, 0.f, 0.f, 0.f}, srs;
#define PACK8(P0, P1, w_) do { const int e_ = (4 * (w_)) & 15; int pa_, pb_; \
    if ((w_) < 4) f8x8u(P0[e_], P0[e_ + 1], P0[e_ + 2], P0[e_ + 3], P0[e_ + 4], P0[e_ + 5], P0[e_ + 6], P0[e_ + 7], pa_, pb_); \
    else          f8x8u(P1[e_], P1[e_ + 1], P1[e_ + 2], P1[e_ + 3], P1[e_ + 4], P1[e_ + 5], P1[e_ + 6], P1[e_ + 7], pa_, pb_); \
    pw[w_] = pa_; pw[(w_) + 1] = pb_; } while (0)
#define RSUM8() srs = __builtin_amdgcn_mfma_scale_f32_16x16x128_f8f6f4(pw, sel, (f32x4){0.f, 0.f, 0.f, 0.f}, 0, 0, 0, 0, 0, 0)
#define MOVE9(P0, P1) do { float sacc = 0.f; \
    _Pragma("unroll") for (int r = 0; r < 16; ++r) sacc += P0[r]; \
    _Pragma("unroll") for (int r = 0; r < 16; ++r) sacc += P1[r]; \
    float srow; { auto rr = __builtin_amdgcn_permlane32_swap(__float_as_uint(sacc), __float_as_uint(sacc), false, false); srow = __uint_as_float(rr[0]) + __uint_as_float(rr[1]); } \
    pdl = fmaxf(__builtin_ceilf(__builtin_amdgcn_logf(srow)) - 6.f, 0.f); const float f_ = __builtin_amdgcn_exp2f(-pdl); \
    _Pragma("unroll") for (int r = 0; r < 16; ++r) { P0[r] *= f_; P1[r] *= f_; negm[r] -= pdl; } \
    { int t2 = tid; asm volatile("" : "+v"(t2)); float* al2 = (float*)(lds + F8_SCR) + (t2 >> 6) * 64 + 32; if (((t2 >> 5) & 1) == 0) al2[t2 & 31] = f_; asm volatile("s_waitcnt lgkmcnt(0)" ::: "memory"); \
      const int q0 = 16 * (t2 & 1) + 4 * ((t2 >> 4) & 3); \
      _Pragma("unroll") for (int r = 0; r < 4; ++r) lacc[r] *= al2[q0 + r]; } \
    _Pragma("unroll") for (int w_ = 0; w_ < 8; w_ += 2) PACK8(P0, P1, w_); \
    RSUM8(); resc = true; } while (0)
#define MOVE9B(C0, C1) do { int t2 = tid; asm volatile("" : "+v"(t2)); const int h2 = (t2 >> 5) & 1; const float* al2 = (const float*)(lds + F8_SCR) + (t2 >> 6) * 64 + 32; asm volatile("s_waitcnt lgkmcnt(0)" ::: "memory"); \
    _Pragma("unroll") for (int r = 0; r < 16; ++r) { C0[r] -= pdl; C1[r] -= pdl; } \
    _Pragma("unroll") for (int d = 0; d < 4; ++d) _Pragma("unroll") for (int r = 0; r < 16; ++r) o[d][r] *= al2[crow(r, h2)]; resc = false; } while (0)
#define TEST9(P0, P1) do { const float mx_ = (srs[0] + srs[1]) + (srs[2] + srs[3]);     \
    if (__builtin_expect(__any(!(mx_ < LIM8)), 0)) MOVE9(P0, P1); \
    lacc += srs; } while (0)
#define DMAK_(tk_, kd_) do { const int tk = (tk_) < NT ? (tk_) : NT - 1; glds16(ksrc + (size_t)tk * KTB, (unsigned)__builtin_amdgcn_readfirstlane((int)(ldsb + F8_KRING + (kd_) * 8192 + (wid % NKP) * 1024))); } while (0)
#define DMAV_(tv_, vd_) do { const int tv = (tv_) < NT ? (tv_) : NT - 1; glds16(vsrc + (size_t)tv * 8192, (unsigned)__builtin_amdgcn_readfirstlane((int)(ldsb + F8_VRING + (vd_) * 8192 + wid * 1024))); } while (0)
#define STEP8(C0, C1, P0, P1, kso, vso, knext, tk_, kd_, tv_, vd_) do { SBAR(); \
    const lds_cptr kp_ = kp0 + (kso); const lds_cptr vp_ = vp0 + (vso); \
    i32x8 vf_[2]; \
      \
    C0 = __builtin_amdgcn_mfma_scale_f32_32x32x64_f8f6f4(kc0_, qc0_, negm, 0, 0, 0, 0, 0, 0); SBAR(); \
    if (NG == 4) { kc0_ = KF8(kp_, 2); } else { vf_[0] = VF8(vp_, 0); } \
    if (NG == 4) { PACK8(P0, P1, 0); PACK8(P0, P1, 2); } else { PACK8(P0, P1, 0); PACK8(P0, P1, 2); PACK8(P0, P1, 4); PACK8(P0, P1, 6); SBAR(); RSUM8(); } \
    SBAR(); \
      \
    C1 = __builtin_amdgcn_mfma_scale_f32_32x32x64_f8f6f4(kc1_, qc0_, negm, 0, 0, 0, 0, 0, 0); SBAR(); \
    if (NG == 4) { kc1_ = KF8(kp_, 3); PACK8(P0, P1, 4); PACK8(P0, P1, 6); SBAR(); RSUM8(); } \
    else { DMAK_(tk_, kd_); DMAV_(tv_, vd_); SBAR(); TEST9(P0, P1); } \
    SBAR(); \
    if (NG == 4) { \
          \
        C0 = __builtin_amdgcn_mfma_scale_f32_32x32x64_f8f6f4(kc0_, qc1_, C0, 0, 0, 0, 0, 0, 0); SBAR(); \
        DMAK_(tk_, kd_); vf_[0] = VF8(vp_, 0); SBAR(); \
          \
        C1 = __builtin_amdgcn_mfma_scale_f32_32x32x64_f8f6f4(kc1_, qc1_, C1, 0, 0, 0, 0, 0, 0); SBAR(); \
        DMAV_(tv_, vd_); SBAR(); TEST9(P0, P1); SBAR(); } \
    if (__builtin_expect(resc, 0)) MOVE9B(C0, C1); \
    SBAR(); \
    _Pragma("unroll") for (int d = 0; d < 4; ++d) { \
        if (d + 1 < 4) vf_[(d + 1) & 1] = VF8(vp_, d + 1); \
        if (d == 3) { const lds_cptr kn_ = kp0 + (knext); kc0_ = KF8(kn_, 0); kc1_ = KF8(kn_, 1); }     \
        SBAR(); \
        o[d] = __builtin_amdgcn_mfma_scale_f32_32x32x64_f8f6f4(pw, vf_[d & 1], o[d], 0, 0, 0, 0, 0, 0); \
        if (d < 2) { _Pragma("unroll") for (int e_ = 0; e_ < 8; ++e_) C0[8 * d + e_] = __builtin_amdgcn_exp2f(C0[8 * d + e_]); PIN(C0); } \
        else       { _Pragma("unroll") for (int e_ = 0; e_ < 8; ++e_) C1[8 * (d - 2) + e_] = __builtin_amdgcn_exp2f(C1[8 * (d - 2) + e_]); PIN(C1); } \
        SBAR(); } \
    } while (0)
    i32x8 kc0_, kc1_, qc0_, qc1_;
    { const lds_cptr kn_ = kp0 + 1 * 8192; kc0_ = KF8(kn_, 0); qc0_ = QF8(0); kc1_ = KF8(kn_, 1); if (NG == 4) qc1_ = QF8(1); else qc1_ = qc0_; }
    WB8(2);
#define STEPQ(C0, C1, P0, P1, t_, q_) STEP8(C0, C1, P0, P1, ((q_) & 3) * 8192, (((q_) + 3) & 3) * 8192, (((q_) + 1) & 3) * 8192, (t_) + 3, ((q_) + 3) & 3, (t_) + 1, ((q_) + 1) & 3)
    int t = 1;
    for (; t + 6 < NT; t += 4) {
        STEPQ(pB0, pB1, pA0, pA1, t, 1); WB8(2);
        STEPQ(pA0, pA1, pB0, pB1, t + 1, 2); WB8(2);
        STEPQ(pB0, pB1, pA0, pA1, t + 2, 3); WB8(2);
        STEPQ(pA0, pA1, pB0, pB1, t + 3, 0); WB8(2);
    }
    STEPQ(pB0, pB1, pA0, pA1, t, 1); WB8(2);
    STEPQ(pA0, pA1, pB0, pB1, t + 1, 2); WB8(2);
    STEP8(pB0, pB1, pA0, pA1, 3 * 8192, 2 * 8192, 0 * 8192, NT, 2, NT, 0); WB8(0);
    const int vs_ = 3;
    {
#pragma unroll
      for (int w_ = 0; w_ < 8; w_ += 2) PACK8(pB0, pB1, w_);
      RSUM8();
      TEST9(pB0, pB1);
      if (resc) MOVE9B(pA0, pA1);
      PV8(vs_ * 8192); }
    { int t2 = tid; asm volatile("" : "+v"(t2)); const int h2 = (t2 >> 5) & 1; float* li2 = (float*)(lds + F8_SCR) + (t2 >> 6) * 64;
      if ((t2 & 15) < 2) { const int q0 = 16 * (t2 & 15) + 4 * ((t2 >> 4) & 3);
#pragma unroll
          for (int r = 0; r < 4; ++r) li2[q0 + r] = lacc[r]; }
      asm volatile("s_waitcnt lgkmcnt(0)" ::: "memory");
#pragma unroll
      for (int r = 0; r < 16; ++r) { const float rl = __builtin_amdgcn_rcpf(li2[crow(r, h2)]);
#pragma unroll
          for (int d = 0; d < 4; ++d) o[d][r] *= rl; } }
    __syncthreads();
#undef DMA8
#undef PIN
#undef KF8
#undef QF8
#undef VF8
#undef STEP8
#undef MOVE9
#undef MOVE9B
#undef TEST9
#undef PACK8
#undef RSUM8
#undef DMAK_
#undef DMAV_
#undef STEPQ
#undef kco
#undef ksrc
#undef vsrc
#undef DMA8K
#undef WB8
#undef QKT8
#undef PV8
#undef PART8
#undef FIN8
#undef RESC8
#undef NEXT3
}
template <int NCB> __device__ __forceinline__ void store_o_lds(const int tid, const f32x16 (&o)[NCB], bf16_t* O, int ldo, char* lds) {
    const int wid = tid >> 6, lane = tid & 63, r32 = lane & 31, hi = lane >> 5;
    constexpr int RB = NCB * 64;
    char* st = lds + wid * 8192;
#pragma unroll
    for (int r = 0; r < 16; ++r) { const int orow = crow(r, hi);
#pragma unroll
        for (int d = 0; d < NCB; ++d) *(bf16_t*)(st + orow * RB + (d * 32 + r32) * 2) = (bf16_t)(cvtpk(o[d][r], 0.f) & 0xffffu); }
    asm volatile("s_waitcnt lgkmcnt(0)" ::: "memory");
    constexpr int CPR = RB / 16;
#pragma unroll
    for (int i = 0; i < (32 * CPR) / 64; ++i) { const int c = lane + 64 * i, row = c / CPR, cc = c % CPR;
        const u32x4 v = *(const u32x4*)(st + row * RB + cc * 16);
        *(u32x4*)((char*)(O + (long)(wid * QBLK + row) * ldo) + cc * 16) = v; }
    asm volatile("s_waitcnt lgkmcnt(0)" ::: "memory");
    __syncthreads();
}
}

struct Args { const float* in[25]; float* out; unsigned char* ws; int ph_lo, ph_hi; };
enum { I_X = 0, I_C, I_CTX, I_CCTX, I_WMOD, I_BMOD, I_LNG, I_LNB, I_WINE, I_WOUTE, I_SINK, I_LQ1, I_LK1, I_LQ2, I_LK2, I_SUBG, I_WINO, I_WOUTO, I_QNG, I_KNG, I_WR, I_BR, I_WG, I_WU, I_WDN };

struct Ctx {
    LAS unsigned char* lds; LAS int* lc; int tid, lane, wave, G, c, gw, NGW;
    const GAS float* const CAS* in; unsigned char* ws;
};

#define INP(i) ((const float*)F.in[i])
__device__ __forceinline__ int lane_id() { int l; asm volatile("v_mbcnt_lo_u32_b32 %0, -1, 0\n\tv_mbcnt_hi_u32_b32 %0, -1, %0" : "=v"(l)); return l; }
__device__ __forceinline__ Ctx make_ctx(int wave_s) {
    Ctx F;
    unsigned t = (unsigned)(wave_s * 64 + lane_id()); asm volatile("" : "+v"(t));
    const CAS char* ka = (const CAS char*)__builtin_amdgcn_kernarg_segment_ptr(); asm volatile("" : "+s"(ka));
    unsigned lb = 0u; asm volatile("" : "+s"(lb));
    F.lds = (LAS unsigned char*)(uintptr_t)lb; F.lc = (LAS int*)(F.lds + LDSCTL_OFF);
    F.tid = (int)t; F.lane = F.tid & 63; F.wave = __builtin_amdgcn_readfirstlane(F.tid >> 6);
    F.G = gridDim.x; F.c = blockIdx.x; F.gw = F.c * NWAVES + F.wave; F.NGW = F.G * NWAVES;
    F.in = (const GAS float* const CAS*)ka; F.ws = (unsigned char*)*(GAS unsigned char* const CAS*)(ka + 208);
    return F;
}
__device__ __forceinline__ void p0_transpose_item(const float* W, int K, int N, bf16_t* WT, int mode, LAS float* scr, int item, int lane) {
    const int nblk = N / 32, kb = item / nblk, nb = item % nblk, k0 = 64 * kb, n0 = 32 * nb;
#pragma unroll 8
    for (int i = 0; i < 32; ++i) { const int kk = 2 * i + (lane >> 5); scr[kk * 33 + (lane & 31)] = W[(size_t)(k0 + kk) * N + n0 + (lane & 31)]; }
    LDS_WAIT(); asm volatile("" ::: "memory");
    const int cc = lane & 7;
#pragma unroll
    for (int j = 0; j < 4; ++j) { const int n = (lane >> 3) + 8 * j; const LAS float* s = scr + (8 * cc) * 33 + n;
        u32x4 o; o.x = cvt_pk_bf16(s[0 * 33], s[1 * 33]); o.y = cvt_pk_bf16(s[2 * 33], s[3 * 33]); o.z = cvt_pk_bf16(s[4 * 33], s[5 * 33]); o.w = cvt_pk_bf16(s[6 * 33], s[7 * 33]);
        const int ng = n0 + n; const int nr = (mode == 0) ? ng : ((ng >> 2) * 8 + (ng & 3) + (mode == 2 ? 4 : 0));
        *(u32x4*)(WT + (size_t)nr * K + k0 + 8 * cc) = o; }
    LDS_WAIT(); asm volatile("" ::: "memory");
}
__device__ __forceinline__ void p0_prologue(const Ctx& F) {
    unsigned char* ws = F.ws;
    for (int blk = F.c; blk < 192; blk += F.G) {
        LAS float* cs = (LAS float*)F.lds;
        for (int i = F.tid; i < 2048; i += NTHREADS) { const float v = (i < 1024) ? INP(I_C)[i] : INP(I_CCTX)[i - 1024]; cs[i] = v / (1.f + __expf(-v)); }
        __syncthreads();
        const int l = blk / 48, cb = (blk % 48) * 128, q = F.tid >> 7, cc = F.tid & 127, col = cb + cc;
        const float* wp = INP(I_WMOD) + (size_t)l * DM * 6144 + (size_t)(q * 256) * 6144 + col;
        float a0 = 0.f, a1 = 0.f;
#pragma unroll 8
        for (int k = 0; k < 256; ++k) { const float w = wp[(size_t)k * 6144]; a0 = fmaf(cs[q * 256 + k], w, a0); a1 = fmaf(cs[1024 + q * 256 + k], w, a1); }
        LAS float* red = (LAS float*)F.lds + 2048;
        red[(0 * 4 + q) * 128 + cc] = a0; red[(1 * 4 + q) * 128 + cc] = a1;
        __syncthreads();
        if (F.tid < 256) { const int s = F.tid >> 7; const float b = INP(I_BMOD)[l * 6144 + col];
            const float v = red[(s * 4 + 0) * 128 + cc] + red[(s * 4 + 1) * 128 + cc] + red[(s * 4 + 2) * 128 + cc] + red[(s * 4 + 3) * 128 + cc] + b;
            ((float*)(ws + WS_MODV))[(l * 2 + s) * 6144 + col] = v; }
        __syncthreads();
    }
    if (F.c == F.G - 1) {
        float* t64 = (float*)(ws + WS_TAB64); float* t128 = (float*)(ws + WS_TAB128);
        const float l2t = 13.287712379549449f;
        for (int i = F.tid; i < 256 * 16; i += NTHREADS) { const int pos = i >> 4, f = i & 15; const float inv = exp2f(-(float)f * (1.f / 16.f) * l2t), a = (float)pos * inv; t64[2 * i] = cosf(a); t64[2 * i + 1] = sinf(a); }
        for (int i = F.tid; i < 256 * 32; i += NTHREADS) { const int pos = i >> 5, f = i & 31; const float inv = exp2f(-(float)f * (1.f / 32.f) * l2t), a = (float)pos * inv; t128[2 * i] = cosf(a); t128[2 * i + 1] = sinf(a); }
        if (F.tid < 2) { const int i = F.tid; float s1 = 0.f, s2 = 0.f;
            for (int k = 0; k < 64; ++k) { s1 += INP(I_LQ1)[i * 64 + k] * INP(I_LK1)[i * 64 + k]; s2 += INP(I_LQ2)[i * 64 + k] * INP(I_LK2)[i * 64 + k]; }
            const float lam_init = 0.8f - 0.6f * expf(-0.3f * (float)(2 * i));
            ((float*)(ws + WS_LAM))[i] = expf(s1) - expf(s2) + lam_init; }
    }
    LAS float* scr = (LAS float*)(F.lds + 32768 + F.wave * 8704);
    constexpr int I_INE = 16 * 72, I_INO = 16 * 48, I_OUT = 16 * 32, I_GU = 16 * 16, I_DN = 8 * 32;
    constexpr int N_A = 2 * I_INE, N_B = 2 * I_INO, N_C = 4 * I_OUT, N_D = 64 * I_GU, N_E = 64 * I_GU, N_F = 64 * I_DN;
    constexpr int NITEMS = N_A + N_B + N_C + N_D + N_E + N_F;
    for (int it = F.gw; it < NITEMS; it += F.NGW) {
        int r = it;
        if (r < N_A) { const int i = r / I_INE; p0_transpose_item(INP(I_WINE) + (size_t)i * DM * EVEN_IN, DM, EVEN_IN, (bf16_t*)(ws + WS_WINE) + (size_t)i * EVEN_IN * DM, 0, scr, r % I_INE, F.lane); continue; } r -= N_A;
        if (r < N_B) { const int i = r / I_INO; p0_transpose_item(INP(I_WINO) + (size_t)i * DM * ODD_IN, DM, ODD_IN, (bf16_t*)(ws + WS_WINO) + (size_t)i * ODD_IN * DM, 0, scr, r % I_INO, F.lane); continue; } r -= N_B;
        if (r < N_C) { const int l = r / I_OUT; const float* src = ((l & 1) ? INP(I_WOUTO) : INP(I_WOUTE)) + (size_t)(l >> 1) * DM * DM;
            p0_transpose_item(src, DM, DM, (bf16_t*)(ws + WS_WOUT) + (size_t)l * DM * DM, 0, scr, r % I_OUT, F.lane); continue; } r -= N_C;
        if (r < N_D) { const int m = r / I_GU; p0_transpose_item(INP(I_WG) + (size_t)m * DM * DEXP, DM, DEXP, (bf16_t*)(ws + WS_WGU) + (size_t)m * 1024 * DM, 1, scr, r % I_GU, F.lane); continue; } r -= N_D;
        if (r < N_E) { const int m = r / I_GU; p0_transpose_item(INP(I_WU) + (size_t)m * DM * DEXP, DM, DEXP, (bf16_t*)(ws + WS_WGU) + (size_t)m * 1024 * DM, 2, scr, r % I_GU, F.lane); continue; } r -= N_E;
        { const int m = r / I_DN; p0_transpose_item(INP(I_WDN) + (size_t)m * DEXP * DM, DEXP, DM, (bf16_t*)(ws + WS_WD) + (size_t)m * DM * DEXP, 0, scr, r % I_DN, F.lane); }
    }
}

__device__ __forceinline__ void load_tstart(const Ctx& F, int l) {
    if (F.tid == 0) { unsigned* cw = (unsigned*)(F.ws + WS_CTL) + CW_CNT + l * 16 * 64; int acc = 0;
        for (int e = 0; e < 16; ++e) { const int n = (int)__hip_atomic_load(cw + e * 64, RLX_AGENT); F.lc[LC_ECNT + e] = n; F.lc[LC_TSTART + e] = acc; acc += (n + 255) >> 8; }
        F.lc[LC_TSTART + 16] = acc; }
    __syncthreads();
}

__device__ __forceinline__ void phase_a(const Ctx& F, int l, float* out) {
    unsigned char* ws = F.ws;
    float* XB = (float*)(ws + WS_XB); const float* X1B = (const float*)(ws + WS_X1B); bf16_t* HB = (bf16_t*)(ws + WS_HB);
    const bf16_t* MO = (const bf16_t*)(ws + WS_QKV); const i32x4* ROUTE = (const i32x4*)(ws + WS_ROUTE); const float* MODV = (const float*)(ws + WS_MODV);
    if (l > 0) load_tstart(F, l - 1);
    const int row_lo = (l == 4) ? NCTX : 0;
    f32x4 Qg2[4], Qg[4], Qb[4], Qsh[4], Qsc[4];
#pragma unroll
    for (int j = 0; j < 4; ++j) { const int col = 4 * F.lane + 256 * j; const int lp = l > 0 ? l - 1 : 0, lq = l < 4 ? l : 3;
        Qg2[j] = *(const f32x4*)(MODV + (lp * 2 + 0) * 6144 + 5120 + col);
        Qg[j] = *(const f32x4*)(INP(I_LNG) + (lp * 2 + 1) * DM + col); Qb[j] = *(const f32x4*)(INP(I_LNB) + (lp * 2 + 1) * DM + col);
        Qsh[j] = *(const f32x4*)(MODV + (lq * 2 + 0) * 6144 + col); Qsc[j] = *(const f32x4*)(MODV + (lq * 2 + 0) * 6144 + 1024 + col); }
    for (int row = row_lo + F.gw; row < MROWS; row += F.NGW) {
        const int isctx = row < NCTX ? 1 : 0;
        f32x4 v[4];
        if (l == 0) {
            const float* src = isctx ? INP(I_CTX) + (size_t)row * DM : INP(I_X) + (size_t)(row - NCTX) * DM;
#pragma unroll
            for (int j = 0; j < 4; ++j) v[j] = *(const f32x4*)(src + 4 * F.lane + 256 * j);
        } else {
            const float* mp = MODV + ((l - 1) * 2 + isctx) * 6144;
            const i32x4 rt = ROUTE[row];
            const int e0 = rt.x >> 15, e1 = rt.y >> 15; const float w0 = __int_as_float(rt.z), w1 = __int_as_float(rt.w);
            const bf16_t* m0 = MO + (size_t)(F.lc[LC_TSTART + e0] * 256 + (rt.x & 32767)) * DM; const bf16_t* m1 = MO + (size_t)(F.lc[LC_TSTART + e1] * 256 + (rt.y & 32767)) * DM;
            float s = 0.f;
#pragma unroll
            for (int j = 0; j < 4; ++j) { const int col = 4 * F.lane + 256 * j;
                const f32x4 x1 = __builtin_nontemporal_load((const f32x4*)(X1B + (size_t)row * DM + col));     f32x4 g2 = Qg2[j]; if (isctx) g2 = *(const f32x4*)(mp + 5120 + col);
                const u32x2 a = __builtin_nontemporal_load((const u32x2*)(m0 + col)), b = __builtin_nontemporal_load((const u32x2*)(m1 + col));
                f32x4 mo; mo.x = w0 * bf_lo(a.x) + w1 * bf_lo(b.x); mo.y = w0 * bf_hi(a.x) + w1 * bf_hi(b.x); mo.z = w0 * bf_lo(a.y) + w1 * bf_lo(b.y); mo.w = w0 * bf_hi(a.y) + w1 * bf_hi(b.y);
                v[j] = ALPHA * x1 + g2 * mo; s += (v[j].x + v[j].y) + (v[j].z + v[j].w); }
            const float mean = wave_sum(s) * (1.f / DM); float s2 = 0.f;
#pragma unroll
            for (int j = 0; j < 4; ++j) { v[j] = v[j] - mean; s2 += (v[j].x * v[j].x + v[j].y * v[j].y) + (v[j].z * v[j].z + v[j].w * v[j].w); }
            const float rstd = 1.f / sqrtf(wave_sum(s2) * (1.f / DM) + LN_EPS);
#pragma unroll
            for (int j = 0; j < 4; ++j) { const int col = 4 * F.lane + 256 * j;
                const f32x4 g = Qg[j], b = Qb[j];
                v[j] = v[j] * rstd * g + b; }
        }
        if (l == 4) {
#pragma unroll
            for (int j = 0; j < 4; ++j) __builtin_nontemporal_store(v[j], (f32x4*)(out + (size_t)(row - NCTX) * DM + 4 * F.lane + 256 * j));
        } else {
            const float* mq = MODV + (l * 2 + isctx) * 6144;
#pragma unroll
            for (int j = 0; j < 4; ++j) { const int col = 4 * F.lane + 256 * j;
                *(f32x4*)(XB + (size_t)row * DM + col) = v[j];
                f32x4 sh = Qsh[j], sc = Qsc[j]; if (isctx) { sh = *(const f32x4*)(mq + col); sc = *(const f32x4*)(mq + 1024 + col); }
                const f32x4 h = v[j] * (1.f + sc) + sh;
                u32x2 w; w.x = cvt_pk_bf16(h.x, h.y); w.y = cvt_pk_bf16(h.z, h.w);
                *(u32x2*)(HB + (size_t)row * DM + col) = w; }
        }
    }
}

__device__ __forceinline__ void kmax_begin(const Ctx& F) { if (F.tid < 16) F.lc[LC_KMAX + F.tid] = 0; __syncthreads(); }
__device__ __forceinline__ void kmax_end(const Ctx& F, int l, int nheads) {
    __syncthreads();
    if (F.tid < nheads) { const unsigned v = (unsigned)F.lc[LC_KMAX + F.tid]; if (v) atomicMax((unsigned*)(F.ws + WS_CTL) + CW_KMAX + (l * 16 + F.tid) * 64, v); }
}
__device__ __forceinline__ void rope8(u32x4& a, u32x4& b, const float* T) {
    unsigned* pa = (unsigned*)&a; unsigned* pb = (unsigned*)&b;
#pragma unroll
    for (int j = 0; j < 4; ++j) { const f32x4 cs = *(const f32x4*)(T + 4 * j);
        const float x10 = bf_lo(pa[j]), x11 = bf_hi(pa[j]), x20 = bf_lo(pb[j]), x21 = bf_hi(pb[j]);
        pa[j] = cvt_pk_bf16(x10 * cs.x - x20 * cs.y, x11 * cs.z - x21 * cs.w);
        pb[j] = cvt_pk_bf16(x10 * cs.y + x20 * cs.x, x11 * cs.w + x21 * cs.z); }
}
__device__ __forceinline__ float ss8(const u32x4& a) {
    const unsigned* p = (const unsigned*)&a; float s = 0.f;
#pragma unroll
    for (int j = 0; j < 4; ++j) { const float lo = bf_lo(p[j]), hi = bf_hi(p[j]); s = fmaf(lo, lo, s); s = fmaf(hi, hi, s); }
    return s;
}
__device__ __forceinline__ u32x2 pk8(const u32x4& a) {
    u32x2 w; w.x = att::f8x4(bf_lo(a.x), bf_hi(a.x), bf_lo(a.y), bf_hi(a.y)); w.y = att::f8x4(bf_lo(a.z), bf_hi(a.z), bf_lo(a.w), bf_hi(a.w)); return w; }
__device__ __forceinline__ void vimg_load(const Ctx& F, const bf16_t* QKV, int ld, int col0, int it2, unsigned (&raw)[64]) {
    const int it = it2 >> 1, h = it / NTILE, tile = it - h * NTILE; const int n = (it2 & 1) * 64 + F.lane;
    const bf16_t* src = QKV + (size_t)(tile * 64) * ld + col0 + h * 128 + n;
#pragma unroll
    for (int k = 0; k < 64; ++k) raw[k] = (unsigned)__builtin_nontemporal_load(src + (size_t)k * ld);
}
__device__ __forceinline__ void vimg_store(const Ctx& F, int it2, const unsigned (&raw)[64]) {
    const int it = it2 >> 1; const int n = (it2 & 1) * 64 + F.lane; unsigned char* img = F.ws + WS_VF8 + (size_t)it * 8192;
#define VRAW(i) __uint_as_float(raw[i] << 16)
#pragma unroll
    for (int c = 0; c < 4; ++c) { u32x4 w;
#pragma unroll
        for (int d = 0; d < 4; ++d) { const int j = 16 * c + 4 * d, hh = j >> 5, e = j & 31;
            w[d] = att::f8x4(VRAW(att::kap(hh, e)), VRAW(att::kap(hh, e + 1)), VRAW(att::kap(hh, e + 2)), VRAW(att::kap(hh, e + 3))); }
        *(u32x4*)(img + att::vimg_off(n, 16 * c)) = w; }
#undef VRAW
}
__device__ __forceinline__ int vimg_first(const Ctx& F) { return (F.gw + F.NGW / 2) % F.NGW; }
__device__ __forceinline__ void vimg_finish(const Ctx& F, const bf16_t* QKV, int ld, int col0, int nheads, unsigned (&raw)[64]) {
    const int nit = 2 * nheads * NTILE; int it2 = vimg_first(F);
    if (it2 < nit) vimg_store(F, it2, raw);
    for (it2 += F.NGW; it2 < nit; it2 += F.NGW) { vimg_load(F, QKV, ld, col0, it2, raw); vimg_store(F, it2, raw); }
}
__device__ __forceinline__ void phase_c_even(const Ctx& F, int l) {
    bf16_t* QKV = (bf16_t*)(F.ws + WS_QKV); const float* T = (const float*)(F.ws + WS_TAB64); unsigned char* KF8 = F.ws + WS_KF8;
    kmax_begin(F);
    unsigned vraw[64];
    if (vimg_first(F) < 2 * 4 * NTILE) vimg_load(F, QKV, EVEN_IN, 1792, vimg_first(F), vraw);
    const int sub = F.lane >> 2, q = F.lane & 3;
    const int e1 = (q >> 1) * 32 + (q & 1) * 8;
    const int nitems = SEQ * 10;
    {
        int it = F.gw * 16 + sub; u32x4 a = {0u, 0u, 0u, 0u}, b = a; bf16_t* p = QKV;
        if (it < nitems) { const int t = it / 10, hd = it - t * 10; p = QKV + (size_t)(NCTX + t) * EVEN_IN + (hd < 2 ? 512 + 64 * hd : 1280 + 64 * (hd - 2)) + e1; a = *(const u32x4*)p; b = *(const u32x4*)(p + 16); }
        while (it < nitems) {
            const int itn = it + F.NGW * 16; u32x4 an = a, bn = b; bf16_t* pn = p;
            if (itn < nitems) { const int tn = itn / 10, hn = itn - tn * 10; pn = QKV + (size_t)(NCTX + tn) * EVEN_IN + (hn < 2 ? 512 + 64 * hn : 1280 + 64 * (hn - 2)) + e1; an = *(const u32x4*)pn; bn = *(const u32x4*)(pn + 16); }
            const int t = it / 10, hd = it - t * 10;
            const int pos = (q >> 1) ? (t & 63) : (t >> 6);
            float ss = ss8(a) + ss8(b);
            rope8(a, b, T + (pos * 16 + (q & 1) * 8) * 2);
            *(u32x4*)p = a; *(u32x4*)(p + 16) = b;
            if (hd >= 2) {
                const int row = NCTX + t; unsigned char* img = KF8 + ((size_t)(hd - 2) * NTILE + (row >> 6)) * 4096;
                *(u32x2*)(img + att::kimg_off<64>(row & 63, e1)) = pk8(a); *(u32x2*)(img + att::kimg_off<64>(row & 63, e1 + 16)) = pk8(b); }
            ss = xor2_add(xor1_add(ss));
            if (q == 0 && hd >= 2) __hip_atomic_fetch_max((LAS unsigned*)(F.lc + LC_KMAX) + (hd - 2), __float_as_uint(ss), __ATOMIC_RELAXED, __HIP_MEMORY_SCOPE_WORKGROUP);
            it = itn; a = an; b = bn; p = pn;
        }
    }
    for (int it = F.gw * 16 + sub; it < NCTX * 8; it += F.NGW * 16) {
        const int row = it >> 3, hd = it & 7;
        const bf16_t* p = QKV + (size_t)row * EVEN_IN + 1280 + 64 * hd + 16 * q;
        const u32x4 a = *(const u32x4*)p, b = *(const u32x4*)(p + 8);
        float ss = ss8(a) + ss8(b);
        { unsigned char* img = KF8 + ((size_t)hd * NTILE + (row >> 6)) * 4096; const u32x2 w0 = pk8(a), w1 = pk8(b);
          *(u32x4*)(img + att::kimg_off<64>(row & 63, 16 * q)) = (u32x4){w0.x, w0.y, w1.x, w1.y}; }
        ss = xor2_add(xor1_add(ss));
        if (q == 0) __hip_atomic_fetch_max((LAS unsigned*)(F.lc + LC_KMAX) + hd, __float_as_uint(ss), __ATOMIC_RELAXED, __HIP_MEMORY_SCOPE_WORKGROUP);
    }
    vimg_finish(F, QKV, EVEN_IN, 1792, 4, vraw);
    kmax_end(F, l, 8);
}
__device__ __forceinline__ void phase_c_odd(const Ctx& F, int li, int l) {
    bf16_t* QKV = (bf16_t*)(F.ws + WS_QKV); const float* T = (const float*)(F.ws + WS_TAB128); unsigned char* KF8 = F.ws + WS_KF8;
    const float* g = INP(I_KNG) + li * 128;
    kmax_begin(F);
    const int sub = F.lane >> 3, q = F.lane & 7;
    const int e1 = (q >> 2) * 64 + (q & 3) * 8;
    const int nitems = MROWS * 2;
    unsigned vraw[64];
    if (vimg_first(F) < 2 * 2 * NTILE) vimg_load(F, QKV, ODD_IN, 1280, vimg_first(F), vraw);
    {
        int it = F.gw * 8 + sub; u32x4 a = {0u, 0u, 0u, 0u}, b = a; bf16_t* p = QKV;
        if (it < nitems) { p = QKV + (size_t)(it >> 1) * ODD_IN + 1024 + (it & 1) * 128 + e1; a = *(const u32x4*)p; b = *(const u32x4*)(p + 32); }
        while (it < nitems) {
            const int itn = it + F.NGW * 8; u32x4 an = a, bn = b; bf16_t* pn = p;
            if (itn < nitems) { pn = QKV + (size_t)(itn >> 1) * ODD_IN + 1024 + (itn & 1) * 128 + e1; an = *(const u32x4*)pn; bn = *(const u32x4*)(pn + 32); }
            const int row = it >> 1, hd = it & 1;
            float ss = ss8(a) + ss8(b);
            ss = half8_add(xor2_add(xor1_add(ss)));
            const float rs = 1.f / sqrtf(ss * (1.f / 128.f) + QK_EPS);
            { unsigned* pa = (unsigned*)&a; unsigned* pb = (unsigned*)&b;
#pragma unroll
              for (int j = 0; j < 4; ++j) { const f32x2 ga = *(const f32x2*)(g + e1 + 2 * j), gb = *(const f32x2*)(g + e1 + 32 + 2 * j);
                  pa[j] = cvt_pk_bf16(bf_lo(pa[j]) * rs * ga.x, bf_hi(pa[j]) * rs * ga.y); pb[j] = cvt_pk_bf16(bf_lo(pb[j]) * rs * gb.x, bf_hi(pb[j]) * rs * gb.y); } }
            float s2 = ss8(a) + ss8(b);
            s2 = half8_add(xor2_add(xor1_add(s2)));
            if (q == 0) __hip_atomic_fetch_max((LAS unsigned*)(F.lc + LC_KMAX) + hd, __float_as_uint(s2), __ATOMIC_RELAXED, __HIP_MEMORY_SCOPE_WORKGROUP);
            if (row >= NCTX) { const int t = row - NCTX, pos = (q >> 2) ? (t & 63) : (t >> 6); rope8(a, b, T + (pos * 32 + (q & 3) * 8) * 2); }
            *(u32x4*)p = a; *(u32x4*)(p + 32) = b;
            { unsigned char* img = KF8 + ((size_t)hd * NTILE + (row >> 6)) * 8192;
              *(u32x2*)(img + att::kimg_off<128>(row & 63, e1)) = pk8(a); *(u32x2*)(img + att::kimg_off<128>(row & 63, e1 + 32)) = pk8(b); }
            it = itn; a = an; b = bn; p = pn;
        }
    }
    vimg_finish(F, QKV, ODD_IN, 1280, 2, vraw);
    kmax_end(F, l, 2);
}

#define ATT_COMMON const bf16_t* QKV = (const bf16_t*)(F.ws + WS_QKV); bf16_t* OB = (bf16_t*)(F.ws + WS_OB); float* SCR = (float*)(F.ws + WS_YB); \
    char* lds = (char*)(unsigned char*)F.lds; (void)SCR; (void)OB;
#define EPI_TID() int te = F.wave * 64 + lane_id(); asm volatile("" : "+v"(te)); const int lane = te & 63, wid = te >> 6, r32 = lane & 31; (void)r32; (void)wid; (void)lane
__device__ __forceinline__ void phase_d_b0(const Ctx& F, int l) {
    ATT_COMMON
    for (int u = (F.c + F.G - 8) % F.G; u < 260; u += F.G) {
        const bool isctx = u >= 256; const int h = isctx ? u - 256 : (u >> 6); const int row0 = isctx ? 0 : NCTX + (u & 63) * 256; const int seq = isctx ? NCTX : MROWS;
        f32x16 o[4];
        const float kmaxC = sqrtf(__uint_as_float(__hip_atomic_load((unsigned*)(F.ws + WS_CTL) + CW_KMAX + (l * 16 + 2 * h) * 64, RLX_AGENT))) * (0.125f * LOG2E * 1.02f);
#if ATT_F8
        att::attn_core_f8<64>(F.wave * 64 + lane_id(), QKV + (size_t)row0 * EVEN_IN + 768 + (2 * h) * 64, EVEN_IN, F.ws + WS_KF8 + (size_t)(2 * h) * NTILE * 4096, F.ws + WS_VF8 + (size_t)h * NTILE * 8192, seq, F.lds, o, nullptr, (const float*)(F.ws + WS_TAB64), isctx ? -1 : (u & 63) * 256, kmaxC);
#else
        att::attn_core_il<64>(F.tid, QKV + (size_t)row0 * EVEN_IN + 768 + (2 * h) * 64, EVEN_IN, QKV + 1280 + (2 * h) * 64, QKV + 1792 + h * 128, EVEN_IN, seq, kmaxC, F.lds, o, nullptr, (const float*)(F.ws + WS_TAB64), isctx ? -1 : (u & 63) * 256);
#endif
        EPI_TID();
        float* scr = SCR + (size_t)u * 32768 + (size_t)wid * 4096 + lane;
#pragma unroll
        for (int r = 0; r < 16; ++r)
#pragma unroll
            for (int d = 0; d < 4; ++d) scr[(r * 4 + d) * 64] = o[d][r];
    }
}
__device__ __forceinline__ void phase_d_b1(const Ctx& F, int li, int l) { const int lam_layer = l;
    ATT_COMMON
    for (int u = (F.c + F.G - 8) % F.G; u < 260; u += F.G) {
        const bool isctx = u >= 256; const int h = isctx ? u - 256 : (u >> 6); const int row0 = isctx ? 0 : NCTX + (u & 63) * 256; const int seq = isctx ? NCTX : MROWS;
        f32x16 o[4];
        const float kmaxC = sqrtf(__uint_as_float(__hip_atomic_load((unsigned*)(F.ws + WS_CTL) + CW_KMAX + (l * 16 + 2 * h + 1) * 64, RLX_AGENT))) * (0.125f * LOG2E * 1.02f);
#if ATT_F8
        att::attn_core_f8<64>(F.wave * 64 + lane_id(), QKV + (size_t)row0 * EVEN_IN + 768 + (2 * h + 1) * 64, EVEN_IN, F.ws + WS_KF8 + (size_t)(2 * h + 1) * NTILE * 4096, F.ws + WS_VF8 + (size_t)h * NTILE * 8192, seq, F.lds, o, nullptr, (const float*)(F.ws + WS_TAB64), isctx ? -1 : (u & 63) * 256, kmaxC);
#else
        att::attn_core_il<64>(F.tid, QKV + (size_t)row0 * EVEN_IN + 768 + (2 * h + 1) * 64, EVEN_IN, QKV + 1280 + (2 * h + 1) * 64, QKV + 1792 + h * 128, EVEN_IN, seq, kmaxC, F.lds, o, nullptr, (const float*)(F.ws + WS_TAB64), isctx ? -1 : (u & 63) * 256);
#endif
        EPI_TID();
        const float* scr = SCR + (size_t)u * 32768 + (size_t)wid * 4096 + lane;
        const float lam = __hip_atomic_load((float*)(F.ws + WS_LAM) + li, RLX_AGENT);
        const float lam_init = 0.8f - 0.6f * expf(-0.3f * (float)lam_layer);
        const float* sg = INP(I_SUBG) + li * 128;
#pragma unroll
        for (int r = 0; r < 16; ++r) { float s = 0.f;
#pragma unroll
            for (int d = 0; d < 4; ++d) { const float v = scr[(r * 4 + d) * 64] - lam * o[d][r]; o[d][r] = v; s += v * v; }
            s = rows32_add(row16_add(half8_add(xor2_add(xor1_add(s)))));
            s = (1.f - lam_init) / sqrtf(s * (1.f / 128.f) + SUBLN_EPS);
#pragma unroll
            for (int d = 0; d < 4; ++d) o[d][r] *= s * sg[d * 32 + r32]; }
        att::store_o_lds<4>(te, o, OB + (size_t)row0 * DM + 512 + h * 128, DM, lds);
    }
}
__device__ __forceinline__ void phase_d_a(const Ctx& F, int li) {
    ATT_COMMON
    unsigned* tk = (unsigned*)(F.ws + WS_CTL) + CW_ATK + li * 64;
    unsigned nxt = 0;
    if (F.tid == 0) nxt = __hip_atomic_fetch_add(tk, 1u, __ATOMIC_RELAXED, __HIP_MEMORY_SCOPE_AGENT);
    for (;;) {
        if (F.tid == 0) F.lc[LC_TK] = (int)nxt;
        __syncthreads();
        const int u = __builtin_amdgcn_readfirstlane(F.lc[LC_TK]);
        if (u >= 520) break;
        if (F.tid == 0) nxt = __hip_atomic_fetch_add(tk, 1u, __ATOMIC_RELAXED, __HIP_MEMORY_SCOPE_AGENT);
        const bool isctx = u >= 512; const int hq = isctx ? u - 512 : (u >> 6); const int q0lat = isctx ? 0 : (u & 63) * 256; const int row0 = isctx ? 0 : NCTX + q0lat; const int seq = isctx ? NCTX : NCTX + 512;
        const int kvh = hq >> 2; const float sink = INP(I_SINK)[li * 8 + hq];
        f32x16 o[2];
        att::attn_core<64, 64, true, 2>(F.wave * 64 + lane_id(), QKV + (size_t)row0 * EVEN_IN + hq * 64, EVEN_IN, QKV + 512 + kvh * 64, QKV + 640 + kvh * 64, EVEN_IN, seq, q0lat, sink * 8.f, 1.f, lds, o, (const float*)(F.ws + WS_TAB64), isctx ? -1 : q0lat);
        EPI_TID();
        att::store_o_lds<2>(te, o, OB + (size_t)row0 * DM + hq * 64, DM, lds);
    }
}
__device__ __forceinline__ void phase_d_odd(const Ctx& F, int l) {
    const bf16_t* QKV = (const bf16_t*)(F.ws + WS_QKV); bf16_t* OB = (bf16_t*)(F.ws + WS_OB);
    char* lds = (char*)(unsigned char*)F.lds;
    const int nun = (l == DEPTH - 1) ? 512 : 520;
    unsigned* tk = (unsigned*)(F.ws + WS_CTL) + CW_ATK + (8 + l) * 64;
    int us = F.c; unsigned nxt = 0u;
    for (;;) {
        int u = us;
        if (us < 512) { us += F.G;
            if (us >= 512 && nun > 512 && F.tid == 0) nxt = __hip_atomic_fetch_add(tk, 1u, __ATOMIC_RELAXED, __HIP_MEMORY_SCOPE_AGENT); }
        else {
            if (nun <= 512) break;
            if (F.tid == 0) F.lc[LC_TK] = (int)nxt;
            __syncthreads();
            u = 512 + __builtin_amdgcn_readfirstlane(F.lc[LC_TK]);
            if (u >= nun) break;
            if (F.tid == 0) nxt = __hip_atomic_fetch_add(tk, 1u, __ATOMIC_RELAXED, __HIP_MEMORY_SCOPE_AGENT);
        }
        const bool isctx = u >= 512; const int hq = isctx ? u - 512 : (u >> 6); const int row0 = isctx ? 0 : NCTX + (u & 63) * 256; const int seq = isctx ? NCTX : MROWS;
        const int kvh = hq >> 2;
        f32x16 o[4];
        const float kmaxC = sqrtf(__uint_as_float(__hip_atomic_load((unsigned*)(F.ws + WS_CTL) + CW_KMAX + (l * 16 + kvh) * 64, RLX_AGENT))) * (0.088388347648318440f * LOG2E * 1.02f);
#if ATT_F8
        att::attn_core_f8<128>(F.wave * 64 + lane_id(), QKV + (size_t)row0 * ODD_IN + hq * 128, ODD_IN, F.ws + WS_KF8 + (size_t)kvh * NTILE * 8192, F.ws + WS_VF8 + (size_t)kvh * NTILE * 8192, seq, F.lds, o, INP(I_QNG) + (l >> 1) * 128, (const float*)(F.ws + WS_TAB128), isctx ? -1 : (u & 63) * 256, kmaxC);
#else
        att::attn_core_il<128>(F.tid, QKV + (size_t)row0 * ODD_IN + hq * 128, ODD_IN, QKV + 1024 + kvh * 128, QKV + 1280 + kvh * 128, ODD_IN, seq, kmaxC, F.lds, o, INP(I_QNG) + (l >> 1) * 128, (const float*)(F.ws + WS_TAB128), isctx ? -1 : (u & 63) * 256);
#endif
        EPI_TID();
        att::store_o_lds<4>(te, o, OB + (size_t)row0 * DM + hq * 128, DM, lds);
    }
}


__device__ __forceinline__ void ctx_outproj_mini(const Ctx& F, const bf16_t* O, const bf16_t* Wt, bf16_t* Y) {
    for (int blk = F.c; blk < 256; blk += F.G) {
        const int rb = blk >> 4, cb = blk & 15, fr = F.lane & 15, fq = F.lane >> 4, kb = F.wave * 128;
        f32x4 acc[4];
#pragma unroll
        for (int n = 0; n < 4; ++n) acc[n] = (f32x4){0.f, 0.f, 0.f, 0.f};
        const bf16_t* ap = O + (size_t)(rb * 16 + fr) * DM + kb + 8 * fq;
        const bf16_t* bp = Wt + (size_t)(cb * 64 + fr) * DM + kb + 8 * fq;
#pragma unroll
        for (int k = 0; k < 4; ++k) { const bf16x8 a = *(const bf16x8*)(ap + 32 * k);
#pragma unroll
            for (int n = 0; n < 4; ++n) { const bf16x8 b = *(const bf16x8*)(bp + (size_t)(16 * n) * DM + 32 * k); acc[n] = __builtin_amdgcn_mfma_f32_16x16x32_bf16(b, a, acc[n], 0, 0, 0); } }
        LAS float* red = (LAS float*)F.lds + F.wave * 1024;
#pragma unroll
        for (int n = 0; n < 4; ++n) *(LAS f32x4*)(red + fr * 64 + 16 * n + 4 * fq) = acc[n];
        __syncthreads();
        { const int e = F.tid * 2; float s0 = 0.f, s1 = 0.f;
#pragma unroll
          for (int w = 0; w < 8; ++w) { const f32x2 v = *(const LAS f32x2*)((LAS float*)F.lds + w * 1024 + e); s0 += v.x; s1 += v.y; }
          const int row = e >> 6, col = e & 63;
          *(unsigned*)(Y + (size_t)(rb * 16 + row) * DM + cb * 64 + col) = cvt_pk_bf16(s0, s1); }
        __syncthreads();
    }
}
__device__ __forceinline__ void phase_f(const Ctx& F, int l, int row_lo, bool dry = false) {
    unsigned char* ws = F.ws;
    const float* XB = (const float*)(ws + WS_XB); const bf16_t* YB = (const bf16_t*)(ws + WS_YB); float* X1B = (float*)(ws + WS_X1B); bf16_t* HB = (bf16_t*)(ws + WS_HB);
    const float* MODV = (const float*)(ws + WS_MODV); i32x4* ROUTE = (i32x4*)(ws + WS_ROUTE); int* IDX = (int*)(ws + WS_IDX);
    LAS float* wr_l = (LAS float*)F.lds;
    for (int i = F.tid; i < 16384; i += NTHREADS) wr_l[(i & 15) * 1024 + (i >> 4)] = INP(I_WR)[i];
    if (F.tid < 16) F.lc[LC_LCNT + F.tid] = 0;
    __syncthreads();
    float br[16];
#pragma unroll
    for (int e = 0; e < 16; ++e) br[e] = INP(I_BR)[e];
    f32x4 Pg[4], Pb[4], Pg1[4], Psh[4], Psc[4];
    { const float* mpL = MODV + (l * 2 + 0) * 6144;
#pragma unroll
      for (int j = 0; j < 4; ++j) { const int col = 4 * F.lane + 256 * j;
          Pg[j] = *(const f32x4*)(INP(I_LNG) + (l * 2) * DM + col); Pb[j] = *(const f32x4*)(INP(I_LNB) + (l * 2) * DM + col);
          Pg1[j] = *(const f32x4*)(mpL + 2048 + col); Psh[j] = *(const f32x4*)(mpL + 3072 + col); Psc[j] = *(const f32x4*)(mpL + 4096 + col); } }
    int nr = 0;
    for (int row0 = row_lo + F.gw; row0 < MROWS; row0 += 2 * F.NGW) {
        const bool vB = row0 + F.NGW < MROWS;
        int rw[2]; rw[0] = row0; rw[1] = vB ? row0 + F.NGW : row0;
        f32x4 v[2][4]; const float* mpp[2];
#pragma unroll
        for (int rI = 0; rI < 2; ++rI) { const int row = rw[rI]; const int isctx = row < NCTX ? 1 : 0; const float* mp = MODV + (l * 2 + isctx) * 6144; mpp[rI] = mp;
#pragma unroll
            for (int j = 0; j < 4; ++j) { const int col = 4 * F.lane + 256 * j;
                const f32x4 x = __builtin_nontemporal_load((const f32x4*)(XB + (size_t)row * DM + col)); f32x4 g1 = Pg1[j]; if (isctx) g1 = *(const f32x4*)(mp + 2048 + col); const u32x2 yw = __builtin_nontemporal_load((const u32x2*)(YB + (size_t)row * DM + col));
                const f32x4 y = {bf_lo(yw.x), bf_hi(yw.x), bf_lo(yw.y), bf_hi(yw.y)};
                v[rI][j] = ALPHA * x + g1 * y; } }
#pragma unroll
        for (int rI = 0; rI < 2; ++rI) { const int row = rw[rI]; const float* mp = mpp[rI]; const bool st = (rI == 0) || vB;
            float s = 0.f;
#pragma unroll
            for (int j = 0; j < 4; ++j) s += (v[rI][j].x + v[rI][j].y) + (v[rI][j].z + v[rI][j].w);
            const float mean = wave_sum(s) * (1.f / DM); float s2 = 0.f;
#pragma unroll
            for (int j = 0; j < 4; ++j) { v[rI][j] = v[rI][j] - mean; s2 += (v[rI][j].x * v[rI][j].x + v[rI][j].y * v[rI][j].y) + (v[rI][j].z * v[rI][j].z + v[rI][j].w * v[rI][j].w); }
            const float rstd = 1.f / sqrtf(wave_sum(s2) * (1.f / DM) + LN_EPS);
#pragma unroll
            for (int j = 0; j < 4; ++j) { const int col = 4 * F.lane + 256 * j;
                const f32x4 g = Pg[j], b = Pb[j];
                v[rI][j] = v[rI][j] * rstd * g + b;
                if (st) *(f32x4*)(X1B + (size_t)row * DM + col) = v[rI][j];
                f32x4 sh = Psh[j], sc = Psc[j]; if (row < NCTX) { sh = *(const f32x4*)(mp + 3072 + col); sc = *(const f32x4*)(mp + 4096 + col); }
                v[rI][j] = v[rI][j] * (1.f + sc) + sh;
                u32x2 w; w.x = cvt_pk_bf16(v[rI][j].x, v[rI][j].y); w.y = cvt_pk_bf16(v[rI][j].z, v[rI][j].w);
                if (st) *(u32x2*)(HB + (size_t)row * DM + col) = w; } }
        float pa[2][16];
#pragma unroll
        for (int e = 0; e < 16; ++e) { float a0 = 0.f, a1 = 0.f;
#pragma unroll
            for (int j = 0; j < 4; ++j) { const f32x4 w = *(const LAS f32x4*)(wr_l + e * 1024 + 4 * F.lane + 256 * j);
                a0 = fmaf(v[0][j].x, w.x, a0); a0 = fmaf(v[0][j].y, w.y, a0); a0 = fmaf(v[0][j].z, w.z, a0); a0 = fmaf(v[0][j].w, w.w, a0);
                a1 = fmaf(v[1][j].x, w.x, a1); a1 = fmaf(v[1][j].y, w.y, a1); a1 = fmaf(v[1][j].z, w.z, a1); a1 = fmaf(v[1][j].w, w.w, a1); }
            pa[0][e] = a0; pa[1][e] = a1; }
        const bool b3 = (F.lane & 8) != 0, b2 = (F.lane & 4) != 0;
        const int el = 4 * (F.lane >> 4) + 2 * ((F.lane >> 3) & 1) + ((F.lane >> 2) & 1);
        LAS float* sx = (LAS float*)(F.lds + 65536) + F.wave * 32;
#pragma unroll
        for (int rI = 0; rI < 2; ++rI) { float r8[8], q4[4], p2[2];
#pragma unroll
            for (int i = 0; i < 8; ++i) { auto rr = __builtin_amdgcn_permlane32_swap(__float_as_uint(pa[rI][i]), __float_as_uint(pa[rI][i + 8]), false, false); r8[i] = __uint_as_float(rr[0]) + __uint_as_float(rr[1]); }
#pragma unroll
            for (int i = 0; i < 4; ++i) { auto rr = __builtin_amdgcn_permlane16_swap(__float_as_uint(r8[i]), __float_as_uint(r8[i + 4]), false, false); q4[i] = __uint_as_float(rr[0]) + __uint_as_float(rr[1]); }
#pragma unroll
            for (int i = 0; i < 2; ++i) { const float snd = b3 ? q4[i] : q4[i + 2], kp = b3 ? q4[i + 2] : q4[i]; p2[i] = kp + dpp_mov<0x140>(snd); }
            float z; { const float snd = b2 ? p2[0] : p2[1], kp = b2 ? p2[1] : p2[0]; z = kp + dpp_mov<0x141>(snd); }
            z = xor2_add(xor1_add(z));
            sx[rI * 16 + el] = 1.f / (1.f + __expf(-z)); }
        asm volatile("s_waitcnt lgkmcnt(0)" ::: "memory");
#pragma unroll
        for (int rI = 0; rI < 2; ++rI) { const int row = rw[rI]; const bool st = (rI == 0) || vB;
        float sc[16], sel[16];
#pragma unroll
        for (int q = 0; q < 4; ++q) { const f32x4 t = *(const LAS f32x4*)(sx + rI * 16 + 4 * q); sc[4 * q] = t.x; sc[4 * q + 1] = t.y; sc[4 * q + 2] = t.z; sc[4 * q + 3] = t.w; }
#pragma unroll
        for (int e = 0; e < 16; ++e) sel[e] = sc[e] + br[e];
        int best = 0; float bestv = -3.0e38f; int ci0[4], ci1[4]; float cw0[4], cw1[4];
#pragma unroll
        for (int g = 0; g < 4; ++g) {
            const float a = sel[4 * g], b = sel[4 * g + 1], c2 = sel[4 * g + 2], d = sel[4 * g + 3];
            int i0 = 0; float m0 = a; { const bool t = b > m0; m0 = t ? b : m0; i0 = t ? 1 : i0; } { const bool t = c2 > m0; m0 = t ? c2 : m0; i0 = t ? 2 : i0; } { const bool t = d > m0; m0 = t ? d : m0; i0 = t ? 3 : i0; }
            int i1 = -1; float m1 = -3.0e38f;
            { const bool t = (i0 != 0) & (a > m1); m1 = t ? a : m1; i1 = t ? 0 : i1; } { const bool t = (i0 != 1) & (b > m1); m1 = t ? b : m1; i1 = t ? 1 : i1; }
            { const bool t = (i0 != 2) & (c2 > m1); m1 = t ? c2 : m1; i1 = t ? 2 : i1; } { const bool t = (i0 != 3) & (d > m1); m1 = t ? d : m1; i1 = t ? 3 : i1; }
            const float gs = m0 + m1; { const bool t = gs > bestv; bestv = t ? gs : bestv; best = t ? g : best; }
            ci0[g] = 4 * g + i0; ci1[g] = 4 * g + i1;
            const float s0 = sc[4 * g], s1 = sc[4 * g + 1], s2_ = sc[4 * g + 2], s3 = sc[4 * g + 3];
            cw0[g] = i0 == 0 ? s0 : (i0 == 1 ? s1 : (i0 == 2 ? s2_ : s3)); cw1[g] = i1 == 0 ? s0 : (i1 == 1 ? s1 : (i1 == 2 ? s2_ : s3)); }
        const int e0 = best == 0 ? ci0[0] : (best == 1 ? ci0[1] : (best == 2 ? ci0[2] : ci0[3])), e1 = best == 0 ? ci1[0] : (best == 1 ? ci1[1] : (best == 2 ? ci1[2] : ci1[3]));
        float w0 = best == 0 ? cw0[0] : (best == 1 ? cw0[1] : (best == 2 ? cw0[2] : cw0[3])), w1 = best == 0 ? cw1[0] : (best == 1 ? cw1[1] : (best == 2 ? cw1[2] : cw1[3]));
        const float wn = 1.f / (w0 + w1); w0 *= wn; w1 *= wn;
        if (st) { if (F.lane == 0 && !dry) {
            const int lp0 = __hip_atomic_fetch_add(F.lc + LC_LCNT + e0, 1, __ATOMIC_RELAXED, __HIP_MEMORY_SCOPE_WORKGROUP);
            const int lp1 = __hip_atomic_fetch_add(F.lc + LC_LCNT + e1, 1, __ATOMIC_RELAXED, __HIP_MEMORY_SCOPE_WORKGROUP);
            LAS int* wt = F.lc + LC_WTAB + (F.wave * 16 + nr) * 8;
            wt[0] = row; wt[1] = e0; wt[2] = lp0; wt[3] = e1; wt[4] = lp1; wt[5] = __float_as_int(w0); wt[6] = __float_as_int(w1); }
            ++nr; } }
    }
    __syncthreads();
    if (dry) return;
    if (F.tid < 16) { const int n = F.lc[LC_LCNT + F.tid];
        const unsigned base = n ? xb_add((unsigned*)(ws + WS_CTL) + CW_CNT + (l * 16 + F.tid) * 64, (unsigned)n) : 0u;
        F.lc[LC_GBASE + F.tid] = (int)base; }
    __syncthreads();
    if (F.lane < nr) {
        const LAS int* wt = F.lc + LC_WTAB + (F.wave * 16 + F.lane) * 8;
        const int row = wt[0], e0 = wt[1], e1 = wt[3]; const int p0 = F.lc[LC_GBASE + e0] + wt[2], p1 = F.lc[LC_GBASE + e1] + wt[4];
        IDX[e0 * MROWS + p0] = row; IDX[e1 * MROWS + p1] = row;
        i32x4 rt; rt.x = (e0 << 15) | p0; rt.y = (e1 << 15) | p1; rt.z = wt[5]; rt.w = wt[6];
        ROUTE[row] = rt; }
}

__global__ void __launch_bounds__(NTHREADS, 2) mk_fwd(Args args) {
    extern __shared__ __attribute__((aligned(16))) unsigned char lds_raw[];
    LAS int* lc0 = (LAS int*)((LAS unsigned char*)lds_raw + LDSCTL_OFF);
    const int wave_s = __builtin_amdgcn_readfirstlane((int)threadIdx.x >> 6);
    for (int u = wave_s * 64 + lane_id(); u < (LDS_BYTES - LDSCTL_OFF) / 4; u += NTHREADS) lc0[u] = 0;
    __syncthreads();
#define IS_T0 (wave_s == 0 && lane_id() == 0)
    unsigned* barw = (unsigned*)(args.ws + WS_CTL) + CW_BAR;
#if MK_MULTI
    XcdBarrier bar; bar.bar = barw; bar.x = 0; bar.st = nullptr;
#define GRID_BAR() do { } while (0)
#else
    XcdBarrier bar = xcd_barrier_post(barw, (volatile LAS unsigned*)(lc0 + LC_BAR), IS_T0);
#define GRID_BAR() xcd_barrier(bar, IS_T0)
#endif
    const int lo = args.ph_lo, hi = args.ph_hi;
#ifndef PHMASK
#define PHMASK 0xFFFF
#endif
#define EN(b) ((PHMASK >> (b)) & 1)
#ifndef REP_MASK
#define REP_MASK 0
#endif
#define REP_CAT2(a, b) a##b
#define REP_CAT(a, b) REP_CAT2(a, b)
#define REP(b) for (int REP_CAT(_rep, __LINE__) = 0; REP_CAT(_rep, __LINE__) < 1 + ((REP_MASK >> (b)) & 1); ++REP_CAT(_rep, __LINE__))
#define IN(k) (lo <= (k) && (k) < hi)
#define SEAM(k) do { if (IN(k) && IN((k) + 1)) GRID_BAR(); } while (0)

    if (IN(0) && EN(0)) REP(0) { const Ctx F = make_ctx(wave_s); p0_prologue(F); } SEAM(0);

    for (int l = 0; l < DEPTH; ++l) {
        const int pb = 1 + 8 * l, li = l >> 1; const bool odd = (l & 1) != 0;
        const int pm_lo = (l == DEPTH - 1) ? 1 : 0;
        if (IN(pb + 0) && EN(1)) REP(1) { const Ctx F = make_ctx(wave_s); phase_a(F, l, nullptr); } SEAM(pb + 0);
        if (IN(pb + 1) && EN(2)) REP(2) {
            const Ctx F = make_ctx(wave_s); unsigned char* ws = F.ws; const int NIN = odd ? ODD_IN : EVEN_IN;
            pg8::DenseSched S; S.init((const bf16_t*)(ws + WS_HB), odd ? (const bf16_t*)(ws + WS_WINO) + (size_t)li * ODD_IN * DM : (const bf16_t*)(ws + WS_WINE) + (size_t)li * EVEN_IN * DM, DM, 0, MROWS / 256, NIN, F.G, F.c);
            pg8::EpiBf16 E{(bf16_t*)(ws + WS_QKV), NIN};
            pg8::gemm_phase<pg8::EpiBf16, pg8::DenseSched>(F.tid, F.lds, DM, S, E);
        } SEAM(pb + 1);
        if (IN(pb + 2) && EN(3)) { const Ctx F = make_ctx(wave_s); if (odd) phase_c_odd(F, li, l); else phase_c_even(F, l); } SEAM(pb + 2);
        if (IN(pb + 3) && EN(4)) REP(4) {
#ifndef ATTSEL
#define ATTSEL 15
#endif
            if (odd) { if (ATTSEL & 8) REP(11) { const Ctx F = make_ctx(wave_s); phase_d_odd(F, l); } }
            else { REP(9) { if (ATTSEL & 1) { const Ctx F = make_ctx(wave_s); phase_d_b0(F, l); } if (ATTSEL & 2) { const Ctx F = make_ctx(wave_s); phase_d_b1(F, li, l); } } if (ATTSEL & 4) REP(10) { const Ctx F = make_ctx(wave_s); phase_d_a(F, li); } }
        } SEAM(pb + 3);
        if (IN(pb + 4) && EN(5)) REP(5) {
            const Ctx F = make_ctx(wave_s); unsigned char* ws = F.ws;
            pg8::DenseSched S; S.init((const bf16_t*)(ws + WS_OB), (const bf16_t*)(ws + WS_WOUT) + (size_t)l * DM * DM, DM, 1, MROWS / 256 - 1, DM, F.G, F.c);
            pg8::EpiBf16 E{(bf16_t*)(ws + WS_YB), DM};
            pg8::gemm_phase<pg8::EpiBf16, pg8::DenseSched>(F.tid, F.lds, DM, S, E);
            if (pm_lo == 0) ctx_outproj_mini(F, (const bf16_t*)(ws + WS_OB), (const bf16_t*)(ws + WS_WOUT) + (size_t)l * DM * DM, (bf16_t*)(ws + WS_YB));
        } SEAM(pb + 4);
#ifdef PF_PROBE
        if (IN(pb + 5) && EN(6)) { const Ctx F = make_ctx(wave_s); phase_f(F, l, pm_lo * 256, true); __syncthreads(); }
#endif
        if (IN(pb + 5) && EN(6)) { const Ctx F = make_ctx(wave_s); phase_f(F, l, pm_lo * 256); } SEAM(pb + 5);
#define MOE_GU_SCHED(S) pg8::MoeSched<true> S; S.Ab = (const bf16_t*)(ws + WS_HB); S.Wb = (const bf16_t*)(ws + WS_WGU) + (size_t)l * NEXP * 1024 * DM; S.idx = (const int*)(ws + WS_IDX); \
            S.tstart = F.lc + LC_TSTART; S.ecnt = F.lc + LC_ECNT; S.K = DM
#define MOE_DN_SCHED(S) pg8::MoeSched<false> S; S.Ab = (const bf16_t*)(ws + WS_YB); S.Wb = (const bf16_t*)(ws + WS_WD) + (size_t)l * NEXP * DM * DEXP; S.idx = nullptr; \
            S.tstart = F.lc + LC_TSTART; S.ecnt = F.lc + LC_ECNT; S.K = DEXP
        int moe_nu = 0, moe_r = 0; bool moe_split = false;
        if ((IN(pb + 6) && EN(7)) || (IN(pb + 7) && EN(8))) { const Ctx F = make_ctx(wave_s); load_tstart(F, l); moe_nu = __builtin_amdgcn_readfirstlane(F.lc[LC_TSTART + 16]) * 4;
            moe_r = moe_nu - 2 * F.G; moe_split = (MK_MULTI == 0) && (REP_MASK == 0) && moe_r > 0 && 3 * moe_r <= F.G; }
        if (IN(pb + 6) && EN(7)) REP(7) {
            const Ctx F = make_ctx(wave_s); unsigned char* ws = F.ws;
            MOE_GU_SCHED(S); S.base = F.c; S.stride = F.G; S.hi = moe_split ? 2 * F.G : moe_nu;
            pg8::EpiGateUp E{(bf16_t*)(ws + WS_YB)};
            pg8::gemm_phase<pg8::EpiGateUp, pg8::MoeSched<true>>(F.tid, F.lds, DM, S, E);
        } SEAM(pb + 6);
        if (IN(pb + 7) && EN(8)) REP(8) {
            if (!moe_split) {
                const Ctx F = make_ctx(wave_s); unsigned char* ws = F.ws;
                MOE_DN_SCHED(S); S.base = F.c; S.stride = F.G; S.hi = moe_nu;
                pg8::EpiBf16 E{(bf16_t*)(ws + WS_QKV), DM};
                pg8::gemm_phase<pg8::EpiBf16, pg8::MoeSched<false>>(F.tid, F.lds, DEXP, S, E);
            } else {
                { const Ctx F = make_ctx(wave_s); unsigned char* ws = F.ws;
                  MOE_GU_SCHED(S); S.base = 2 * F.G + F.c; S.stride = F.G; S.hi = moe_nu;
                  pg8::EpiGateUp E{(bf16_t*)(ws + WS_YB)};
                  pg8::gemm_phase<pg8::EpiGateUp, pg8::MoeSched<true>>(F.tid, F.lds, DM, S, E); }
                { const Ctx F = make_ctx(wave_s); unsigned char* ws = F.ws;
                  MOE_DN_SCHED(S); S.base = F.c >= moe_r ? 2 * (F.c - moe_r) : 0; S.stride = 1; S.hi = F.c >= moe_r ? S.base + 2 : 0;
                  pg8::EpiBf16 E{(bf16_t*)(ws + WS_QKV), DM};
                  pg8::gemm_phase<pg8::EpiBf16, pg8::MoeSched<false>>(F.tid, F.lds, DEXP, S, E); }
                GRID_BAR();
                { const Ctx F = make_ctx(wave_s); unsigned char* ws = F.ws;
                  MOE_DN_SCHED(S); S.base = 2 * (F.G - moe_r) + F.c; S.stride = F.G; S.hi = moe_nu;
                  pg8::EpiBf16 E{(bf16_t*)(ws + WS_QKV), DM};
                  pg8::gemm_phase<pg8::EpiBf16, pg8::MoeSched<false>>(F.tid, F.lds, DEXP, S, E); }
            }
        } SEAM(pb + 7);
    }
    if (IN(33) && EN(1)) { const Ctx F = make_ctx(wave_s); float* outp = (float*)*(GAS float* const CAS*)((const CAS char*)F.in + 200); phase_a(F, 4, outp); }
#undef IN
#undef SEAM
}

constexpr int NPHASE = 34;
extern "C" void kernel_launch(void* const* d_in, const int* in_sizes, int n_in, void* d_out, int out_size, void* d_ws, size_t ws_size, hipStream_t stream) {
    static int grid = 0;
    if (grid == 0) {
        if (n_in != 25 || out_size != SEQ * DM || ws_size < WS_END) { fprintf(stderr, "kernel_launch: shape mismatch n_in %d out %d ws %zu (need %zu)\n", n_in, out_size, ws_size, (size_t)WS_END); grid = -1; return; }
        int dev = 0, cus = 0, per_cu = 0;
        if (hipGetDevice(&dev) != hipSuccess || hipDeviceGetAttribute(&cus, hipDeviceAttributeMultiprocessorCount, dev) != hipSuccess) { grid = -1; return; }
        if (hipFuncSetAttribute((const void*)mk_fwd, hipFuncAttributeMaxDynamicSharedMemorySize, LDS_BYTES) != hipSuccess) { fprintf(stderr, "kernel_launch: hipFuncSetAttribute failed\n"); grid = -1; return; }
        if (hipOccupancyMaxActiveBlocksPerMultiprocessor(&per_cu, (const void*)mk_fwd, NTHREADS, LDS_BYTES) != hipSuccess || per_cu < 1) { fprintf(stderr, "kernel_launch: occupancy query says %d\n", per_cu); }
        (void)hipGetLastError();
        grid = cus;
    }
    if (grid < 0) return;
    if (hipMemsetAsync((char*)d_ws + WS_CTL, 0, CTL_ZERO_BYTES, stream) != hipSuccess) return;
    Args a{};
    for (int i = 0; i < 25; ++i) a.in[i] = (const float*)d_in[i];
    a.out = (float*)d_out; a.ws = (unsigned char*)d_ws;
#if MK_MULTI
    for (int p = 0; p < NPHASE; ++p) { a.ph_lo = p; a.ph_hi = p + 1; hipLaunchKernelGGL(mk_fwd, dim3(grid), dim3(NTHREADS), LDS_BYTES, stream, a); }
#else
    a.ph_lo = 0; a.ph_hi = NPHASE;
    hipLaunchKernelGGL(mk_fwd, dim3(grid), dim3(NTHREADS), LDS_BYTES, stream, a);
#endif
    const hipError_t le = hipPeekAtLastError();
    if (le != hipSuccess) fprintf(stderr, "kernel_launch: launch failed: %s\n", hipGetErrorName(le));
}
```
